# Optimizing an MI355X kernel written in HIP

```python
import math
import jax, jax.numpy as jnp
from jax import lax
import numpy as np

D_MODEL = 1024
BATCH = 2
SEQ = 8192
DEPTH = 1

HG_HEADS = 8
HG_DK = 128
HG_DV = D_MODEL // HG_HEADS
HG_KW = HG_HEADS * HG_DK
HG_VW = HG_HEADS * HG_DV
CHUNK = 64
CV_WIDTH = D_MODEL
CV_GROUPS = 8
CONV_K = 3
PROJ_WIDTHS = (HG_KW, HG_KW, HG_VW, HG_VW, CV_WIDTH, CV_WIDTH, CV_WIDTH, D_MODEL, D_MODEL)
PROJ_W = sum(PROJ_WIDTHS)
SPLIT_IDX = tuple(int(v) for v in np.cumsum(PROJ_WIDTHS)[:-1])
N_KEYS = 128
N_EXPERTS = N_KEYS * N_KEYS
PK_HEADS = 8
PK_DKEY = 256
PK_HALF = PK_DKEY // 2
PK_TOPK = 16
PEER_BLOCK = 128
PLE_DIM = 256
LN_EPS = 1e-5
RMS_EPS = 1e-6
ALPHA = (2.0 * DEPTH) ** 0.25
BETA = (8.0 * DEPTH) ** -0.25

kernel_name = "hybrid_hgrn2_shortconv_peer_deepnorm"


def layer_norm(x, g, b):
    xf = x.astype(jnp.float32)
    mu = jnp.mean(xf, axis=-1, keepdims=True)
    xc = xf - mu
    var = jnp.mean(xc * xc, axis=-1, keepdims=True)
    return (xc * lax.rsqrt(var + LN_EPS) * g.astype(jnp.float32) + b.astype(jnp.float32)).astype(x.dtype)


def hgrn2_chunkwise(q, k, v, logf):
    bsz, seq = q.shape[0], q.shape[1]
    n = seq // CHUNK

    def to_chunks(t):
        return t.astype(jnp.float32).reshape(bsz, n, CHUNK, HG_HEADS, t.shape[-1]).transpose(0, 3, 1, 2, 4)

    q, k, v, logf = to_chunks(q), to_chunks(k), to_chunks(v), to_chunks(logf)
    bcum = jnp.cumsum(logf, axis=3)
    qe = q * jnp.exp(bcum)
    ke = k * jnp.exp(-bcum)
    causal = jnp.tril(jnp.ones((CHUNK, CHUNK), dtype=bool))
    a = jnp.einsum('bhnik,bhnjk->bhnij', qe, ke)
    a = jnp.where(causal, a, 0.0)
    o_intra = jnp.einsum('bhnij,bhnjv->bhniv', a, v)
    b_last = bcum[:, :, :, -1:, :]
    k_end = k * jnp.exp(b_last - bcum)
    ds = jnp.einsum('bhnck,bhncv->bhnkv', k_end, v)
    decay = jnp.exp(b_last[:, :, :, 0, :])

    def step(state, inp):
        d, dsn = inp
        return d[..., None] * state + dsn, state

    s0 = jnp.zeros((bsz, HG_HEADS, HG_DK, HG_DV), jnp.float32)
    _, s_prev = lax.scan(step, s0, (jnp.moveaxis(decay, 2, 0), jnp.moveaxis(ds, 2, 0)))
    s_prev = jnp.moveaxis(s_prev, 0, 2)
    o_inter = jnp.einsum('bhnck,bhnkv->bhncv', qe, s_prev)
    o = o_intra + o_inter
    return o.transpose(0, 2, 3, 1, 4).reshape(bsz, seq, HG_HEADS, HG_DV)


def causal_depthwise_conv3(u, w, b):
    seq = u.shape[1]
    up = jnp.pad(u, ((0, 0), (CONV_K - 1, 0), (0, 0)))
    y = b
    for j in range(CONV_K):
        y = y + up[:, j:j + seq, :] * w[j]
    return y


def token_mixer(x, w_in, lb, hg_norm_g, conv_w, conv_b, w_branch_a, w_branch_b, w_out):
    bsz, seq = x.shape[0], x.shape[1]
    z = x @ w_in
    q, fz, iv, og, cb, cc, ch, ga, gb = jnp.split(z, SPLIT_IDX, axis=-1)
    q = q.reshape(bsz, seq, HG_HEADS, HG_DK) * (HG_DK ** -0.5)
    fz = fz.reshape(bsz, seq, HG_HEADS, HG_DK).astype(jnp.float32)
    lbh = lb.reshape(HG_HEADS, HG_DK)
    f = lbh + (1.0 - lbh) * jax.nn.sigmoid(fz)
    logf = jnp.log(f)
    kin = (1.0 - lbh) * jax.nn.sigmoid(-fz)
    v = iv.reshape(bsz, seq, HG_HEADS, HG_DV)
    o = hgrn2_chunkwise(q, kin, v, logf)
    o = o * lax.rsqrt(jnp.mean(o * o, axis=-1, keepdims=True) + RMS_EPS)
    o = o * hg_norm_g.reshape(HG_HEADS, HG_DV).astype(jnp.float32)
    o = o.reshape(bsz, seq, HG_VW).astype(x.dtype) * jax.nn.silu(og)
    yc = cb * causal_depthwise_conv3(cc * ch, conv_w, conv_b)
    merged = jax.nn.sigmoid(ga) * (o @ w_branch_a) + jax.nn.sigmoid(gb) * (yc @ w_branch_b)
    return merged @ w_out


def peer(x, w_q, sub_keys, u, v):
    bsz, seq, d = x.shape
    xt = x.reshape((bsz * seq) // PEER_BLOCK, PEER_BLOCK, d)

    def block(xb):
        tb = xb.shape[0]
        qh = (xb @ w_q).reshape(tb, PK_HEADS, 2, PK_HALF)
        s = jnp.einsum('thpd,hpkd->thpk', qh, sub_keys).astype(jnp.float32)
        s1, i1 = lax.top_k(s[:, :, 0], PK_TOPK)
        s2, i2 = lax.top_k(s[:, :, 1], PK_TOPK)
        cand = (s1[..., :, None] + s2[..., None, :]).reshape(tb, PK_HEADS, PK_TOPK * PK_TOPK)
        cidx = (i1[..., :, None] * N_KEYS + i2[..., None, :]).reshape(tb, PK_HEADS, PK_TOPK * PK_TOPK)
        top, pos = lax.top_k(cand, PK_TOPK)
        eidx = jnp.take_along_axis(cidx, pos, axis=-1)
        g = jax.nn.softmax(top, axis=-1).astype(xb.dtype)
        ue = jnp.take(u, eidx, axis=0)
        h = jax.nn.gelu(jnp.einsum('thkd,td->thk', ue, xb), approximate=False)
        ve = jnp.take(v, eidx, axis=0)
        return jnp.einsum('thk,thkd->td', g * h, ve)

    out = lax.map(block, xt)
    return out.reshape(bsz, seq, d)


def setup_inputs(seed: int = 0) -> dict:
    key = jax.random.key(seed)
    ks = jax.random.split(key, 20)
    f32 = jnp.float32
    nrm = lambda k, shape, s: jax.random.normal(k, shape, f32) * s
    return {
        "x": nrm(ks[0], (BATCH, SEQ, D_MODEL), 1.0),
        "p": nrm(ks[1], (DEPTH, BATCH, SEQ, PLE_DIM), 1.0),
        "w_in": nrm(ks[2], (DEPTH, D_MODEL, PROJ_W), D_MODEL ** -0.5),
        "lb_param": nrm(ks[3], (DEPTH + 1, HG_KW), 0.5),
        "hg_norm_g": 1.0 + nrm(ks[4], (DEPTH, HG_VW), 0.02),
        "conv_w": nrm(ks[5], (DEPTH, CONV_K, CV_WIDTH), CONV_K ** -0.5),
        "conv_b": nrm(ks[6], (DEPTH, CV_WIDTH), 0.02),
        "w_branch_a": nrm(ks[7], (DEPTH, HG_VW, D_MODEL), BETA * HG_VW ** -0.5),
        "w_branch_b": nrm(ks[8], (DEPTH, CV_WIDTH, D_MODEL), BETA * CV_WIDTH ** -0.5),
        "w_out": nrm(ks[9], (DEPTH, D_MODEL, D_MODEL), BETA * D_MODEL ** -0.5),
        "ln1_g": 1.0 + nrm(ks[10], (DEPTH, D_MODEL), 0.02),
        "ln1_b": nrm(ks[11], (DEPTH, D_MODEL), 0.02),
        "pk_w_q": nrm(ks[12], (DEPTH, D_MODEL, PK_HEADS * PK_DKEY), D_MODEL ** -0.5),
        "pk_sub_keys": nrm(ks[13], (DEPTH, PK_HEADS, 2, N_KEYS, PK_HALF), PK_HALF ** -0.5),
        "pk_u": nrm(ks[14], (DEPTH, N_EXPERTS, D_MODEL), D_MODEL ** -0.5),
        "pk_v": nrm(ks[15], (DEPTH, N_EXPERTS, D_MODEL), BETA),
        "ln2_g": 1.0 + nrm(ks[16], (DEPTH, D_MODEL), 0.02),
        "ln2_b": nrm(ks[17], (DEPTH, D_MODEL), 0.02),
        "ple_w_gate": nrm(ks[18], (DEPTH, D_MODEL, D_MODEL), D_MODEL ** -0.5),
        "ple_w_proj": nrm(ks[19], (DEPTH, PLE_DIM, D_MODEL), PLE_DIM ** -0.5),
    }


def reference(x, p, w_in, lb_param, hg_norm_g, conv_w, conv_b, w_branch_a, w_branch_b, w_out,
              ln1_g, ln1_b, pk_w_q, pk_sub_keys, pk_u, pk_v, ln2_g, ln2_b, ple_w_gate, ple_w_proj):
    lb_all = jnp.cumsum(jax.nn.softmax(lb_param.astype(jnp.float32), axis=0), axis=0)
    for i in range(DEPTH):
        mix = token_mixer(x, w_in[i], lb_all[i], hg_norm_g[i], conv_w[i], conv_b[i],
                          w_branch_a[i], w_branch_b[i], w_out[i])
        x = layer_norm(ALPHA * x + mix, ln1_g[i], ln1_b[i])
        x = layer_norm(ALPHA * x + peer(x, pk_w_q[i], pk_sub_keys[i], pk_u[i], pk_v[i]), ln2_g[i], ln2_b[i])
        x = x + jax.nn.sigmoid(x @ ple_w_gate[i]) * (p[i] @ ple_w_proj[i])
    return x
```

```cpp
#include <hip/hip_runtime.h>
#include <cstdio>
#include <cstdint>
#include <cmath>

#ifndef MK_N_LAUNCHES
#define MK_N_LAUNCHES 14
#endif

constexpr int BATCH = 2, SEQ = 8192, D = 1024, T = BATCH * SEQ;
constexpr int PROJ_W = 9216;
constexpr int NHEAD = 8, DK = 128;
constexpr int PKH = 8, PKD = 256, NKEYS = 128, TOPK = 16;
constexpr int PLE = 256;
constexpr float LN_EPS = 1e-5f, RMS_EPS = 1e-6f;
constexpr float ALPHA = 1.189207115002721f;
constexpr int NWAVES = 8;
constexpr int NPHASES = 14;
constexpr int N_LAUNCHES = MK_N_LAUNCHES;

constexpr size_t MiB = 1u << 20;
constexpr size_t WS_CTL = 0, CTL_ZERO_BYTES = 1 * MiB;
constexpr size_t WS_WIN = 1 * MiB;
constexpr size_t WS_WA = 19 * MiB, WS_WB = 21 * MiB, WS_WO = 23 * MiB, WS_WPG = 25 * MiB;
constexpr size_t WS_WQ = 27 * MiB;
constexpr size_t WS_SK = 31 * MiB;
constexpr size_t WS_WPP = 31 * MiB + 512 * 1024;
constexpr size_t WS_XB = 32 * MiB;
constexpr size_t WS_BIG = 64 * MiB;
constexpr size_t WS_X1 = 128 * MiB;
constexpr size_t WS_X1B = 192 * MiB;
constexpr size_t WS_OA = 224 * MiB;
constexpr size_t WS_PB = 256 * MiB;
constexpr size_t WS_END = 264 * MiB;
constexpr size_t WS_YC = WS_XB;
constexpr size_t WS_IDS = WS_XB;
constexpr size_t WS_GW = WS_XB + 8 * MiB;
constexpr size_t WS_Y = WS_BIG;
constexpr size_t WS_QP = WS_BIG;
constexpr size_t WS_X2B = WS_BIG;
constexpr int CW_BAR = 4096;

constexpr int LDS_BYTES = 147456;
constexpr int RING_BYTES = 131072, LDSCTL_OFF = RING_BYTES, MISC_OFF = LDSCTL_OFF + 320;

#define GAS __attribute__((address_space(1)))
#define LAS __attribute__((address_space(3)))
typedef unsigned short bf16;
typedef unsigned v4u __attribute__((ext_vector_type(4)));
typedef float f32x4 __attribute__((ext_vector_type(4)));
typedef GAS unsigned gu32;
#define RLX_AGENT __ATOMIC_RELAXED, __HIP_MEMORY_SCOPE_AGENT
#define LDS_WAIT() asm volatile("s_waitcnt lgkmcnt(0)" ::: "memory")

__device__ __forceinline__ unsigned f2bf(float f) { unsigned u = __builtin_bit_cast(unsigned, f); return (u + 0x7fffu + ((u >> 16) & 1u)) >> 16; }
__device__ __forceinline__ unsigned pk2(float lo, float hi) { return f2bf(lo) | (f2bf(hi) << 16); }
__device__ __forceinline__ float bf2f(unsigned short h) { return __builtin_bit_cast(float, (unsigned)h << 16); }
__device__ __forceinline__ float bflo(unsigned w) { return __builtin_bit_cast(float, w << 16); }
__device__ __forceinline__ float bfhi(unsigned w) { return __builtin_bit_cast(float, w & 0xffff0000u); }
__device__ __forceinline__ void unpack8(const v4u w, float (&o)[8]) { o[0] = bflo(w.x); o[1] = bfhi(w.x); o[2] = bflo(w.y); o[3] = bfhi(w.y); o[4] = bflo(w.z); o[5] = bfhi(w.z); o[6] = bflo(w.w); o[7] = bfhi(w.w); }
__device__ __forceinline__ v4u pack8(const float (&v)[8]) { v4u w; w.x = pk2(v[0], v[1]); w.y = pk2(v[2], v[3]); w.z = pk2(v[4], v[5]); w.w = pk2(v[6], v[7]); return w; }
__device__ __forceinline__ float sigmoidf_(float x) { return 1.0f / (1.0f + __expf(-x)); }
__device__ __forceinline__ float wave_sum(float v) {
#pragma unroll
    for (int o = 1; o < 64; o <<= 1) v += __shfl_xor(v, o);
    return v;
}

#define XB_TMO      128
#define XB_XCNT(j)  (256  + 64 * (j))
#define XB_XSUB(j)  (1280 + 64 * (j))
#define XB_XGEN(j)  (2304 + 64 * (j))
#define XB_TOP      3328
#define XB_TOPGEN   3392
#define XCD_BAR_WORDS 3456
#define XB_SPIN_CAP (1u << 26)

__device__ __forceinline__ unsigned xb_ld(unsigned* p)              { return __hip_atomic_load(p, __ATOMIC_RELAXED, __HIP_MEMORY_SCOPE_AGENT); }
__device__ __forceinline__ unsigned xb_add(unsigned* p, unsigned v) { return __hip_atomic_fetch_add(p, v, __ATOMIC_RELAXED, __HIP_MEMORY_SCOPE_AGENT); }
__device__ __forceinline__ unsigned xb_xcc_id() { return (unsigned)__builtin_amdgcn_s_getreg((3 << 11) | 20) & 0xFu; }
#define XB_SPIN(cond, bar) do { unsigned _sp = 0; while (cond) { __builtin_amdgcn_s_sleep(1); \
    if ((++_sp & 255u) == 0u) { if (xb_ld(&(bar)[XB_TMO])) break; if (_sp > XB_SPIN_CAP) { atomicAdd(&(bar)[XB_TMO], 1u); break; } } } } while (0)

struct XcdBarrier { unsigned* bar; unsigned x; volatile LAS unsigned* st; };

__device__ __forceinline__ XcdBarrier xcd_barrier_post(unsigned* bar, volatile LAS unsigned* st) {
    XcdBarrier b; b.bar = bar; b.x = xb_xcc_id(); b.st = st;
    if (threadIdx.x == 0) (void)xb_add(&bar[XB_XCNT(b.x)], 1u);
    return b;
}
__device__ __forceinline__ void xcd_barrier_complete(unsigned* bar, unsigned x, unsigned& nloc, unsigned& nx) {
    const unsigned G = gridDim.x * gridDim.y * gridDim.z;
    unsigned sum, cnt, mine, sp = 0u;
    for (;;) {
        sum = 0u; cnt = 0u; mine = 0u;
#pragma unroll
        for (unsigned j = 0; j < 16; ++j) { const unsigned c = xb_ld(&bar[XB_XCNT(j)]); sum += c; cnt += (c > 0u) ? 1u : 0u; mine = (j == x) ? c : mine; }
        if (sum == G) break;
        __builtin_amdgcn_s_sleep(1);
        if ((++sp & 255u) == 0u) { if (xb_ld(&bar[XB_TMO])) break; if (sp > XB_SPIN_CAP) { atomicAdd(&bar[XB_TMO], 1u); break; } }
    }
    nloc = mine > 0u ? mine : 1u; nx = cnt > 0u ? cnt : 1u;
}
__device__ __forceinline__ void xcd_barrier(const XcdBarrier& b) {
    asm volatile("s_waitcnt vmcnt(0)" ::: "memory");
    __syncthreads();
    if (threadIdx.x == 0) {
        unsigned* bar = b.bar;
        __builtin_amdgcn_s_waitcnt(0);
        unsigned nloc = b.st[0], nx = b.st[1];
        if (nloc == 0u) { xcd_barrier_complete(bar, b.x, nloc, nx); b.st[0] = nloc; b.st[1] = nx; }
        const unsigned old = xb_add(&bar[XB_XSUB(b.x)], 1u);
        const unsigned gen = old / nloc;
        if (old + 1u == (gen + 1u) * nloc) {
            __builtin_amdgcn_fence(__ATOMIC_RELEASE, "agent");
            asm volatile("s_waitcnt vmcnt(0)" ::: "memory");
            const unsigned og = xb_add(&bar[XB_TOP], 1u);
            const unsigned tg = og / nx;
            if (og + 1u == (tg + 1u) * nx) xb_add(&bar[XB_TOPGEN], 1u);
            else XB_SPIN(xb_ld(&bar[XB_TOPGEN]) == tg, bar);
            __builtin_amdgcn_fence(__ATOMIC_ACQUIRE, "agent");
            xb_add(&bar[XB_XGEN(b.x)], 1u);
            asm volatile("s_waitcnt vmcnt(0)" ::: "memory");
        } else {
            XB_SPIN(xb_ld(&bar[XB_XGEN(b.x)]) == gen, bar);
            __builtin_amdgcn_fence(__ATOMIC_ACQUIRE, "agent");
            asm volatile("s_waitcnt vmcnt(0)" ::: "memory");
        }
    }
    __syncthreads();
}

struct Frame {
    LAS unsigned char* lds;
    int tid, lane, wave, vcu, G;
};

struct Args {
    const float* in[20]; float* out; unsigned char* ws; int ph_lo, ph_hi, li, pad;
};

__device__ __forceinline__ void p0_transpose_item(const float* W, int K, int N, bf16* WT, LAS float* scr, int item, int lane) {
    const int nblk = N / 32, kb = item / nblk, nb = item % nblk, k0 = 64 * kb, n0 = 32 * nb;
#pragma unroll 8
    for (int i = 0; i < 32; ++i) { const int kk = 2 * i + (lane >> 5); scr[kk * 33 + (lane & 31)] = W[(size_t)(k0 + kk) * N + n0 + (lane & 31)]; }
    LDS_WAIT(); asm volatile("" ::: "memory");
    const int c = lane & 7;
#pragma unroll
    for (int j = 0; j < 4; ++j) { const int n = (lane >> 3) + 8 * j; const LAS float* s = scr + (8 * c) * 33 + n;
        v4u o; o.x = pk2(s[0 * 33], s[1 * 33]); o.y = pk2(s[2 * 33], s[3 * 33]); o.z = pk2(s[4 * 33], s[5 * 33]); o.w = pk2(s[6 * 33], s[7 * 33]);
        *(v4u*)(WT + (size_t)(n0 + n) * K + k0 + 8 * c) = o; }
    LDS_WAIT(); asm volatile("" ::: "memory");
}
__device__ __forceinline__ void convert_rows(const float* src, bf16* dst, size_t n, int gtid, int nthreads) {
    for (size_t i = (size_t)gtid * 8; i < n; i += (size_t)nthreads * 8) {
        const f32x4 a = *(const f32x4*)(src + i), b = *(const f32x4*)(src + i + 4);
        v4u o; o.x = pk2(a.x, a.y); o.y = pk2(a.z, a.w); o.z = pk2(b.x, b.y); o.w = pk2(b.z, b.w);
        *(v4u*)(dst + i) = o;
    }
}

template <class Epi>
__device__ __forceinline__ void naive_gemm(const Frame& F, const bf16* A, const bf16* Bt, int M, int N, int K, const Epi& E) {
    LAS float* As = (LAS float*)F.lds;
    LAS float* Bs = As + 32 * 132;
    const int tid = F.tid, tr = tid >> 4, tc = tid & 15;
    const int ntn = N / 128, nt = (M / 128) * ntn;
    for (int tile = F.vcu; tile < nt; tile += F.G) {
        const int tm = tile / ntn, tn = tile % ntn;
        float acc[4][8];
#pragma unroll
        for (int i = 0; i < 4; ++i)
#pragma unroll
            for (int j = 0; j < 8; ++j) acc[i][j] = 0.f;
        for (int k0 = 0; k0 < K; k0 += 32) {
            { const int r = tid >> 2, kc = (tid & 3) * 8;
              const v4u a = *(const v4u*)(A + (size_t)(tm * 128 + r) * K + k0 + kc);
              const v4u b = *(const v4u*)(Bt + (size_t)(tn * 128 + r) * K + k0 + kc);
              float fa[8], fb[8]; unpack8(a, fa); unpack8(b, fb);
#pragma unroll
              for (int j = 0; j < 8; ++j) { As[(kc + j) * 132 + r] = fa[j]; Bs[(kc + j) * 132 + r] = fb[j]; } }
            __syncthreads();
#pragma unroll 8
            for (int k = 0; k < 32; ++k) {
                const f32x4 a = *(const LAS f32x4*)(As + k * 132 + tr * 4);
                const f32x4 b0 = *(const LAS f32x4*)(Bs + k * 132 + tc * 8), b1 = *(const LAS f32x4*)(Bs + k * 132 + tc * 8 + 4);
#pragma unroll
                for (int i = 0; i < 4; ++i) {
                    acc[i][0] += a[i] * b0.x; acc[i][1] += a[i] * b0.y; acc[i][2] += a[i] * b0.z; acc[i][3] += a[i] * b0.w;
                    acc[i][4] += a[i] * b1.x; acc[i][5] += a[i] * b1.y; acc[i][6] += a[i] * b1.z; acc[i][7] += a[i] * b1.w; }
            }
            __syncthreads();
        }
#pragma unroll
        for (int i = 0; i < 4; ++i) E.row8(tm * 128 + tr * 4 + i, tn * 128 + tc * 8, acc[i]);
    }
}

struct EpiStore { bf16* O; int ldc;
    __device__ __forceinline__ void row8(int r, int c0, const float (&v)[8]) const { *(v4u*)(O + (size_t)r * ldc + c0) = pack8(v); } };
struct EpiGateA { float* TMP; const bf16* Zcg;
    __device__ __forceinline__ void row8(int r, int c0, const float (&v)[8]) const {
        float g[8]; unpack8(*(const v4u*)(Zcg + (size_t)r * 5120 + 3072 + c0), g);
        f32x4 o0, o1; o0.x = sigmoidf_(g[0]) * v[0]; o0.y = sigmoidf_(g[1]) * v[1]; o0.z = sigmoidf_(g[2]) * v[2]; o0.w = sigmoidf_(g[3]) * v[3];
        o1.x = sigmoidf_(g[4]) * v[4]; o1.y = sigmoidf_(g[5]) * v[5]; o1.z = sigmoidf_(g[6]) * v[6]; o1.w = sigmoidf_(g[7]) * v[7];
        *(f32x4*)(TMP + (size_t)r * D + c0) = o0; *(f32x4*)(TMP + (size_t)r * D + c0 + 4) = o1; } };
struct EpiGateB { const float* TMP; const bf16* Zcg; bf16* MERGED;
    __device__ __forceinline__ void row8(int r, int c0, const float (&v)[8]) const {
        float g[8]; unpack8(*(const v4u*)(Zcg + (size_t)r * 5120 + 4096 + c0), g);
        const f32x4 t0 = *(const f32x4*)(TMP + (size_t)r * D + c0), t1 = *(const f32x4*)(TMP + (size_t)r * D + c0 + 4);
        float o[8]; o[0] = t0.x + sigmoidf_(g[0]) * v[0]; o[1] = t0.y + sigmoidf_(g[1]) * v[1]; o[2] = t0.z + sigmoidf_(g[2]) * v[2]; o[3] = t0.w + sigmoidf_(g[3]) * v[3];
        o[4] = t1.x + sigmoidf_(g[4]) * v[4]; o[5] = t1.y + sigmoidf_(g[5]) * v[5]; o[6] = t1.z + sigmoidf_(g[6]) * v[6]; o[7] = t1.w + sigmoidf_(g[7]) * v[7];
        *(v4u*)(MERGED + (size_t)r * D + c0) = pack8(o); } };
struct EpiResid { const float* X; float* Y;
    __device__ __forceinline__ void row8(int r, int c0, const float (&v)[8]) const {
        const f32x4 x0 = *(const f32x4*)(X + (size_t)r * D + c0), x1 = *(const f32x4*)(X + (size_t)r * D + c0 + 4);
        f32x4 o0, o1; o0.x = ALPHA * x0.x + v[0]; o0.y = ALPHA * x0.y + v[1]; o0.z = ALPHA * x0.z + v[2]; o0.w = ALPHA * x0.w + v[3];
        o1.x = ALPHA * x1.x + v[4]; o1.y = ALPHA * x1.y + v[5]; o1.z = ALPHA * x1.z + v[6]; o1.w = ALPHA * x1.w + v[7];
        *(f32x4*)(Y + (size_t)r * D + c0) = o0; *(f32x4*)(Y + (size_t)r * D + c0 + 4) = o1; } };
struct EpiFinal { const float* X2; const bf16* PP; float* OUT;
    __device__ __forceinline__ void row8(int r, int c0, const float (&v)[8]) const {
        float p[8]; unpack8(*(const v4u*)(PP + (size_t)r * D + c0), p);
        const f32x4 x0 = *(const f32x4*)(X2 + (size_t)r * D + c0), x1 = *(const f32x4*)(X2 + (size_t)r * D + c0 + 4);
        f32x4 o0, o1; o0.x = x0.x + sigmoidf_(v[0]) * p[0]; o0.y = x0.y + sigmoidf_(v[1]) * p[1]; o0.z = x0.z + sigmoidf_(v[2]) * p[2]; o0.w = x0.w + sigmoidf_(v[3]) * p[3];
        o1.x = x1.x + sigmoidf_(v[4]) * p[4]; o1.y = x1.y + sigmoidf_(v[5]) * p[5]; o1.z = x1.z + sigmoidf_(v[6]) * p[6]; o1.w = x1.w + sigmoidf_(v[7]) * p[7];
        *(f32x4*)(OUT + (size_t)r * D + c0) = o0; *(f32x4*)(OUT + (size_t)r * D + c0 + 4) = o1; } };

__device__ __forceinline__ void ln_row_store(f32x4 (&v)[4], const float* g, const float* b, float* orow, bf16* obrow, int lane) {
    float s = 0.f;
#pragma unroll
    for (int j = 0; j < 4; ++j) s += (v[j].x + v[j].y) + (v[j].z + v[j].w);
    const float mean = wave_sum(s) * (1.f / D); float s2 = 0.f;
#pragma unroll
    for (int j = 0; j < 4; ++j) { v[j] = v[j] - mean; s2 += (v[j].x * v[j].x + v[j].y * v[j].y) + (v[j].z * v[j].z + v[j].w * v[j].w); }
    const float rstd = 1.f / sqrtf(wave_sum(s2) * (1.f / D) + LN_EPS);
#pragma unroll
    for (int j = 0; j < 4; ++j) {
        const f32x4 gg = *(const f32x4*)(g + 4 * lane + 256 * j), bb = *(const f32x4*)(b + 4 * lane + 256 * j);
        const f32x4 o = v[j] * rstd * gg + bb;
        *(f32x4*)(orow + 4 * lane + 256 * j) = o;
        unsigned long long w = (unsigned long long)pk2(o.x, o.y) | ((unsigned long long)pk2(o.z, o.w) << 32);
        *(unsigned long long*)(obrow + 4 * lane + 256 * j) = w;
    }
}
__device__ __forceinline__ float gelu_erf(float x) { return 0.5f * x * (1.0f + erff(x * 0.70710678118654752f)); }

__global__ void __launch_bounds__(NWAVES * 64, 2) skel_fwd(Args args) {
    extern __shared__ __attribute__((aligned(16))) unsigned char lds[];
    Frame F;
    F.lds = (LAS unsigned char*)lds;
    F.tid = threadIdx.x; F.lane = F.tid & 63; F.wave = __builtin_amdgcn_readfirstlane(F.tid >> 6);
    F.G = gridDim.x; { const int bx = blockIdx.x; F.vcu = (F.G % 8 == 0) ? (bx % 8) * (F.G / 8) + bx / 8 : bx; }
    unsigned char* ws = args.ws;
    volatile LAS unsigned* MISC = (volatile LAS unsigned*)(F.lds + MISC_OFF);
    for (int u = F.tid; u < (LDS_BYTES - LDSCTL_OFF) / 4; u += NWAVES * 64) ((LAS unsigned*)(F.lds + LDSCTL_OFF))[u] = 0u;
    __syncthreads();
    XcdBarrier bar; bar.bar = (unsigned*)(ws + WS_CTL) + CW_BAR; bar.x = 0; bar.st = nullptr;
    if (N_LAUNCHES == 1) bar = xcd_barrier_post((unsigned*)(ws + WS_CTL) + CW_BAR, MISC + 8);
    const int lo = args.ph_lo, hi = args.ph_hi;
#define IN(k) (lo <= (k) && (k) < hi)
#define SEAM(k) do { if (IN(k) && IN((k) + 1)) xcd_barrier(bar); } while (0)

    const float* x = args.in[0]; const float* p = args.in[1]; const float* w_in = args.in[2]; const float* lb_param = args.in[3];
    const float* hg_norm_g = args.in[4]; const float* conv_w = args.in[5]; const float* conv_b = args.in[6];
    const float* w_a = args.in[7]; const float* w_b = args.in[8]; const float* w_out = args.in[9];
    const float* ln1_g = args.in[10]; const float* ln1_b = args.in[11]; const float* pk_wq = args.in[12]; const float* pk_sk = args.in[13];
    const float* pk_u = args.in[14]; const float* pk_v = args.in[15]; const float* ln2_g = args.in[16]; const float* ln2_b = args.in[17];
    const float* w_pg = args.in[18]; const float* w_pp = args.in[19];
    float* out = args.out;
    bf16* WinT = (bf16*)(ws + WS_WIN); bf16* WaT = (bf16*)(ws + WS_WA); bf16* WbT = (bf16*)(ws + WS_WB); bf16* WoT = (bf16*)(ws + WS_WO);
    bf16* WpgT = (bf16*)(ws + WS_WPG); bf16* WqT = (bf16*)(ws + WS_WQ); bf16* SKB = (bf16*)(ws + WS_SK); bf16* WppT = (bf16*)(ws + WS_WPP);
    bf16* XB = (bf16*)(ws + WS_XB); bf16* PB = (bf16*)(ws + WS_PB);
    bf16* Zhg = (bf16*)(ws + WS_BIG); bf16* Zcg = (bf16*)(ws + WS_BIG);
    float* ORAW = out;
    bf16* OA = (bf16*)(ws + WS_OA); bf16* YC = (bf16*)(ws + WS_YC);
    float* TMP = out;
    bf16* MERGED = (bf16*)(ws + WS_OA);
    float* Y = (float*)(ws + WS_Y); float* X1 = (float*)(ws + WS_X1); bf16* X1B = (bf16*)(ws + WS_X1B);
    bf16* QP = (bf16*)(ws + WS_QP); bf16* PP = (bf16*)(ws + WS_OA);
    int* IDS = (int*)(ws + WS_IDS); float* GW = (float*)(ws + WS_GW);
    bf16* X2B = (bf16*)(ws + WS_X2B);

    const int gtid = F.vcu * (NWAVES * 64) + F.tid, NT = F.G * NWAVES * 64;
    const int gw = F.vcu * NWAVES + F.wave, NGW = F.G * NWAVES;

    if (IN(0)) {
        LAS float* scr = (LAS float*)(F.lds + F.wave * 16384);
        constexpr int I_IN = (D / 64) * (PROJ_W / 32), I_SQ = (D / 64) * (D / 32), I_Q = (D / 64) * (2048 / 32), I_PP = (PLE / 64) * (D / 32);
        constexpr int NITEMS = I_IN + 4 * I_SQ + I_Q + I_PP;
        for (int it = gw; it < NITEMS; it += NGW) {
            int r = it;
            if (r < I_IN) { p0_transpose_item(w_in, D, PROJ_W, WinT, scr, r, F.lane); continue; } r -= I_IN;
            if (r < I_SQ) { p0_transpose_item(w_a, D, D, WaT, scr, r, F.lane); continue; } r -= I_SQ;
            if (r < I_SQ) { p0_transpose_item(w_b, D, D, WbT, scr, r, F.lane); continue; } r -= I_SQ;
            if (r < I_SQ) { p0_transpose_item(w_out, D, D, WoT, scr, r, F.lane); continue; } r -= I_SQ;
            if (r < I_SQ) { p0_transpose_item(w_pg, D, D, WpgT, scr, r, F.lane); continue; } r -= I_SQ;
            if (r < I_Q) { p0_transpose_item(pk_wq, D, 2048, WqT, scr, r, F.lane); continue; } r -= I_Q;
            p0_transpose_item(w_pp, PLE, D, WppT, scr, r, F.lane);
        }
        convert_rows(x, XB, (size_t)T * D, gtid, NT);
        convert_rows(p, PB, (size_t)T * PLE, gtid, NT);
        convert_rows(pk_sk, SKB, (size_t)PKH * 2 * NKEYS * 128, gtid, NT);
    }
    SEAM(0);
    if (IN(1)) { EpiStore E{Zhg, 4096}; naive_gemm(F, XB, WinT, T, 4096, D, E); }
    SEAM(1);
    if (IN(2)) {
        LAS float* scr = (LAS float*)(F.lds + F.wave * 16384);
        for (int w = F.wave * F.G + F.vcu; w < 64; w += NWAVES * F.G) {
            const int b = w >> 5, h = (w >> 2) & 7, dvb = w & 3, kh = F.lane >> 5, dv = dvb * 32 + (F.lane & 31);
            float S[64];
#pragma unroll
            for (int k = 0; k < 64; ++k) S[k] = 0.f;
            float lbv[2];
#pragma unroll
            for (int j = 0; j < 2; ++j) { const int k = h * 128 + F.lane + 64 * j; lbv[j] = 1.0f / (1.0f + expf(lb_param[1024 + k] - lb_param[k])); }
            LAS float* sf = scr; LAS float* sk = scr + 128; LAS float* sq = scr + 256;
            for (int t = 0; t < SEQ; ++t) {
                const size_t row = (size_t)b * SEQ + t;
                const bf16* zrow = Zhg + row * 4096;
#pragma unroll
                for (int j = 0; j < 2; ++j) { const int k = F.lane + 64 * j;
                    const float q = bf2f(zrow[h * 128 + k]) * 0.08838834764831845f, fz = bf2f(zrow[1024 + h * 128 + k]);
                    const float sg = 1.0f / (1.0f + expf(-fz));
                    sf[k] = lbv[j] + (1.0f - lbv[j]) * sg; sk[k] = (1.0f - lbv[j]) * (1.0f - sg); sq[k] = q; }
                const float v = bf2f(zrow[2048 + h * 128 + dv]);
                LDS_WAIT(); asm volatile("" ::: "memory");
                float o = 0.f;
#pragma unroll
                for (int k4 = 0; k4 < 16; ++k4) {
                    const f32x4 f4 = ((const LAS f32x4*)sf)[kh * 16 + k4], kk4 = ((const LAS f32x4*)sk)[kh * 16 + k4], q4 = ((const LAS f32x4*)sq)[kh * 16 + k4];
                    S[4 * k4 + 0] = f4.x * S[4 * k4 + 0] + kk4.x * v; o += S[4 * k4 + 0] * q4.x;
                    S[4 * k4 + 1] = f4.y * S[4 * k4 + 1] + kk4.y * v; o += S[4 * k4 + 1] * q4.y;
                    S[4 * k4 + 2] = f4.z * S[4 * k4 + 2] + kk4.z * v; o += S[4 * k4 + 2] * q4.z;
                    S[4 * k4 + 3] = f4.w * S[4 * k4 + 3] + kk4.w * v; o += S[4 * k4 + 3] * q4.w;
                }
                o += __shfl_xor(o, 32);
                if (kh == 0) ORAW[row * D + h * 128 + dv] = o;
                LDS_WAIT(); asm volatile("" ::: "memory");
            }
        }
    }
    SEAM(2);
    if (IN(3)) {
        for (int row = gw; row < T; row += NGW) {
            const int c0 = F.lane * 16;
            float o[16];
#pragma unroll
            for (int j = 0; j < 4; ++j) { const f32x4 a = *(const f32x4*)(ORAW + (size_t)row * D + c0 + 4 * j); o[4 * j] = a.x; o[4 * j + 1] = a.y; o[4 * j + 2] = a.z; o[4 * j + 3] = a.w; }
            float ss = 0.f;
#pragma unroll
            for (int j = 0; j < 16; ++j) ss += o[j] * o[j];
            ss += __shfl_xor(ss, 1); ss += __shfl_xor(ss, 2); ss += __shfl_xor(ss, 4);
            const float r = 1.0f / sqrtf(ss * (1.0f / 128.0f) + RMS_EPS);
            float og[16]; { float t0[8], t1[8]; unpack8(*(const v4u*)(Zhg + (size_t)row * 4096 + 3072 + c0), t0); unpack8(*(const v4u*)(Zhg + (size_t)row * 4096 + 3072 + c0 + 8), t1);
#pragma unroll
                for (int j = 0; j < 8; ++j) { og[j] = t0[j]; og[8 + j] = t1[j]; } }
            float res[16];
#pragma unroll
            for (int j = 0; j < 16; ++j) { const float gg = hg_norm_g[c0 + j]; const float sl = og[j] / (1.0f + expf(-og[j])); res[j] = o[j] * r * gg * sl; }
            float r0[8], r1[8];
#pragma unroll
            for (int j = 0; j < 8; ++j) { r0[j] = res[j]; r1[j] = res[8 + j]; }
            *(v4u*)(OA + (size_t)row * D + c0) = pack8(r0); *(v4u*)(OA + (size_t)row * D + c0 + 8) = pack8(r1);
        }
    }
    SEAM(3);
    if (IN(4)) { EpiStore E{Zcg, 5120}; naive_gemm(F, XB, WinT + (size_t)4096 * D, T, 5120, D, E); }
    SEAM(4);
    if (IN(5)) {
        for (int i = gtid; i < T * (D / 8); i += NT) {
            const int row = i / (D / 8), c0 = (i % (D / 8)) * 8, t = row % SEQ;
            float cb[8], u0[8], u1[8], u2[8], a[8], b[8];
            unpack8(*(const v4u*)(Zcg + (size_t)row * 5120 + c0), cb);
            unpack8(*(const v4u*)(Zcg + (size_t)row * 5120 + 1024 + c0), a); unpack8(*(const v4u*)(Zcg + (size_t)row * 5120 + 2048 + c0), b);
#pragma unroll
            for (int j = 0; j < 8; ++j) u2[j] = a[j] * b[j];
            if (t >= 1) { unpack8(*(const v4u*)(Zcg + (size_t)(row - 1) * 5120 + 1024 + c0), a); unpack8(*(const v4u*)(Zcg + (size_t)(row - 1) * 5120 + 2048 + c0), b);
#pragma unroll
                for (int j = 0; j < 8; ++j) u1[j] = a[j] * b[j]; }
            else {
#pragma unroll
                for (int j = 0; j < 8; ++j) u1[j] = 0.f; }
            if (t >= 2) { unpack8(*(const v4u*)(Zcg + (size_t)(row - 2) * 5120 + 1024 + c0), a); unpack8(*(const v4u*)(Zcg + (size_t)(row - 2) * 5120 + 2048 + c0), b);
#pragma unroll
                for (int j = 0; j < 8; ++j) u0[j] = a[j] * b[j]; }
            else {
#pragma unroll
                for (int j = 0; j < 8; ++j) u0[j] = 0.f; }
            float y[8];
#pragma unroll
            for (int j = 0; j < 8; ++j) { const int c = c0 + j; y[j] = cb[j] * (conv_b[c] + conv_w[c] * u0[j] + conv_w[1024 + c] * u1[j] + conv_w[2048 + c] * u2[j]); }
            *(v4u*)(YC + (size_t)row * D + c0) = pack8(y);
        }
    }
    SEAM(5);
    if (IN(6)) { EpiGateA E{TMP, Zcg}; naive_gemm(F, OA, WaT, T, D, D, E); }
    SEAM(6);
    if (IN(7)) { EpiGateB E{TMP, Zcg, MERGED}; naive_gemm(F, YC, WbT, T, D, D, E); }
    SEAM(7);
    if (IN(8)) { EpiResid E{x, Y}; naive_gemm(F, MERGED, WoT, T, D, D, E); }
    SEAM(8);
    if (IN(9)) {
        for (int row = gw; row < T; row += NGW) {
            f32x4 v[4];
#pragma unroll
            for (int j = 0; j < 4; ++j) v[j] = *(const f32x4*)(Y + (size_t)row * D + 4 * F.lane + 256 * j);
            ln_row_store(v, ln1_g, ln1_b, X1 + (size_t)row * D, X1B + (size_t)row * D, F.lane);
        }
    }
    SEAM(9);
    if (IN(10)) {
        { EpiStore E{QP, 2048}; naive_gemm(F, X1B, WqT, T, 2048, D, E); }
        { EpiStore E{PP, D}; naive_gemm(F, PB, WppT, T, D, PLE, E); }
    }
    SEAM(10);
    if (IN(11)) {
        LAS float* sq = (LAS float*)(F.lds + F.wave * 16384);
        const float NEG = -3.0e38f;
        for (int task = gw; task < T * PKH; task += NGW) {
            const int t = task >> 3, h = task & 7, lane = F.lane;
            { const unsigned long long w = *(const unsigned long long*)(QP + (size_t)t * 2048 + h * 256 + lane * 4);
              sq[lane * 4 + 0] = bflo((unsigned)w); sq[lane * 4 + 1] = bfhi((unsigned)w); sq[lane * 4 + 2] = bflo((unsigned)(w >> 32)); sq[lane * 4 + 3] = bfhi((unsigned)(w >> 32)); }
            LDS_WAIT(); asm volatile("" ::: "memory");
            float s[2][2];
#pragma unroll
            for (int pp = 0; pp < 2; ++pp)
#pragma unroll
                for (int j = 0; j < 2; ++j) {
                    const bf16* krow = SKB + ((size_t)((h * 2 + pp) * 128 + lane + 64 * j)) * 128;
                    float a = 0.f;
#pragma unroll 4
                    for (int d8 = 0; d8 < 16; ++d8) { float kv[8]; unpack8(*(const v4u*)(krow + d8 * 8), kv);
                        const f32x4 q0 = *(const LAS f32x4*)(sq + pp * 128 + d8 * 8), q1 = *(const LAS f32x4*)(sq + pp * 128 + d8 * 8 + 4);
                        a += q0.x * kv[0] + q0.y * kv[1] + q0.z * kv[2] + q0.w * kv[3] + q1.x * kv[4] + q1.y * kv[5] + q1.z * kv[6] + q1.w * kv[7]; }
                    s[pp][j] = a;
                }
            float myv[2] = {0.f, 0.f}; int myi[2] = {0, 0};
#pragma unroll
            for (int pp = 0; pp < 2; ++pp) {
                float a0 = s[pp][0], a1 = s[pp][1];
                for (int it = 0; it < TOPK; ++it) {
                    float bv; int bi;
                    if (a0 >= a1) { bv = a0; bi = lane; } else { bv = a1; bi = lane + 64; }
#pragma unroll
                    for (int off = 32; off >= 1; off >>= 1) { const float ov = __shfl_xor(bv, off); const int oi = __shfl_xor(bi, off);
                        if (ov > bv || (ov == bv && oi < bi)) { bv = ov; bi = oi; } }
                    if (lane == it) { myv[pp] = bv; myi[pp] = bi; }
                    if (bi == lane) a0 = NEG; if (bi == lane + 64) a1 = NEG;
                }
            }
            float cv[4];
            { const int a = lane >> 2; const float s1 = __shfl(myv[0], a);
#pragma unroll
              for (int j = 0; j < 4; ++j) { const int b = (lane & 3) * 4 + j; cv[j] = s1 + __shfl(myv[1], b); } }
            float topv = 0.f; int tope = 0;
            for (int it = 0; it < TOPK; ++it) {
                float bv = cv[0]; int bi = lane * 4;
#pragma unroll
                for (int j = 1; j < 4; ++j) if (cv[j] > bv) { bv = cv[j]; bi = lane * 4 + j; }
#pragma unroll
                for (int off = 32; off >= 1; off >>= 1) { const float ov = __shfl_xor(bv, off); const int oi = __shfl_xor(bi, off);
                    if (ov > bv || (ov == bv && oi < bi)) { bv = ov; bi = oi; } }
                const int e = __shfl(myi[0], bi >> 4) * 128 + __shfl(myi[1], bi & 15);
                if (lane == it) { topv = bv; tope = e; }
#pragma unroll
                for (int j = 0; j < 4; ++j) if (bi == lane * 4 + j) cv[j] = NEG;
            }
            const float mx = __shfl(topv, 0);
            float ev = (lane < TOPK) ? expf(topv - mx) : 0.f;
            float sum = ev; sum += __shfl_xor(sum, 1); sum += __shfl_xor(sum, 2); sum += __shfl_xor(sum, 4); sum += __shfl_xor(sum, 8);
            if (lane < TOPK) { IDS[(size_t)t * 128 + h * 16 + lane] = tope; GW[(size_t)t * 128 + h * 16 + lane] = ev / sum; }
            LDS_WAIT(); asm volatile("" ::: "memory");
        }
    }
    SEAM(11);
    if (IN(12)) {
        for (int t = gw; t < T; t += NGW) {
            const int lane = F.lane;
            f32x4 xv[4];
#pragma unroll
            for (int j = 0; j < 4; ++j) xv[j] = *(const f32x4*)(X1 + (size_t)t * D + 4 * lane + 256 * j);
            const int id0 = IDS[(size_t)t * 128 + lane], id1 = IDS[(size_t)t * 128 + 64 + lane];
            const float g0 = GW[(size_t)t * 128 + lane], g1 = GW[(size_t)t * 128 + 64 + lane];
            f32x4 acc[4];
#pragma unroll
            for (int j = 0; j < 4; ++j) acc[j] = (f32x4){0.f, 0.f, 0.f, 0.f};
            for (int i = 0; i < 128; ++i) {
                const int e = __shfl(i < 64 ? id0 : id1, i & 63); const float g = __shfl(i < 64 ? g0 : g1, i & 63);
                const float* ur = pk_u + (size_t)e * D; const float* vr = pk_v + (size_t)e * D;
                float d = 0.f;
#pragma unroll
                for (int j = 0; j < 4; ++j) { const f32x4 u4 = *(const f32x4*)(ur + 4 * lane + 256 * j); d += (u4.x * xv[j].x + u4.y * xv[j].y) + (u4.z * xv[j].z + u4.w * xv[j].w); }
                d = wave_sum(d);
                const float wgt = g * gelu_erf(d);
#pragma unroll
                for (int j = 0; j < 4; ++j) { const f32x4 v4 = *(const f32x4*)(vr + 4 * lane + 256 * j); acc[j] = acc[j] + v4 * wgt; }
            }
#pragma unroll
            for (int j = 0; j < 4; ++j) acc[j] = xv[j] * ALPHA + acc[j];
            ln_row_store(acc, ln2_g, ln2_b, X1 + (size_t)t * D, X2B + (size_t)t * D, lane);
        }
    }
    SEAM(12);
    if (IN(13)) { EpiFinal E{X1, PP, out}; naive_gemm(F, X2B, WpgT, T, D, D, E); }
#undef IN
#undef SEAM
}

extern "C" void kernel_launch(void* const* d_in, const int* in_sizes, int n_in, void* d_out, int out_size, void* d_ws, size_t ws_size, hipStream_t stream) {
    static int grid = 0;
    if (grid == 0) {
        if (n_in != 20 || out_size != T * D || ws_size < WS_END) { fprintf(stderr, "kernel_launch: unexpected shapes (n_in %d out %d ws %zu)\n", n_in, out_size, ws_size); grid = -1; return; }
        int dev = 0, cus = 0;
        if (hipGetDevice(&dev) != hipSuccess || hipDeviceGetAttribute(&cus, hipDeviceAttributeMultiprocessorCount, dev) != hipSuccess) { grid = -1; return; }
        if (hipFuncSetAttribute((const void*)skel_fwd, hipFuncAttributeMaxDynamicSharedMemorySize, LDS_BYTES) != hipSuccess) { fprintf(stderr, "kernel_launch: hipFuncSetAttribute failed\n"); grid = -1; return; }
        (void)hipGetLastError();
        grid = cus;
    }
    if (grid < 0) return;
    if (hipMemsetAsync((char*)d_ws + WS_CTL, 0, CTL_ZERO_BYTES, stream) != hipSuccess) return;
    Args a{};
    for (int i = 0; i < 20; ++i) a.in[i] = (const float*)d_in[i];
    a.out = (float*)d_out; a.ws = (unsigned char*)d_ws;
    if (N_LAUNCHES == 1) {
        a.ph_lo = 0; a.ph_hi = NPHASES; a.li = 0;
        hipLaunchKernelGGL(skel_fwd, dim3(grid), dim3(NWAVES * 64), LDS_BYTES, stream, a);
    } else {
        for (int li = 0; li < NPHASES; ++li) {
            a.ph_lo = li; a.ph_hi = li + 1; a.li = li;
            hipLaunchKernelGGL(skel_fwd, dim3(grid), dim3(NWAVES * 64), LDS_BYTES, stream, a);
        }
    }
}
```

```cpp
#include <hip/hip_runtime.h>
#include <cstdio>
#include <cstdint>
#include <cmath>

#ifndef MK_N_LAUNCHES
#define MK_N_LAUNCHES 1
#endif

constexpr int BATCH = 2, SEQ = 8192, D = 1024, T = BATCH * SEQ;
constexpr int PROJ_W = 9216;
constexpr int NHEAD = 8, DK = 128;
constexpr int PKH = 8, PKD = 256, NKEYS = 128, TOPK = 16;
constexpr int PLE = 256;
constexpr float LN_EPS = 1e-5f, RMS_EPS = 1e-6f;
constexpr float ALPHA = 1.189207115002721f;
constexpr int NWAVES = 8;
constexpr int NPHASES = 14;
constexpr int N_LAUNCHES = MK_N_LAUNCHES;

constexpr size_t MiB = 1u << 20;
constexpr size_t WS_CTL = 0, CTL_ZERO_BYTES = 1 * MiB;
constexpr size_t WS_WIN = 1 * MiB;
constexpr size_t WS_WA = 19 * MiB, WS_WB = 21 * MiB, WS_WO = 23 * MiB, WS_WPG = 25 * MiB;
constexpr size_t WS_WQ = 27 * MiB;
constexpr size_t WS_SK = 31 * MiB;
constexpr size_t WS_WPP = 31 * MiB + 512 * 1024;
constexpr size_t WS_XB = 32 * MiB;
constexpr size_t WS_BIG = 64 * MiB;
constexpr size_t WS_X1 = 128 * MiB;
constexpr size_t WS_X1B = 192 * MiB;
constexpr size_t WS_OA = 224 * MiB;
constexpr size_t WS_PB = 256 * MiB;
constexpr size_t WS_END = 264 * MiB;
constexpr size_t WS_YC = WS_XB;
constexpr size_t WS_IDS = WS_XB;
constexpr size_t WS_GW = WS_XB + 8 * MiB;
constexpr size_t WS_Y = WS_BIG;
constexpr size_t WS_QP = WS_BIG;
constexpr size_t WS_X2B = WS_BIG;
constexpr int CW_BAR = 4096;

constexpr int LDS_BYTES = 147456;
constexpr int RING_BYTES = 131072, LDSCTL_OFF = RING_BYTES, MISC_OFF = LDSCTL_OFF + 320;

#define GAS __attribute__((address_space(1)))
#define LAS __attribute__((address_space(3)))
typedef unsigned short bf16;
typedef unsigned v4u __attribute__((ext_vector_type(4)));
typedef float f32x4 __attribute__((ext_vector_type(4)));
typedef GAS unsigned gu32;
#define RLX_AGENT __ATOMIC_RELAXED, __HIP_MEMORY_SCOPE_AGENT
#define LDS_WAIT() asm volatile("s_waitcnt lgkmcnt(0)" ::: "memory")

__device__ __forceinline__ unsigned f2bf(float f) { unsigned u = __builtin_bit_cast(unsigned, f); return (u + 0x7fffu + ((u >> 16) & 1u)) >> 16; }
__device__ __forceinline__ unsigned pk2(float lo, float hi) { return f2bf(lo) | (f2bf(hi) << 16); }
__device__ __forceinline__ float bf2f(unsigned short h) { return __builtin_bit_cast(float, (unsigned)h << 16); }
__device__ __forceinline__ float bflo(unsigned w) { return __builtin_bit_cast(float, w << 16); }
__device__ __forceinline__ float bfhi(unsigned w) { return __builtin_bit_cast(float, w & 0xffff0000u); }
__device__ __forceinline__ void unpack8(const v4u w, float (&o)[8]) { o[0] = bflo(w.x); o[1] = bfhi(w.x); o[2] = bflo(w.y); o[3] = bfhi(w.y); o[4] = bflo(w.z); o[5] = bfhi(w.z); o[6] = bflo(w.w); o[7] = bfhi(w.w); }
__device__ __forceinline__ v4u pack8(const float (&v)[8]) { v4u w; w.x = pk2(v[0], v[1]); w.y = pk2(v[2], v[3]); w.z = pk2(v[4], v[5]); w.w = pk2(v[6], v[7]); return w; }
__device__ __forceinline__ float sigmoidf_(float x) { return 1.0f / (1.0f + __expf(-x)); }
__device__ __forceinline__ float wave_sum(float v) {
#pragma unroll
    for (int o = 1; o < 64; o <<= 1) v += __shfl_xor(v, o);
    return v;
}

#define XB_TMO      128
#define XB_XCNT(j)  (256  + 64 * (j))
#define XB_XSUB(j)  (1280 + 64 * (j))
#define XB_XGEN(j)  (2304 + 64 * (j))
#define XB_TOP      3328
#define XB_TOPGEN   3392
#define XCD_BAR_WORDS 3456
#define XB_SPIN_CAP (1u << 26)

__device__ __forceinline__ unsigned xb_ld(unsigned* p)              { return __hip_atomic_load(p, __ATOMIC_RELAXED, __HIP_MEMORY_SCOPE_AGENT); }
__device__ __forceinline__ unsigned xb_add(unsigned* p, unsigned v) { return __hip_atomic_fetch_add(p, v, __ATOMIC_RELAXED, __HIP_MEMORY_SCOPE_AGENT); }
__device__ __forceinline__ unsigned xb_xcc_id() { return (unsigned)__builtin_amdgcn_s_getreg((3 << 11) | 20) & 0xFu; }
#define XB_SPIN(cond, bar) do { unsigned _sp = 0; while (cond) { __builtin_amdgcn_s_sleep(1); \
    if ((++_sp & 255u) == 0u) { if (xb_ld(&(bar)[XB_TMO])) break; if (_sp > XB_SPIN_CAP) { atomicAdd(&(bar)[XB_TMO], 1u); break; } } } } while (0)

struct XcdBarrier { unsigned* bar; unsigned x; volatile LAS unsigned* st; };

__device__ __forceinline__ XcdBarrier xcd_barrier_post(unsigned* bar, volatile LAS unsigned* st) {
    XcdBarrier b; b.bar = bar; b.x = xb_xcc_id(); b.st = st;
    if (threadIdx.x == 0) (void)xb_add(&bar[XB_XCNT(b.x)], 1u);
    return b;
}
__device__ __forceinline__ void xcd_barrier_complete(unsigned* bar, unsigned x, unsigned& nloc, unsigned& nx) {
    const unsigned G = gridDim.x * gridDim.y * gridDim.z;
    unsigned sum, cnt, mine, sp = 0u;
    for (;;) {
        sum = 0u; cnt = 0u; mine = 0u;
#pragma unroll
        for (unsigned j = 0; j < 16; ++j) { const unsigned c = xb_ld(&bar[XB_XCNT(j)]); sum += c; cnt += (c > 0u) ? 1u : 0u; mine = (j == x) ? c : mine; }
        if (sum == G) break;
        __builtin_amdgcn_s_sleep(1);
        if ((++sp & 255u) == 0u) { if (xb_ld(&bar[XB_TMO])) break; if (sp > XB_SPIN_CAP) { atomicAdd(&bar[XB_TMO], 1u); break; } }
    }
    nloc = mine > 0u ? mine : 1u; nx = cnt > 0u ? cnt : 1u;
}
__device__ __forceinline__ void xcd_barrier(const XcdBarrier& b) {
    asm volatile("s_waitcnt vmcnt(0)" ::: "memory");
    __syncthreads();
    if (threadIdx.x == 0) {
        unsigned* bar = b.bar;
        __builtin_amdgcn_s_waitcnt(0);
        unsigned nloc = b.st[0], nx = b.st[1];
        if (nloc == 0u) { xcd_barrier_complete(bar, b.x, nloc, nx); b.st[0] = nloc; b.st[1] = nx; }
        const unsigned old = xb_add(&bar[XB_XSUB(b.x)], 1u);
        const unsigned gen = old / nloc;
        if (old + 1u == (gen + 1u) * nloc) {
            __builtin_amdgcn_fence(__ATOMIC_RELEASE, "agent");
            asm volatile("s_waitcnt vmcnt(0)" ::: "memory");
            const unsigned og = xb_add(&bar[XB_TOP], 1u);
            const unsigned tg = og / nx;
            if (og + 1u == (tg + 1u) * nx) xb_add(&bar[XB_TOPGEN], 1u);
            else XB_SPIN(xb_ld(&bar[XB_TOPGEN]) == tg, bar);
            __builtin_amdgcn_fence(__ATOMIC_ACQUIRE, "agent");
            xb_add(&bar[XB_XGEN(b.x)], 1u);
            asm volatile("s_waitcnt vmcnt(0)" ::: "memory");
        } else {
            XB_SPIN(xb_ld(&bar[XB_XGEN(b.x)]) == gen, bar);
            __builtin_amdgcn_fence(__ATOMIC_ACQUIRE, "agent");
            asm volatile("s_waitcnt vmcnt(0)" ::: "memory");
        }
    }
    __syncthreads();
}

struct Frame {
    LAS unsigned char* lds;
    int tid, lane, wave, vcu, G;
};

struct Args {
    const float* in[20]; float* out; unsigned char* ws; int ph_lo, ph_hi, li, pad;
};

__device__ __forceinline__ void p0_transpose_item(const float* W, int K, int N, bf16* WT, LAS float* scr, int item, int lane) {
    const int nblk = N / 32, kb = item / nblk, nb = item % nblk, k0 = 64 * kb, n0 = 32 * nb;
#pragma unroll 8
    for (int i = 0; i < 32; ++i) { const int kk = 2 * i + (lane >> 5); scr[kk * 33 + (lane & 31)] = W[(size_t)(k0 + kk) * N + n0 + (lane & 31)]; }
    LDS_WAIT(); asm volatile("" ::: "memory");
    const int c = lane & 7;
#pragma unroll
    for (int j = 0; j < 4; ++j) { const int n = (lane >> 3) + 8 * j; const LAS float* s = scr + (8 * c) * 33 + n;
        v4u o; o.x = pk2(s[0 * 33], s[1 * 33]); o.y = pk2(s[2 * 33], s[3 * 33]); o.z = pk2(s[4 * 33], s[5 * 33]); o.w = pk2(s[6 * 33], s[7 * 33]);
        *(v4u*)(WT + (size_t)(n0 + n) * K + k0 + 8 * c) = o; }
    LDS_WAIT(); asm volatile("" ::: "memory");
}
__device__ __forceinline__ void convert_rows(const float* src, bf16* dst, size_t n, int gtid, int nthreads) {
    for (size_t i = (size_t)gtid * 8; i < n; i += (size_t)nthreads * 8) {
        const f32x4 a = *(const f32x4*)(src + i), b = *(const f32x4*)(src + i + 4);
        v4u o; o.x = pk2(a.x, a.y); o.y = pk2(a.z, a.w); o.z = pk2(b.x, b.y); o.w = pk2(b.z, b.w);
        *(v4u*)(dst + i) = o;
    }
}

template <class Epi>
__device__ __forceinline__ void naive_gemm(const Frame& F, const bf16* A, const bf16* Bt, int M, int N, int K, const Epi& E) {
    LAS float* As = (LAS float*)F.lds;
    LAS float* Bs = As + 32 * 132;
    const int tid = F.tid, tr = tid >> 4, tc = tid & 15;
    const int ntn = N / 128, nt = (M / 128) * ntn;
    for (int tile = F.vcu; tile < nt; tile += F.G) {
        const int tm = tile / ntn, tn = tile % ntn;
        float acc[4][8];
#pragma unroll
        for (int i = 0; i < 4; ++i)
#pragma unroll
            for (int j = 0; j < 8; ++j) acc[i][j] = 0.f;
        for (int k0 = 0; k0 < K; k0 += 32) {
            { const int r = tid >> 2, kc = (tid & 3) * 8;
              const v4u a = *(const v4u*)(A + (size_t)(tm * 128 + r) * K + k0 + kc);
              const v4u b = *(const v4u*)(Bt + (size_t)(tn * 128 + r) * K + k0 + kc);
              float fa[8], fb[8]; unpack8(a, fa); unpack8(b, fb);
#pragma unroll
              for (int j = 0; j < 8; ++j) { As[(kc + j) * 132 + r] = fa[j]; Bs[(kc + j) * 132 + r] = fb[j]; } }
            __syncthreads();
#pragma unroll 8
            for (int k = 0; k < 32; ++k) {
                const f32x4 a = *(const LAS f32x4*)(As + k * 132 + tr * 4);
                const f32x4 b0 = *(const LAS f32x4*)(Bs + k * 132 + tc * 8), b1 = *(const LAS f32x4*)(Bs + k * 132 + tc * 8 + 4);
#pragma unroll
                for (int i = 0; i < 4; ++i) {
                    acc[i][0] += a[i] * b0.x; acc[i][1] += a[i] * b0.y; acc[i][2] += a[i] * b0.z; acc[i][3] += a[i] * b0.w;
                    acc[i][4] += a[i] * b1.x; acc[i][5] += a[i] * b1.y; acc[i][6] += a[i] * b1.z; acc[i][7] += a[i] * b1.w; }
            }
            __syncthreads();
        }
#pragma unroll
        for (int i = 0; i < 4; ++i) E.row8(tm * 128 + tr * 4 + i, tn * 128 + tc * 8, acc[i]);
    }
}

struct EpiStore { bf16* O; int ldc;
    __device__ __forceinline__ void row8(int r, int c0, const float (&v)[8]) const { *(v4u*)(O + (size_t)r * ldc + c0) = pack8(v); } };
struct EpiGateA { float* TMP; const bf16* Zcg;
    __device__ __forceinline__ void row8(int r, int c0, const float (&v)[8]) const {
        float g[8]; unpack8(*(const v4u*)(Zcg + (size_t)r * 5120 + 3072 + c0), g);
        f32x4 o0, o1; o0.x = sigmoidf_(g[0]) * v[0]; o0.y = sigmoidf_(g[1]) * v[1]; o0.z = sigmoidf_(g[2]) * v[2]; o0.w = sigmoidf_(g[3]) * v[3];
        o1.x = sigmoidf_(g[4]) * v[4]; o1.y = sigmoidf_(g[5]) * v[5]; o1.z = sigmoidf_(g[6]) * v[6]; o1.w = sigmoidf_(g[7]) * v[7];
        *(f32x4*)(TMP + (size_t)r * D + c0) = o0; *(f32x4*)(TMP + (size_t)r * D + c0 + 4) = o1; } };
struct EpiGateB { const float* TMP; const bf16* Zcg; bf16* MERGED;
    __device__ __forceinline__ void row8(int r, int c0, const float (&v)[8]) const {
        float g[8]; unpack8(*(const v4u*)(Zcg + (size_t)r * 5120 + 4096 + c0), g);
        const f32x4 t0 = *(const f32x4*)(TMP + (size_t)r * D + c0), t1 = *(const f32x4*)(TMP + (size_t)r * D + c0 + 4);
        float o[8]; o[0] = t0.x + sigmoidf_(g[0]) * v[0]; o[1] = t0.y + sigmoidf_(g[1]) * v[1]; o[2] = t0.z + sigmoidf_(g[2]) * v[2]; o[3] = t0.w + sigmoidf_(g[3]) * v[3];
        o[4] = t1.x + sigmoidf_(g[4]) * v[4]; o[5] = t1.y + sigmoidf_(g[5]) * v[5]; o[6] = t1.z + sigmoidf_(g[6]) * v[6]; o[7] = t1.w + sigmoidf_(g[7]) * v[7];
        *(v4u*)(MERGED + (size_t)r * D + c0) = pack8(o); } };
struct EpiResid { const float* X; float* Y;
    __device__ __forceinline__ void row8(int r, int c0, const float (&v)[8]) const {
        const f32x4 x0 = *(const f32x4*)(X + (size_t)r * D + c0), x1 = *(const f32x4*)(X + (size_t)r * D + c0 + 4);
        f32x4 o0, o1; o0.x = ALPHA * x0.x + v[0]; o0.y = ALPHA * x0.y + v[1]; o0.z = ALPHA * x0.z + v[2]; o0.w = ALPHA * x0.w + v[3];
        o1.x = ALPHA * x1.x + v[4]; o1.y = ALPHA * x1.y + v[5]; o1.z = ALPHA * x1.z + v[6]; o1.w = ALPHA * x1.w + v[7];
        *(f32x4*)(Y + (size_t)r * D + c0) = o0; *(f32x4*)(Y + (size_t)r * D + c0 + 4) = o1; } };
struct EpiFinal { const float* X2; const bf16* PP; float* OUT;
    __device__ __forceinline__ void row8(int r, int c0, const float (&v)[8]) const {
        float p[8]; unpack8(*(const v4u*)(PP + (size_t)r * D + c0), p);
        const f32x4 x0 = *(const f32x4*)(X2 + (size_t)r * D + c0), x1 = *(const f32x4*)(X2 + (size_t)r * D + c0 + 4);
        f32x4 o0, o1; o0.x = x0.x + sigmoidf_(v[0]) * p[0]; o0.y = x0.y + sigmoidf_(v[1]) * p[1]; o0.z = x0.z + sigmoidf_(v[2]) * p[2]; o0.w = x0.w + sigmoidf_(v[3]) * p[3];
        o1.x = x1.x + sigmoidf_(v[4]) * p[4]; o1.y = x1.y + sigmoidf_(v[5]) * p[5]; o1.z = x1.z + sigmoidf_(v[6]) * p[6]; o1.w = x1.w + sigmoidf_(v[7]) * p[7];
        *(f32x4*)(OUT + (size_t)r * D + c0) = o0; *(f32x4*)(OUT + (size_t)r * D + c0 + 4) = o1; } };

__device__ __forceinline__ void ln_row_store(f32x4 (&v)[4], const float* g, const float* b, float* orow, bf16* obrow, int lane) {
    float s = 0.f;
#pragma unroll
    for (int j = 0; j < 4; ++j) s += (v[j].x + v[j].y) + (v[j].z + v[j].w);
    const float mean = wave_sum(s) * (1.f / D); float s2 = 0.f;
#pragma unroll
    for (int j = 0; j < 4; ++j) { v[j] = v[j] - mean; s2 += (v[j].x * v[j].x + v[j].y * v[j].y) + (v[j].z * v[j].z + v[j].w * v[j].w); }
    const float rstd = 1.f / sqrtf(wave_sum(s2) * (1.f / D) + LN_EPS);
#pragma unroll
    for (int j = 0; j < 4; ++j) {
        const f32x4 gg = *(const f32x4*)(g + 4 * lane + 256 * j), bb = *(const f32x4*)(b + 4 * lane + 256 * j);
        const f32x4 o = v[j] * rstd * gg + bb;
        *(f32x4*)(orow + 4 * lane + 256 * j) = o;
        unsigned long long w = (unsigned long long)pk2(o.x, o.y) | ((unsigned long long)pk2(o.z, o.w) << 32);
        *(unsigned long long*)(obrow + 4 * lane + 256 * j) = w;
    }
}
__device__ __forceinline__ float gelu_erf(float x) { return 0.5f * x * (1.0f + erff(x * 0.70710678118654752f)); }

__global__ void __launch_bounds__(NWAVES * 64, 2) skel_fwd(Args args) {
    extern __shared__ __attribute__((aligned(16))) unsigned char lds[];
    Frame F;
    F.lds = (LAS unsigned char*)lds;
    F.tid = threadIdx.x; F.lane = F.tid & 63; F.wave = __builtin_amdgcn_readfirstlane(F.tid >> 6);
    F.G = gridDim.x; { const int bx = blockIdx.x; F.vcu = (F.G % 8 == 0) ? (bx % 8) * (F.G / 8) + bx / 8 : bx; }
    unsigned char* ws = args.ws;
    volatile LAS unsigned* MISC = (volatile LAS unsigned*)(F.lds + MISC_OFF);
    for (int u = F.tid; u < (LDS_BYTES - LDSCTL_OFF) / 4; u += NWAVES * 64) ((LAS unsigned*)(F.lds + LDSCTL_OFF))[u] = 0u;
    __syncthreads();
    XcdBarrier bar; bar.bar = (unsigned*)(ws + WS_CTL) + CW_BAR; bar.x = 0; bar.st = nullptr;
    if (N_LAUNCHES == 1) bar = xcd_barrier_post((unsigned*)(ws + WS_CTL) + CW_BAR, MISC + 8);
    const int lo = args.ph_lo, hi = args.ph_hi;
#define IN(k) (lo <= (k) && (k) < hi)
#define SEAM(k) do { if (IN(k) && IN((k) + 1)) xcd_barrier(bar); } while (0)

    const float* x = args.in[0]; const float* p = args.in[1]; const float* w_in = args.in[2]; const float* lb_param = args.in[3];
    const float* hg_norm_g = args.in[4]; const float* conv_w = args.in[5]; const float* conv_b = args.in[6];
    const float* w_a = args.in[7]; const float* w_b = args.in[8]; const float* w_out = args.in[9];
    const float* ln1_g = args.in[10]; const float* ln1_b = args.in[11]; const float* pk_wq = args.in[12]; const float* pk_sk = args.in[13];
    const float* pk_u = args.in[14]; const float* pk_v = args.in[15]; const float* ln2_g = args.in[16]; const float* ln2_b = args.in[17];
    const float* w_pg = args.in[18]; const float* w_pp = args.in[19];
    float* out = args.out;
    bf16* WinT = (bf16*)(ws + WS_WIN); bf16* WaT = (bf16*)(ws + WS_WA); bf16* WbT = (bf16*)(ws + WS_WB); bf16* WoT = (bf16*)(ws + WS_WO);
    bf16* WpgT = (bf16*)(ws + WS_WPG); bf16* WqT = (bf16*)(ws + WS_WQ); bf16* SKB = (bf16*)(ws + WS_SK); bf16* WppT = (bf16*)(ws + WS_WPP);
    bf16* XB = (bf16*)(ws + WS_XB); bf16* PB = (bf16*)(ws + WS_PB);
    bf16* Zhg = (bf16*)(ws + WS_BIG); bf16* Zcg = (bf16*)(ws + WS_BIG);
    float* ORAW = out;
    bf16* OA = (bf16*)(ws + WS_OA); bf16* YC = (bf16*)(ws + WS_YC);
    float* TMP = out;
    bf16* MERGED = (bf16*)(ws + WS_OA);
    float* Y = (float*)(ws + WS_Y); float* X1 = (float*)(ws + WS_X1); bf16* X1B = (bf16*)(ws + WS_X1B);
    bf16* QP = (bf16*)(ws + WS_QP); bf16* PP = (bf16*)(ws + WS_OA);
    int* IDS = (int*)(ws + WS_IDS); float* GW = (float*)(ws + WS_GW);
    bf16* X2B = (bf16*)(ws + WS_X2B);

    const int gtid = F.vcu * (NWAVES * 64) + F.tid, NT = F.G * NWAVES * 64;
    const int gw = F.vcu * NWAVES + F.wave, NGW = F.G * NWAVES;

    if (IN(0)) {
        LAS float* scr = (LAS float*)(F.lds + F.wave * 16384);
        constexpr int I_IN = (D / 64) * (PROJ_W / 32), I_SQ = (D / 64) * (D / 32), I_Q = (D / 64) * (2048 / 32), I_PP = (PLE / 64) * (D / 32);
        constexpr int NITEMS = I_IN + 4 * I_SQ + I_Q + I_PP;
        for (int it = gw; it < NITEMS; it += NGW) {
            int r = it;
            if (r < I_IN) { p0_transpose_item(w_in, D, PROJ_W, WinT, scr, r, F.lane); continue; } r -= I_IN;
            if (r < I_SQ) { p0_transpose_item(w_a, D, D, WaT, scr, r, F.lane); continue; } r -= I_SQ;
            if (r < I_SQ) { p0_transpose_item(w_b, D, D, WbT, scr, r, F.lane); continue; } r -= I_SQ;
            if (r < I_SQ) { p0_transpose_item(w_out, D, D, WoT, scr, r, F.lane); continue; } r -= I_SQ;
            if (r < I_SQ) { p0_transpose_item(w_pg, D, D, WpgT, scr, r, F.lane); continue; } r -= I_SQ;
            if (r < I_Q) { p0_transpose_item(pk_wq, D, 2048, WqT, scr, r, F.lane); continue; } r -= I_Q;
            p0_transpose_item(w_pp, PLE, D, WppT, scr, r, F.lane);
        }
        convert_rows(x, XB, (size_t)T * D, gtid, NT);
        convert_rows(p, PB, (size_t)T * PLE, gtid, NT);
        convert_rows(pk_sk, SKB, (size_t)PKH * 2 * NKEYS * 128, gtid, NT);
    }
    SEAM(0);
    if (IN(1)) { EpiStore E{Zhg, 4096}; naive_gemm(F, XB, WinT, T, 4096, D, E); }
    SEAM(1);
    if (IN(2)) {
        LAS float* scr = (LAS float*)(F.lds + F.wave * 16384);
        for (int w = F.wave * F.G + F.vcu; w < 64; w += NWAVES * F.G) {
            const int b = w >> 5, h = (w >> 2) & 7, dvb = w & 3, kh = F.lane >> 5, dv = dvb * 32 + (F.lane & 31);
            float S[64];
#pragma unroll
            for (int k = 0; k < 64; ++k) S[k] = 0.f;
            float lbv[2];
#pragma unroll
            for (int j = 0; j < 2; ++j) { const int k = h * 128 + F.lane + 64 * j; lbv[j] = 1.0f / (1.0f + expf(lb_param[1024 + k] - lb_param[k])); }
            LAS float* sf = scr; LAS float* sk = scr + 128; LAS float* sq = scr + 256;
            for (int t = 0; t < SEQ; ++t) {
                const size_t row = (size_t)b * SEQ + t;
                const bf16* zrow = Zhg + row * 4096;
#pragma unroll
                for (int j = 0; j < 2; ++j) { const int k = F.lane + 64 * j;
                    const float q = bf2f(zrow[h * 128 + k]) * 0.08838834764831845f, fz = bf2f(zrow[1024 + h * 128 + k]);
                    const float sg = 1.0f / (1.0f + expf(-fz));
                    sf[k] = lbv[j] + (1.0f - lbv[j]) * sg; sk[k] = (1.0f - lbv[j]) * (1.0f - sg); sq[k] = q; }
                const float v = bf2f(zrow[2048 + h * 128 + dv]);
                LDS_WAIT(); asm volatile("" ::: "memory");
                float o = 0.f;
#pragma unroll
                for (int k4 = 0; k4 < 16; ++k4) {
                    const f32x4 f4 = ((const LAS f32x4*)sf)[kh * 16 + k4], kk4 = ((const LAS f32x4*)sk)[kh * 16 + k4], q4 = ((const LAS f32x4*)sq)[kh * 16 + k4];
                    S[4 * k4 + 0] = f4.x * S[4 * k4 + 0] + kk4.x * v; o += S[4 * k4 + 0] * q4.x;
                    S[4 * k4 + 1] = f4.y * S[4 * k4 + 1] + kk4.y * v; o += S[4 * k4 + 1] * q4.y;
                    S[4 * k4 + 2] = f4.z * S[4 * k4 + 2] + kk4.z * v; o += S[4 * k4 + 2] * q4.z;
                    S[4 * k4 + 3] = f4.w * S[4 * k4 + 3] + kk4.w * v; o += S[4 * k4 + 3] * q4.w;
                }
                o += __shfl_xor(o, 32);
                if (kh == 0) ORAW[row * D + h * 128 + dv] = o;
                LDS_WAIT(); asm volatile("" ::: "memory");
            }
        }
    }
    SEAM(2);
    if (IN(3)) {
        for (int row = gw; row < T; row += NGW) {
            const int c0 = F.lane * 16;
            float o[16];
#pragma unroll
            for (int j = 0; j < 4; ++j) { const f32x4 a = *(const f32x4*)(ORAW + (size_t)row * D + c0 + 4 * j); o[4 * j] = a.x; o[4 * j + 1] = a.y; o[4 * j + 2] = a.z; o[4 * j + 3] = a.w; }
            float ss = 0.f;
#pragma unroll
            for (int j = 0; j < 16; ++j) ss += o[j] * o[j];
            ss += __shfl_xor(ss, 1); ss += __shfl_xor(ss, 2); ss += __shfl_xor(ss, 4);
            const float r = 1.0f / sqrtf(ss * (1.0f / 128.0f) + RMS_EPS);
            float og[16]; { float t0[8], t1[8]; unpack8(*(const v4u*)(Zhg + (size_t)row * 4096 + 3072 + c0), t0); unpack8(*(const v4u*)(Zhg + (size_t)row * 4096 + 3072 + c0 + 8), t1);
#pragma unroll
                for (int j = 0; j < 8; ++j) { og[j] = t0[j]; og[8 + j] = t1[j]; } }
            float res[16];
#pragma unroll
            for (int j = 0; j < 16; ++j) { const float gg = hg_norm_g[c0 + j]; const float sl = og[j] / (1.0f + expf(-og[j])); res[j] = o[j] * r * gg * sl; }
            float r0[8], r1[8];
#pragma unroll
            for (int j = 0; j < 8; ++j) { r0[j] = res[j]; r1[j] = res[8 + j]; }
            *(v4u*)(OA + (size_t)row * D + c0) = pack8(r0); *(v4u*)(OA + (size_t)row * D + c0 + 8) = pack8(r1);
        }
    }
    SEAM(3);
    if (IN(4)) { EpiStore E{Zcg, 5120}; naive_gemm(F, XB, WinT + (size_t)4096 * D, T, 5120, D, E); }
    SEAM(4);
    if (IN(5)) {
        for (int i = gtid; i < T * (D / 8); i += NT) {
            const int row = i / (D / 8), c0 = (i % (D / 8)) * 8, t = row % SEQ;
            float cb[8], u0[8], u1[8], u2[8], a[8], b[8];
            unpack8(*(const v4u*)(Zcg + (size_t)row * 5120 + c0), cb);
            unpack8(*(const v4u*)(Zcg + (size_t)row * 5120 + 1024 + c0), a); unpack8(*(const v4u*)(Zcg + (size_t)row * 5120 + 2048 + c0), b);
#pragma unroll
            for (int j = 0; j < 8; ++j) u2[j] = a[j] * b[j];
            if (t >= 1) { unpack8(*(const v4u*)(Zcg + (size_t)(row - 1) * 5120 + 1024 + c0), a); unpack8(*(const v4u*)(Zcg + (size_t)(row - 1) * 5120 + 2048 + c0), b);
#pragma unroll
                for (int j = 0; j < 8; ++j) u1[j] = a[j] * b[j]; }
            else {
#pragma unroll
                for (int j = 0; j < 8; ++j) u1[j] = 0.f; }
            if (t >= 2) { unpack8(*(const v4u*)(Zcg + (size_t)(row - 2) * 5120 + 1024 + c0), a); unpack8(*(const v4u*)(Zcg + (size_t)(row - 2) * 5120 + 2048 + c0), b);
#pragma unroll
                for (int j = 0; j < 8; ++j) u0[j] = a[j] * b[j]; }
            else {
#pragma unroll
                for (int j = 0; j < 8; ++j) u0[j] = 0.f; }
            float y[8];
#pragma unroll
            for (int j = 0; j < 8; ++j) { const int c = c0 + j; y[j] = cb[j] * (conv_b[c] + conv_w[c] * u0[j] + conv_w[1024 + c] * u1[j] + conv_w[2048 + c] * u2[j]); }
            *(v4u*)(YC + (size_t)row * D + c0) = pack8(y);
        }
    }
    SEAM(5);
    if (IN(6)) { EpiGateA E{TMP, Zcg}; naive_gemm(F, OA, WaT, T, D, D, E); }
    SEAM(6);
    if (IN(7)) { EpiGateB E{TMP, Zcg, MERGED}; naive_gemm(F, YC, WbT, T, D, D, E); }
    SEAM(7);
    if (IN(8)) { EpiResid E{x, Y}; naive_gemm(F, MERGED, WoT, T, D, D, E); }
    SEAM(8);
    if (IN(9)) {
        for (int row = gw; row < T; row += NGW) {
            f32x4 v[4];
#pragma unroll
            for (int j = 0; j < 4; ++j) v[j] = *(const f32x4*)(Y + (size_t)row * D + 4 * F.lane + 256 * j);
            ln_row_store(v, ln1_g, ln1_b, X1 + (size_t)row * D, X1B + (size_t)row * D, F.lane);
        }
    }
    SEAM(9);
    if (IN(10)) {
        { EpiStore E{QP, 2048}; naive_gemm(F, X1B, WqT, T, 2048, D, E); }
        { EpiStore E{PP, D}; naive_gemm(F, PB, WppT, T, D, PLE, E); }
    }
    SEAM(10);
    if (IN(11)) {
        LAS float* sq = (LAS float*)(F.lds + F.wave * 16384);
        const float NEG = -3.0e38f;
        for (int task = gw; task < T * PKH; task += NGW) {
            const int t = task >> 3, h = task & 7, lane = F.lane;
            { const unsigned long long w = *(const unsigned long long*)(QP + (size_t)t * 2048 + h * 256 + lane * 4);
              sq[lane * 4 + 0] = bflo((unsigned)w); sq[lane * 4 + 1] = bfhi((unsigned)w); sq[lane * 4 + 2] = bflo((unsigned)(w >> 32)); sq[lane * 4 + 3] = bfhi((unsigned)(w >> 32)); }
            LDS_WAIT(); asm volatile("" ::: "memory");
            float s[2][2];
#pragma unroll
            for (int pp = 0; pp < 2; ++pp)
#pragma unroll
                for (int j = 0; j < 2; ++j) {
                    const bf16* krow = SKB + ((size_t)((h * 2 + pp) * 128 + lane + 64 * j)) * 128;
                    float a = 0.f;
#pragma unroll 4
                    for (int d8 = 0; d8 < 16; ++d8) { float kv[8]; unpack8(*(const v4u*)(krow + d8 * 8), kv);
                        const f32x4 q0 = *(const LAS f32x4*)(sq + pp * 128 + d8 * 8), q1 = *(const LAS f32x4*)(sq + pp * 128 + d8 * 8 + 4);
                        a += q0.x * kv[0] + q0.y * kv[1] + q0.z * kv[2] + q0.w * kv[3] + q1.x * kv[4] + q1.y * kv[5] + q1.z * kv[6] + q1.w * kv[7]; }
                    s[pp][j] = a;
                }
            float myv[2] = {0.f, 0.f}; int myi[2] = {0, 0};
#pragma unroll
            for (int pp = 0; pp < 2; ++pp) {
                float a0 = s[pp][0], a1 = s[pp][1];
                for (int it = 0; it < TOPK; ++it) {
                    float bv; int bi;
                    if (a0 >= a1) { bv = a0; bi = lane; } else { bv = a1; bi = lane + 64; }
#pragma unroll
                    for (int off = 32; off >= 1; off >>= 1) { const float ov = __shfl_xor(bv, off); const int oi = __shfl_xor(bi, off);
                        if (ov > bv || (ov == bv && oi < bi)) { bv = ov; bi = oi; } }
                    if (lane == it) { myv[pp] = bv; myi[pp] = bi; }
                    if (bi == lane) a0 = NEG; if (bi == lane + 64) a1 = NEG;
                }
            }
            float cv[4];
            { const int a = lane >> 2; const float s1 = __shfl(myv[0], a);
#pragma unroll
              for (int j = 0; j < 4; ++j) { const int b = (lane & 3) * 4 + j; cv[j] = s1 + __shfl(myv[1], b); } }
            float topv = 0.f; int tope = 0;
            for (int it = 0; it < TOPK; ++it) {
                float bv = cv[0]; int bi = lane * 4;
#pragma unroll
                for (int j = 1; j < 4; ++j) if (cv[j] > bv) { bv = cv[j]; bi = lane * 4 + j; }
#pragma unroll
                for (int off = 32; off >= 1; off >>= 1) { const float ov = __shfl_xor(bv, off); const int oi = __shfl_xor(bi, off);
                    if (ov > bv || (ov == bv && oi < bi)) { bv = ov; bi = oi; } }
                const int e = __shfl(myi[0], bi >> 4) * 128 + __shfl(myi[1], bi & 15);
                if (lane == it) { topv = bv; tope = e; }
#pragma unroll
                for (int j = 0; j < 4; ++j) if (bi == lane * 4 + j) cv[j] = NEG;
            }
            const float mx = __shfl(topv, 0);
            float ev = (lane < TOPK) ? expf(topv - mx) : 0.f;
            float sum = ev; sum += __shfl_xor(sum, 1); sum += __shfl_xor(sum, 2); sum += __shfl_xor(sum, 4); sum += __shfl_xor(sum, 8);
            if (lane < TOPK) { IDS[(size_t)t * 128 + h * 16 + lane] = tope; GW[(size_t)t * 128 + h * 16 + lane] = ev / sum; }
            LDS_WAIT(); asm volatile("" ::: "memory");
        }
    }
    SEAM(11);
    if (IN(12)) {
        for (int t = gw; t < T; t += NGW) {
            const int lane = F.lane;
            f32x4 xv[4];
#pragma unroll
            for (int j = 0; j < 4; ++j) xv[j] = *(const f32x4*)(X1 + (size_t)t * D + 4 * lane + 256 * j);
            const int id0 = IDS[(size_t)t * 128 + lane], id1 = IDS[(size_t)t * 128 + 64 + lane];
            const float g0 = GW[(size_t)t * 128 + lane], g1 = GW[(size_t)t * 128 + 64 + lane];
            f32x4 acc[4];
#pragma unroll
            for (int j = 0; j < 4; ++j) acc[j] = (f32x4){0.f, 0.f, 0.f, 0.f};
            for (int i = 0; i < 128; ++i) {
                const int e = __shfl(i < 64 ? id0 : id1, i & 63); const float g = __shfl(i < 64 ? g0 : g1, i & 63);
                const float* ur = pk_u + (size_t)e * D; const float* vr = pk_v + (size_t)e * D;
                float d = 0.f;
#pragma unroll
                for (int j = 0; j < 4; ++j) { const f32x4 u4 = *(const f32x4*)(ur + 4 * lane + 256 * j); d += (u4.x * xv[j].x + u4.y * xv[j].y) + (u4.z * xv[j].z + u4.w * xv[j].w); }
                d = wave_sum(d);
                const float wgt = g * gelu_erf(d);
#pragma unroll
                for (int j = 0; j < 4; ++j) { const f32x4 v4 = *(const f32x4*)(vr + 4 * lane + 256 * j); acc[j] = acc[j] + v4 * wgt; }
            }
#pragma unroll
            for (int j = 0; j < 4; ++j) acc[j] = xv[j] * ALPHA + acc[j];
            ln_row_store(acc, ln2_g, ln2_b, X1 + (size_t)t * D, X2B + (size_t)t * D, lane);
        }
    }
    SEAM(12);
    if (IN(13)) { EpiFinal E{X1, PP, out}; naive_gemm(F, X2B, WpgT, T, D, D, E); }
#undef IN
#undef SEAM
}

extern "C" void kernel_launch(void* const* d_in, const int* in_sizes, int n_in, void* d_out, int out_size, void* d_ws, size_t ws_size, hipStream_t stream) {
    static int grid = 0;
    if (grid == 0) {
        if (n_in != 20 || out_size != T * D || ws_size < WS_END) { fprintf(stderr, "kernel_launch: unexpected shapes (n_in %d out %d ws %zu)\n", n_in, out_size, ws_size); grid = -1; return; }
        int dev = 0, cus = 0;
        if (hipGetDevice(&dev) != hipSuccess || hipDeviceGetAttribute(&cus, hipDeviceAttributeMultiprocessorCount, dev) != hipSuccess) { grid = -1; return; }
        if (hipFuncSetAttribute((const void*)skel_fwd, hipFuncAttributeMaxDynamicSharedMemorySize, LDS_BYTES) != hipSuccess) { fprintf(stderr, "kernel_launch: hipFuncSetAttribute failed\n"); grid = -1; return; }
        (void)hipGetLastError();
        grid = cus;
    }
    if (grid < 0) return;
    if (hipMemsetAsync((char*)d_ws + WS_CTL, 0, CTL_ZERO_BYTES, stream) != hipSuccess) return;
    Args a{};
    for (int i = 0; i < 20; ++i) a.in[i] = (const float*)d_in[i];
    a.out = (float*)d_out; a.ws = (unsigned char*)d_ws;
    if (N_LAUNCHES == 1) {
        a.ph_lo = 0; a.ph_hi = NPHASES; a.li = 0;
        hipLaunchKernelGGL(skel_fwd, dim3(grid), dim3(NWAVES * 64), LDS_BYTES, stream, a);
    } else {
        for (int li = 0; li < NPHASES; ++li) {
            a.ph_lo = li; a.ph_hi = li + 1; a.li = li;
            hipLaunchKernelGGL(skel_fwd, dim3(grid), dim3(NWAVES * 64), LDS_BYTES, stream, a);
        }
    }
}
```

```cpp
#include <hip/hip_runtime.h>
#include <cstdio>
#include <cstdint>
#include <cmath>

#ifndef MK_N_LAUNCHES
#define MK_N_LAUNCHES 1
#endif

constexpr int BATCH = 2, SEQ = 8192, D = 1024, T = BATCH * SEQ;
constexpr int PROJ_W = 9216;
constexpr int NHEAD = 8, DK = 128;
constexpr int PKH = 8, PKD = 256, NKEYS = 128, TOPK = 16;
constexpr int PLE = 256;
constexpr float LN_EPS = 1e-5f, RMS_EPS = 1e-6f;
constexpr float ALPHA = 1.189207115002721f;
constexpr int NWAVES = 8;
constexpr int NPHASES = 14;
constexpr int N_LAUNCHES = MK_N_LAUNCHES;

constexpr size_t MiB = 1u << 20;
constexpr size_t WS_CTL = 0, CTL_ZERO_BYTES = 1 * MiB;
constexpr size_t WS_WIN = 1 * MiB;
constexpr size_t WS_WA = 19 * MiB, WS_WB = 21 * MiB, WS_WO = 23 * MiB, WS_WPG = 25 * MiB;
constexpr size_t WS_WQ = 27 * MiB;
constexpr size_t WS_SK = 31 * MiB;
constexpr size_t WS_WPP = 31 * MiB + 512 * 1024;
constexpr size_t WS_XB = 32 * MiB;
constexpr size_t WS_BIG = 64 * MiB;
constexpr size_t WS_X1 = 128 * MiB;
constexpr size_t WS_X1B = 192 * MiB;
constexpr size_t WS_OA = 224 * MiB;
constexpr size_t WS_PB = 256 * MiB;
constexpr size_t WS_END = 264 * MiB;
constexpr size_t WS_YC = WS_XB;
constexpr size_t WS_IDS = WS_XB;
constexpr size_t WS_GW = WS_XB + 8 * MiB;
constexpr size_t WS_Y = WS_BIG;
constexpr size_t WS_QP = WS_BIG;
constexpr size_t WS_X2B = WS_BIG;
constexpr int CW_BAR = 4096;

constexpr int LDS_BYTES = 147456;
constexpr int RING_BYTES = 131072, LDSCTL_OFF = RING_BYTES, MISC_OFF = LDSCTL_OFF + 320;

#define GAS __attribute__((address_space(1)))
#define LAS __attribute__((address_space(3)))
typedef unsigned short bf16;
typedef unsigned v4u __attribute__((ext_vector_type(4)));
typedef float f32x4 __attribute__((ext_vector_type(4)));
typedef GAS unsigned gu32;
#define RLX_AGENT __ATOMIC_RELAXED, __HIP_MEMORY_SCOPE_AGENT
#define LDS_WAIT() asm volatile("s_waitcnt lgkmcnt(0)" ::: "memory")

__device__ __forceinline__ unsigned f2bf(float f) { unsigned u = __builtin_bit_cast(unsigned, f); return (u + 0x7fffu + ((u >> 16) & 1u)) >> 16; }
__device__ __forceinline__ unsigned pk2(float lo, float hi) { return f2bf(lo) | (f2bf(hi) << 16); }
__device__ __forceinline__ float bf2f(unsigned short h) { return __builtin_bit_cast(float, (unsigned)h << 16); }
__device__ __forceinline__ float bflo(unsigned w) { return __builtin_bit_cast(float, w << 16); }
__device__ __forceinline__ float bfhi(unsigned w) { return __builtin_bit_cast(float, w & 0xffff0000u); }
__device__ __forceinline__ void unpack8(const v4u w, float (&o)[8]) { o[0] = bflo(w.x); o[1] = bfhi(w.x); o[2] = bflo(w.y); o[3] = bfhi(w.y); o[4] = bflo(w.z); o[5] = bfhi(w.z); o[6] = bflo(w.w); o[7] = bfhi(w.w); }
__device__ __forceinline__ v4u pack8(const float (&v)[8]) { v4u w; w.x = pk2(v[0], v[1]); w.y = pk2(v[2], v[3]); w.z = pk2(v[4], v[5]); w.w = pk2(v[6], v[7]); return w; }
__device__ __forceinline__ float sigmoidf_(float x) { return 1.0f / (1.0f + __expf(-x)); }
__device__ __forceinline__ float wave_sum(float v) {
#pragma unroll
    for (int o = 1; o < 64; o <<= 1) v += __shfl_xor(v, o);
    return v;
}

#define XB_TMO      128
#define XB_XCNT(j)  (256  + 64 * (j))
#define XB_XSUB(j)  (1280 + 64 * (j))
#define XB_XGEN(j)  (2304 + 64 * (j))
#define XB_TOP      3328
#define XB_TOPGEN   3392
#define XCD_BAR_WORDS 3456
#define XB_SPIN_CAP (1u << 26)

__device__ __forceinline__ unsigned xb_ld(unsigned* p)              { return __hip_atomic_load(p, __ATOMIC_RELAXED, __HIP_MEMORY_SCOPE_AGENT); }
__device__ __forceinline__ unsigned xb_add(unsigned* p, unsigned v) { return __hip_atomic_fetch_add(p, v, __ATOMIC_RELAXED, __HIP_MEMORY_SCOPE_AGENT); }
__device__ __forceinline__ unsigned xb_xcc_id() { return (unsigned)__builtin_amdgcn_s_getreg((3 << 11) | 20) & 0xFu; }
#define XB_SPIN(cond, bar) do { unsigned _sp = 0; while (cond) { __builtin_amdgcn_s_sleep(1); \
    if ((++_sp & 255u) == 0u) { if (xb_ld(&(bar)[XB_TMO])) break; if (_sp > XB_SPIN_CAP) { atomicAdd(&(bar)[XB_TMO], 1u); break; } } } } while (0)

struct XcdBarrier { unsigned* bar; unsigned x; volatile LAS unsigned* st; };

__device__ __forceinline__ XcdBarrier xcd_barrier_post(unsigned* bar, volatile LAS unsigned* st) {
    XcdBarrier b; b.bar = bar; b.x = xb_xcc_id(); b.st = st;
    if (threadIdx.x == 0) (void)xb_add(&bar[XB_XCNT(b.x)], 1u);
    return b;
}
__device__ __forceinline__ void xcd_barrier_complete(unsigned* bar, unsigned x, unsigned& nloc, unsigned& nx) {
    const unsigned G = gridDim.x * gridDim.y * gridDim.z;
    unsigned sum, cnt, mine, sp = 0u;
    for (;;) {
        sum = 0u; cnt = 0u; mine = 0u;
#pragma unroll
        for (unsigned j = 0; j < 16; ++j) { const unsigned c = xb_ld(&bar[XB_XCNT(j)]); sum += c; cnt += (c > 0u) ? 1u : 0u; mine = (j == x) ? c : mine; }
        if (sum == G) break;
        __builtin_amdgcn_s_sleep(1);
        if ((++sp & 255u) == 0u) { if (xb_ld(&bar[XB_TMO])) break; if (sp > XB_SPIN_CAP) { atomicAdd(&bar[XB_TMO], 1u); break; } }
    }
    nloc = mine > 0u ? mine : 1u; nx = cnt > 0u ? cnt : 1u;
}
__device__ __forceinline__ void xcd_barrier(const XcdBarrier& b) {
    asm volatile("s_waitcnt vmcnt(0)" ::: "memory");
    __syncthreads();
    if (threadIdx.x == 0) {
        unsigned* bar = b.bar;
        __builtin_amdgcn_s_waitcnt(0);
        unsigned nloc = b.st[0], nx = b.st[1];
        if (nloc == 0u) { xcd_barrier_complete(bar, b.x, nloc, nx); b.st[0] = nloc; b.st[1] = nx; }
        const unsigned old = xb_add(&bar[XB_XSUB(b.x)], 1u);
        const unsigned gen = old / nloc;
        if (old + 1u == (gen + 1u) * nloc) {
            __builtin_amdgcn_fence(__ATOMIC_RELEASE, "agent");
            asm volatile("s_waitcnt vmcnt(0)" ::: "memory");
            const unsigned og = xb_add(&bar[XB_TOP], 1u);
            const unsigned tg = og / nx;
            if (og + 1u == (tg + 1u) * nx) xb_add(&bar[XB_TOPGEN], 1u);
            else XB_SPIN(xb_ld(&bar[XB_TOPGEN]) == tg, bar);
            __builtin_amdgcn_fence(__ATOMIC_ACQUIRE, "agent");
            xb_add(&bar[XB_XGEN(b.x)], 1u);
            asm volatile("s_waitcnt vmcnt(0)" ::: "memory");
        } else {
            XB_SPIN(xb_ld(&bar[XB_XGEN(b.x)]) == gen, bar);
            __builtin_amdgcn_fence(__ATOMIC_ACQUIRE, "agent");
            asm volatile("s_waitcnt vmcnt(0)" ::: "memory");
        }
    }
    __syncthreads();
}

struct Frame {
    LAS unsigned char* lds;
    int tid, lane, wave, vcu, G;
};

struct Args {
    const float* in[20]; float* out; unsigned char* ws; int ph_lo, ph_hi, li, pad;
};

__device__ __forceinline__ void p0_transpose_item(const float* W, int K, int N, bf16* WT, LAS float* scr, int item, int lane) {
    const int nblk = N / 32, kb = item / nblk, nb = item % nblk, k0 = 64 * kb, n0 = 32 * nb;
#pragma unroll 8
    for (int i = 0; i < 32; ++i) { const int kk = 2 * i + (lane >> 5); scr[kk * 33 + (lane & 31)] = W[(size_t)(k0 + kk) * N + n0 + (lane & 31)]; }
    LDS_WAIT(); asm volatile("" ::: "memory");
    const int c = lane & 7;
#pragma unroll
    for (int j = 0; j < 4; ++j) { const int n = (lane >> 3) + 8 * j; const LAS float* s = scr + (8 * c) * 33 + n;
        v4u o; o.x = pk2(s[0 * 33], s[1 * 33]); o.y = pk2(s[2 * 33], s[3 * 33]); o.z = pk2(s[4 * 33], s[5 * 33]); o.w = pk2(s[6 * 33], s[7 * 33]);
        *(v4u*)(WT + (size_t)(n0 + n) * K + k0 + 8 * c) = o; }
    LDS_WAIT(); asm volatile("" ::: "memory");
}
__device__ __forceinline__ void convert_rows(const float* src, bf16* dst, size_t n, int gtid, int nthreads) {
    for (size_t i = (size_t)gtid * 8; i < n; i += (size_t)nthreads * 8) {
        const f32x4 a = *(const f32x4*)(src + i), b = *(const f32x4*)(src + i + 4);
        v4u o; o.x = pk2(a.x, a.y); o.y = pk2(a.z, a.w); o.z = pk2(b.x, b.y); o.w = pk2(b.z, b.w);
        *(v4u*)(dst + i) = o;
    }
}

namespace pg8 {
#define PG8_LAS __attribute__((address_space(3)))
typedef unsigned short bf16_t;
typedef short bf16x8 __attribute__((ext_vector_type(8)));
typedef float f32x4 __attribute__((ext_vector_type(4)));
typedef unsigned u32x4 __attribute__((ext_vector_type(4)));
constexpr int BM = 256, BK = 64, HALF = 128, HTB = HALF * BK * 2  , STAGE_BYTES = 8 * HTB, NXCD = 8, WGM = 8;

__host__ __device__ __forceinline__ int lds_byte(int r, int c) { const int st = (r >> 4) * 2 + (c >> 5), rr = r & 15, cc = c & 31, ob = rr * 64 + cc * 2; return st * 1024 + (ob ^ (((ob >> 9) & 1) << 5)); }
__host__ __device__ __forceinline__ void stage_rc(int b, int& R, int& C) { const int st = b / 1024, sb = b % 1024, swz = sb ^ (((sb >> 9) & 1) << 5); R = (st >> 1) * 16 + swz / 64; C = (st & 1) * 32 + (swz % 64) / 2; }
__host__ __device__ __forceinline__ int perm32(int rho) { const int n = rho >> 4, i = rho & 15; return 8 * (i >> 2) + 4 * n + (i & 3); }

struct Unit { int pm, pn; };
struct Gemm { const bf16_t* A; const bf16_t* Bt; int M, N, K; };

struct StaticOrder {
    int nM, nN, nwg, G, c;
    __host__ __device__ void init(int M, int N, int G_, int c_) { nM = M / BM; nN = N / BM; nwg = nM * nN; G = G_; c = c_; }
    __host__ __device__ bool next(int i, Unit& u) const {
        const long L = (long)i * G + c; if (L >= nwg) return false;
        int wgid = (int)L; { const int q = nwg / NXCD, r = nwg % NXCD, xcd = wgid % NXCD, off = wgid / NXCD; wgid = (xcd < r ? xcd * (q + 1) : r * (q + 1) + (xcd - r) * q) + off; }
        const int nig = WGM * nN, gid = wgid / nig, fm = gid * WGM, gsz = (nM - fm) < WGM ? (nM - fm) : WGM;
        u.pm = fm + ((wgid % nig) % gsz); u.pn = (wgid % nig) / gsz; return true;
    }
    __device__ __forceinline__ void a_ready(const Unit&) const {}
    __device__ __forceinline__ void done(const Unit&) const {}
};

__device__ __forceinline__ unsigned cvt_pk_bf16(float lo, float hi) { unsigned r; asm volatile("v_cvt_pk_bf16_f32 %0, %1, %2" : "=v"(r) : "v"(lo), "v"(hi)); return r; }
typedef float f32x2 __attribute__((ext_vector_type(2)));
template <class Epi, class Sched, bool ALIGN_EPI = false, bool SP2 = false>
__device__ __forceinline__ void gemm_phase(PG8_LAS unsigned char* lds, const Gemm g, const Sched& S, const Epi& E) {
    const int tid = threadIdx.x, wid = __builtin_amdgcn_readfirstlane(tid >> 6), lane = tid & 63, wr = wid >> 2, wc = wid & 3, fr = lane & 15, fq = lane >> 4;
    const int K = g.K, nt = K / BK;
    unsigned voffA[2], voffB[2];
#pragma unroll
    for (int i = 0; i < 2; ++i) { int R, C; stage_rc(tid * 16 + i * 8192, R, C); const int Rb = Epi::PERM ? ((R & ~31) + perm32(R & 31)) : R;
        voffA[i] = (unsigned)(R * K + C) * 2u; voffB[i] = (unsigned)(Rb * K + C) * 2u; }
    const size_t kstep = (size_t)(BK * 2);
    const size_t hstep = (size_t)HALF * K * 2;
    const size_t tstep = 2 * hstep;
    const unsigned ldsw = (unsigned)wid * 1024u;
    const int aoff = lds_byte(wr * 64 + fr, fq * 8), boff = lds_byte(wc * 32 + fr, fq * 8);
#define PG8_SA(b, h) (((b) * 2 + (h)) * HTB)
#define PG8_SB(b, h) ((4 + (b) * 2 + (h)) * HTB)
#define PG8_STAGE(bufoff, gbase, voff) do { _Pragma("unroll") for (int _i = 0; _i < 2; ++_i) \
        __builtin_amdgcn_global_load_lds((const unsigned*)((const char*)(gbase) + (voff)[_i]), (PG8_LAS unsigned*)(lds + (bufoff) + ldsw + _i * 8192), 16, 0, 0); } while (0)
#define PG8_LDA(dst, b, h) do { _Pragma("unroll") for (int m = 0; m < 4; ++m) _Pragma("unroll") for (int k = 0; k < 2; ++k) dst[m][k] = *(const PG8_LAS bf16x8*)(lds + PG8_SA(b, h) + aoff + m * 2048 + k * 1024); } while (0)
#define PG8_LDB(dst, b, h) do { _Pragma("unroll") for (int n = 0; n < 2; ++n) _Pragma("unroll") for (int k = 0; k < 2; ++k) dst[n][k] = *(const PG8_LAS bf16x8*)(lds + PG8_SB(b, h) + boff + n * 2048 + k * 1024); } while (0)
#define PG8_MMA(ai, bj, At, Bt) do { __builtin_amdgcn_s_setprio(1); _Pragma("unroll") for (int m = 0; m < 4; ++m) _Pragma("unroll") for (int n = 0; n < 2; ++n) _Pragma("unroll") for (int k = 0; k < 2; ++k) \
        acc[ai][bj][m][n] = __builtin_amdgcn_mfma_f32_16x16x32_bf16(Bt[n][k], At[m][k], acc[ai][bj][m][n], 0, 0, 0); __builtin_amdgcn_s_setprio(0); } while (0)
#define PG8_WAIT_V(n) asm volatile("s_waitcnt vmcnt(" #n ")" ::: "memory")
#define PG8_WAIT_L(n) asm volatile("s_waitcnt lgkmcnt(" #n ")" ::: "memory")
#define PG8_BAR __builtin_amdgcn_s_barrier()
#define PG8_SCHED __builtin_amdgcn_sched_barrier(0)
    Unit cur, nxt; int ui = 0;
    if (!S.next(0, cur)) return;
    f32x4 acc[2][2][4][2];
#pragma unroll
    for (int a = 0; a < 2; ++a)
#pragma unroll
        for (int b = 0; b < 2; ++b)
#pragma unroll
            for (int m = 0; m < 4; ++m)
#pragma unroll
                for (int n = 0; n < 2; ++n) acc[a][b][m][n] = (f32x4){0.f, 0.f, 0.f, 0.f};
    bf16x8 At[4][2], B0[2][2], B1[2][2];
    const char* cA = (const char*)g.A + (size_t)cur.pm * tstep; const char* cB = (const char*)g.Bt + (size_t)cur.pn * tstep;
    S.a_ready(cur);
    if constexpr (SP2) {
        PG8_STAGE(PG8_SB(0, 0), cB, voffB); PG8_STAGE(PG8_SB(0, 1), cB + hstep, voffB); PG8_STAGE(PG8_SA(0, 0), cA, voffA); PG8_STAGE(PG8_SA(0, 1), cA + hstep, voffA);
        if (wr == 1) PG8_BAR;
        PG8_WAIT_V(2); PG8_BAR;
        PG8_STAGE(PG8_SB(1, 0), cB + kstep, voffB); PG8_STAGE(PG8_SA(1, 0), cA + kstep, voffA); PG8_STAGE(PG8_SB(1, 1), cB + hstep + kstep, voffB);
        PG8_WAIT_V(6); PG8_BAR;
    } else {
        PG8_STAGE(PG8_SB(0, 0), cB, voffB); PG8_STAGE(PG8_SA(0, 0), cA, voffA); PG8_STAGE(PG8_SB(0, 1), cB + hstep, voffB); PG8_STAGE(PG8_SA(0, 1), cA + hstep, voffA);
        if (wr == 1) PG8_BAR;
        PG8_WAIT_V(4); PG8_BAR;
        PG8_STAGE(PG8_SB(1, 0), cB + kstep, voffB); PG8_STAGE(PG8_SA(1, 0), cA + kstep, voffA); PG8_STAGE(PG8_SB(1, 1), cB + hstep + kstep, voffB);
        PG8_WAIT_V(6); PG8_BAR;
    }
    for (;;) {
        const bool has_next = S.next(ui + 1, nxt);
        const char* nA = has_next ? (const char*)g.A + (size_t)nxt.pm * tstep : cA; const char* nB = has_next ? (const char*)g.Bt + (size_t)nxt.pn * tstep : cB;
        for (int t = 0; t < nt; t += 2) {
            const bool last = (t == nt - 2);
            const char* a1 = cA + (size_t)(t + 1) * kstep;
            const char* a2 = last ? nA : cA + (size_t)(t + 2) * kstep; const char* b2 = last ? nB : cB + (size_t)(t + 2) * kstep;
            const char* a3 = a2 + kstep; const char* b3 = b2 + kstep;
            if (last && has_next) S.a_ready(nxt);
            if constexpr (SP2) {
            PG8_LDB(B0, 0, 0); PG8_LDB(B1, 0, 1); PG8_SCHED; PG8_LDA(At, 0, 0); PG8_STAGE(PG8_SA(1, 1), a1 + hstep, voffA);
            PG8_WAIT_V(8); PG8_WAIT_L(0); PG8_BAR; PG8_MMA(0, 0, At, B0); PG8_MMA(0, 1, At, B1); PG8_BAR; PG8_SCHED;
            PG8_LDA(At, 0, 1); PG8_STAGE(PG8_SB(0, 0), b2, voffB); PG8_STAGE(PG8_SB(0, 1), b2 + hstep, voffB); PG8_STAGE(PG8_SA(0, 0), a2, voffA);
            PG8_WAIT_V(8); PG8_WAIT_L(0); PG8_BAR; PG8_MMA(1, 0, At, B0); PG8_MMA(1, 1, At, B1); PG8_BAR; PG8_SCHED;
            PG8_LDB(B0, 1, 0); PG8_LDB(B1, 1, 1); PG8_SCHED; PG8_LDA(At, 1, 0); PG8_STAGE(PG8_SA(0, 1), a2 + hstep, voffA);
            PG8_WAIT_V(8); PG8_WAIT_L(0); PG8_BAR; PG8_MMA(0, 0, At, B0); PG8_MMA(0, 1, At, B1); PG8_BAR; PG8_SCHED;
            PG8_LDA(At, 1, 1); PG8_STAGE(PG8_SB(1, 0), b3, voffB); PG8_STAGE(PG8_SB(1, 1), b3 + hstep, voffB); PG8_STAGE(PG8_SA(1, 0), a3, voffA);
            PG8_WAIT_V(8); PG8_WAIT_L(0); PG8_BAR; PG8_MMA(1, 0, At, B0); PG8_MMA(1, 1, At, B1); PG8_BAR; PG8_SCHED;
            } else {
            PG8_LDB(B0, 0, 0); PG8_SCHED; PG8_LDA(At, 0, 0); PG8_STAGE(PG8_SA(1, 1), a1 + hstep, voffA);
            PG8_WAIT_L(8); PG8_BAR; PG8_WAIT_L(0); PG8_MMA(0, 0, At, B0); PG8_BAR; PG8_SCHED;
            PG8_LDB(B1, 0, 1); PG8_STAGE(PG8_SB(0, 0), b2, voffB);
            PG8_BAR; PG8_WAIT_L(0); PG8_MMA(0, 1, At, B1); PG8_BAR;
            PG8_LDA(At, 0, 1); PG8_STAGE(PG8_SA(0, 0), a2, voffA);
            PG8_BAR; PG8_WAIT_L(0); PG8_MMA(1, 0, At, B0); PG8_BAR; PG8_SCHED;
            PG8_STAGE(PG8_SB(0, 1), b2 + hstep, voffB);
            PG8_WAIT_V(6); PG8_BAR; PG8_MMA(1, 1, At, B1); PG8_BAR;
            PG8_LDB(B0, 1, 0); PG8_SCHED; PG8_LDA(At, 1, 0); PG8_STAGE(PG8_SA(0, 1), a2 + hstep, voffA);
            PG8_WAIT_L(8); PG8_BAR; PG8_WAIT_L(0); PG8_MMA(0, 0, At, B0); PG8_BAR; PG8_SCHED;
            PG8_LDB(B1, 1, 1); PG8_STAGE(PG8_SB(1, 0), b3, voffB);
            PG8_BAR; PG8_WAIT_L(0); PG8_MMA(0, 1, At, B1); PG8_BAR;
            PG8_LDA(At, 1, 1); PG8_STAGE(PG8_SA(1, 0), a3, voffA);
            PG8_BAR; PG8_WAIT_L(0); PG8_MMA(1, 0, At, B0); PG8_BAR; PG8_SCHED;
            PG8_STAGE(PG8_SB(1, 1), b3 + hstep, voffB);
            PG8_WAIT_V(6); PG8_BAR; PG8_MMA(1, 1, At, B1); PG8_BAR;
            }
        }
        if constexpr (ALIGN_EPI) { if (wr == 0) PG8_BAR; }
        if constexpr (!Epi::AFTER_DRAIN) { E(acc, cur, wr, wc, fr, fq); S.done(cur); }
        if (!has_next) break;
#pragma unroll
        for (int a = 0; a < 2; ++a)
#pragma unroll
            for (int b = 0; b < 2; ++b)
#pragma unroll
                for (int m = 0; m < 4; ++m)
#pragma unroll
                    for (int n = 0; n < 2; ++n) acc[a][b][m][n] = (f32x4){0.f, 0.f, 0.f, 0.f};
        cur = nxt; cA = nA; cB = nB; ++ui;
        if constexpr (ALIGN_EPI) { if (wr == 1) PG8_BAR; }
    }
    PG8_WAIT_V(0);
    if constexpr (!ALIGN_EPI) { if (wr == 0) PG8_BAR; }
    PG8_BAR;
    if constexpr (Epi::AFTER_DRAIN) { E.fused(acc, cur, wr, wc, fr, fq, lds, wid, lane); S.done(cur); }
#undef PG8_SA
#undef PG8_SB
#undef PG8_STAGE
#undef PG8_LDA
#undef PG8_LDB
#undef PG8_MMA
#undef PG8_WAIT_V
#undef PG8_WAIT_L
#undef PG8_BAR
#undef PG8_SCHED
}

template <class Fn> struct EpiRow8 {
    static constexpr bool PERM = true, AFTER_DRAIN = false; Fn f;
    __device__ __forceinline__ void operator()(const f32x4 (&acc)[2][2][4][2], const Unit& u, int wr, int wc, int fr, int fq) const {
#pragma unroll
        for (int ai = 0; ai < 2; ++ai)
#pragma unroll
            for (int m = 0; m < 4; ++m) { const int r = u.pm * BM + ai * HALF + wr * 64 + m * 16 + fr;
#pragma unroll
                for (int bj = 0; bj < 2; ++bj) { const int c0 = u.pn * BM + bj * HALF + wc * 32 + 8 * fq;
                    const f32x4 v0 = acc[ai][bj][m][0], v1 = acc[ai][bj][m][1];
                    const float v[8] = {v0[0], v0[1], v0[2], v0[3], v1[0], v1[1], v1[2], v1[3]};
                    f.row8(r, c0, v); } }
    }
};
}

template <class Epi>
__device__ __forceinline__ void naive_gemm(const Frame& F, const bf16* A, const bf16* Bt, int M, int N, int K, const Epi& E) {
    LAS float* As = (LAS float*)F.lds;
    LAS float* Bs = As + 32 * 132;
    const int tid = F.tid, tr = tid >> 4, tc = tid & 15;
    const int ntn = N / 128, nt = (M / 128) * ntn;
    for (int tile = F.vcu; tile < nt; tile += F.G) {
        const int tm = tile / ntn, tn = tile % ntn;
        float acc[4][8];
#pragma unroll
        for (int i = 0; i < 4; ++i)
#pragma unroll
            for (int j = 0; j < 8; ++j) acc[i][j] = 0.f;
        for (int k0 = 0; k0 < K; k0 += 32) {
            { const int r = tid >> 2, kc = (tid & 3) * 8;
              const v4u a = *(const v4u*)(A + (size_t)(tm * 128 + r) * K + k0 + kc);
              const v4u b = *(const v4u*)(Bt + (size_t)(tn * 128 + r) * K + k0 + kc);
              float fa[8], fb[8]; unpack8(a, fa); unpack8(b, fb);
#pragma unroll
              for (int j = 0; j < 8; ++j) { As[(kc + j) * 132 + r] = fa[j]; Bs[(kc + j) * 132 + r] = fb[j]; } }
            __syncthreads();
#pragma unroll 8
            for (int k = 0; k < 32; ++k) {
                const f32x4 a = *(const LAS f32x4*)(As + k * 132 + tr * 4);
                const f32x4 b0 = *(const LAS f32x4*)(Bs + k * 132 + tc * 8), b1 = *(const LAS f32x4*)(Bs + k * 132 + tc * 8 + 4);
#pragma unroll
                for (int i = 0; i < 4; ++i) {
                    acc[i][0] += a[i] * b0.x; acc[i][1] += a[i] * b0.y; acc[i][2] += a[i] * b0.z; acc[i][3] += a[i] * b0.w;
                    acc[i][4] += a[i] * b1.x; acc[i][5] += a[i] * b1.y; acc[i][6] += a[i] * b1.z; acc[i][7] += a[i] * b1.w; }
            }
            __syncthreads();
        }
#pragma unroll
        for (int i = 0; i < 4; ++i) E.row8(tm * 128 + tr * 4 + i, tn * 128 + tc * 8, acc[i]);
    }
}

struct EpiStore { bf16* O; int ldc;
    __device__ __forceinline__ void row8(int r, int c0, const float (&v)[8]) const { *(v4u*)(O + (size_t)r * ldc + c0) = pack8(v); } };
struct EpiGateA { float* TMP; const bf16* Zcg;
    __device__ __forceinline__ void row8(int r, int c0, const float (&v)[8]) const {
        float g[8]; unpack8(*(const v4u*)(Zcg + (size_t)r * 5120 + 3072 + c0), g);
        f32x4 o0, o1; o0.x = sigmoidf_(g[0]) * v[0]; o0.y = sigmoidf_(g[1]) * v[1]; o0.z = sigmoidf_(g[2]) * v[2]; o0.w = sigmoidf_(g[3]) * v[3];
        o1.x = sigmoidf_(g[4]) * v[4]; o1.y = sigmoidf_(g[5]) * v[5]; o1.z = sigmoidf_(g[6]) * v[6]; o1.w = sigmoidf_(g[7]) * v[7];
        *(f32x4*)(TMP + (size_t)r * D + c0) = o0; *(f32x4*)(TMP + (size_t)r * D + c0 + 4) = o1; } };
struct EpiGateB { const float* TMP; const bf16* Zcg; bf16* MERGED;
    __device__ __forceinline__ void row8(int r, int c0, const float (&v)[8]) const {
        float g[8]; unpack8(*(const v4u*)(Zcg + (size_t)r * 5120 + 4096 + c0), g);
        const f32x4 t0 = *(const f32x4*)(TMP + (size_t)r * D + c0), t1 = *(const f32x4*)(TMP + (size_t)r * D + c0 + 4);
        float o[8]; o[0] = t0.x + sigmoidf_(g[0]) * v[0]; o[1] = t0.y + sigmoidf_(g[1]) * v[1]; o[2] = t0.z + sigmoidf_(g[2]) * v[2]; o[3] = t0.w + sigmoidf_(g[3]) * v[3];
        o[4] = t1.x + sigmoidf_(g[4]) * v[4]; o[5] = t1.y + sigmoidf_(g[5]) * v[5]; o[6] = t1.z + sigmoidf_(g[6]) * v[6]; o[7] = t1.w + sigmoidf_(g[7]) * v[7];
        *(v4u*)(MERGED + (size_t)r * D + c0) = pack8(o); } };
struct EpiResid { const float* X; float* Y;
    __device__ __forceinline__ void row8(int r, int c0, const float (&v)[8]) const {
        const f32x4 x0 = *(const f32x4*)(X + (size_t)r * D + c0), x1 = *(const f32x4*)(X + (size_t)r * D + c0 + 4);
        f32x4 o0, o1; o0.x = ALPHA * x0.x + v[0]; o0.y = ALPHA * x0.y + v[1]; o0.z = ALPHA * x0.z + v[2]; o0.w = ALPHA * x0.w + v[3];
        o1.x = ALPHA * x1.x + v[4]; o1.y = ALPHA * x1.y + v[5]; o1.z = ALPHA * x1.z + v[6]; o1.w = ALPHA * x1.w + v[7];
        *(f32x4*)(Y + (size_t)r * D + c0) = o0; *(f32x4*)(Y + (size_t)r * D + c0 + 4) = o1; } };
struct EpiFinal { const float* X2; const bf16* PP; float* OUT;
    __device__ __forceinline__ void row8(int r, int c0, const float (&v)[8]) const {
        float p[8]; unpack8(*(const v4u*)(PP + (size_t)r * D + c0), p);
        const f32x4 x0 = *(const f32x4*)(X2 + (size_t)r * D + c0), x1 = *(const f32x4*)(X2 + (size_t)r * D + c0 + 4);
        f32x4 o0, o1; o0.x = x0.x + sigmoidf_(v[0]) * p[0]; o0.y = x0.y + sigmoidf_(v[1]) * p[1]; o0.z = x0.z + sigmoidf_(v[2]) * p[2]; o0.w = x0.w + sigmoidf_(v[3]) * p[3];
        o1.x = x1.x + sigmoidf_(v[4]) * p[4]; o1.y = x1.y + sigmoidf_(v[5]) * p[5]; o1.z = x1.z + sigmoidf_(v[6]) * p[6]; o1.w = x1.w + sigmoidf_(v[7]) * p[7];
        *(f32x4*)(OUT + (size_t)r * D + c0) = o0; *(f32x4*)(OUT + (size_t)r * D + c0 + 4) = o1; } };


template <class Fn>
__device__ __forceinline__ void run_gemm(const Frame& F, const bf16* A, const bf16* Bt, int M, int N, int K, const Fn& fn) {
    pg8::Gemm g{A, Bt, M, N, K}; pg8::StaticOrder S; S.init(M, N, F.G, (int)blockIdx.x);
    pg8::EpiRow8<Fn> E{fn};
    pg8::gemm_phase<pg8::EpiRow8<Fn>, pg8::StaticOrder, true, true>(F.lds, g, S, E);
}

__device__ __forceinline__ void ln_row_store(f32x4 (&v)[4], const float* g, const float* b, float* orow, bf16* obrow, int lane) {
    float s = 0.f;
#pragma unroll
    for (int j = 0; j < 4; ++j) s += (v[j].x + v[j].y) + (v[j].z + v[j].w);
    const float mean = wave_sum(s) * (1.f / D); float s2 = 0.f;
#pragma unroll
    for (int j = 0; j < 4; ++j) { v[j] = v[j] - mean; s2 += (v[j].x * v[j].x + v[j].y * v[j].y) + (v[j].z * v[j].z + v[j].w * v[j].w); }
    const float rstd = 1.f / sqrtf(wave_sum(s2) * (1.f / D) + LN_EPS);
#pragma unroll
    for (int j = 0; j < 4; ++j) {
        const f32x4 gg = *(const f32x4*)(g + 4 * lane + 256 * j), bb = *(const f32x4*)(b + 4 * lane + 256 * j);
        const f32x4 o = v[j] * rstd * gg + bb;
        *(f32x4*)(orow + 4 * lane + 256 * j) = o;
        unsigned long long w = (unsigned long long)pk2(o.x, o.y) | ((unsigned long long)pk2(o.z, o.w) << 32);
        *(unsigned long long*)(obrow + 4 * lane + 256 * j) = w;
    }
}
__device__ __forceinline__ float gelu_erf(float x) { return 0.5f * x * (1.0f + erff(x * 0.70710678118654752f)); }

__global__ void __launch_bounds__(NWAVES * 64, 2) skel_fwd(Args args) {
    extern __shared__ __attribute__((aligned(16))) unsigned char lds[];
    Frame F;
    F.lds = (LAS unsigned char*)lds;
    F.tid = threadIdx.x; F.lane = F.tid & 63; F.wave = __builtin_amdgcn_readfirstlane(F.tid >> 6);
    F.G = gridDim.x; { const int bx = blockIdx.x; F.vcu = (F.G % 8 == 0) ? (bx % 8) * (F.G / 8) + bx / 8 : bx; }
    unsigned char* ws = args.ws;
    volatile LAS unsigned* MISC = (volatile LAS unsigned*)(F.lds + MISC_OFF);
    for (int u = F.tid; u < (LDS_BYTES - LDSCTL_OFF) / 4; u += NWAVES * 64) ((LAS unsigned*)(F.lds + LDSCTL_OFF))[u] = 0u;
    __syncthreads();
    XcdBarrier bar; bar.bar = (unsigned*)(ws + WS_CTL) + CW_BAR; bar.x = 0; bar.st = nullptr;
    if (N_LAUNCHES == 1) bar = xcd_barrier_post((unsigned*)(ws + WS_CTL) + CW_BAR, MISC + 8);
    const int lo = args.ph_lo, hi = args.ph_hi;
#define IN(k) (lo <= (k) && (k) < hi)
#define SEAM(k) do { if (IN(k) && IN((k) + 1)) xcd_barrier(bar); } while (0)

    const float* x = args.in[0]; const float* p = args.in[1]; const float* w_in = args.in[2]; const float* lb_param = args.in[3];
    const float* hg_norm_g = args.in[4]; const float* conv_w = args.in[5]; const float* conv_b = args.in[6];
    const float* w_a = args.in[7]; const float* w_b = args.in[8]; const float* w_out = args.in[9];
    const float* ln1_g = args.in[10]; const float* ln1_b = args.in[11]; const float* pk_wq = args.in[12]; const float* pk_sk = args.in[13];
    const float* pk_u = args.in[14]; const float* pk_v = args.in[15]; const float* ln2_g = args.in[16]; const float* ln2_b = args.in[17];
    const float* w_pg = args.in[18]; const float* w_pp = args.in[19];
    float* out = args.out;
    bf16* WinT = (bf16*)(ws + WS_WIN); bf16* WaT = (bf16*)(ws + WS_WA); bf16* WbT = (bf16*)(ws + WS_WB); bf16* WoT = (bf16*)(ws + WS_WO);
    bf16* WpgT = (bf16*)(ws + WS_WPG); bf16* WqT = (bf16*)(ws + WS_WQ); bf16* SKB = (bf16*)(ws + WS_SK); bf16* WppT = (bf16*)(ws + WS_WPP);
    bf16* XB = (bf16*)(ws + WS_XB); bf16* PB = (bf16*)(ws + WS_PB);
    bf16* Zhg = (bf16*)(ws + WS_BIG); bf16* Zcg = (bf16*)(ws + WS_BIG);
    float* ORAW = out;
    bf16* OA = (bf16*)(ws + WS_OA); bf16* YC = (bf16*)(ws + WS_YC);
    float* TMP = out;
    bf16* MERGED = (bf16*)(ws + WS_OA);
    float* Y = (float*)(ws + WS_Y); float* X1 = (float*)(ws + WS_X1); bf16* X1B = (bf16*)(ws + WS_X1B);
    bf16* QP = (bf16*)(ws + WS_QP); bf16* PP = (bf16*)(ws + WS_OA);
    int* IDS = (int*)(ws + WS_IDS); float* GW = (float*)(ws + WS_GW);
    bf16* X2B = (bf16*)(ws + WS_X2B);

    const int gtid = F.vcu * (NWAVES * 64) + F.tid, NT = F.G * NWAVES * 64;
    const int gw = F.vcu * NWAVES + F.wave, NGW = F.G * NWAVES;

    if (IN(0)) {
        LAS float* scr = (LAS float*)(F.lds + F.wave * 16384);
        constexpr int I_IN = (D / 64) * (PROJ_W / 32), I_SQ = (D / 64) * (D / 32), I_Q = (D / 64) * (2048 / 32), I_PP = (PLE / 64) * (D / 32);
        constexpr int NITEMS = I_IN + 4 * I_SQ + I_Q + I_PP;
        for (int it = gw; it < NITEMS; it += NGW) {
            int r = it;
            if (r < I_IN) { p0_transpose_item(w_in, D, PROJ_W, WinT, scr, r, F.lane); continue; } r -= I_IN;
            if (r < I_SQ) { p0_transpose_item(w_a, D, D, WaT, scr, r, F.lane); continue; } r -= I_SQ;
            if (r < I_SQ) { p0_transpose_item(w_b, D, D, WbT, scr, r, F.lane); continue; } r -= I_SQ;
            if (r < I_SQ) { p0_transpose_item(w_out, D, D, WoT, scr, r, F.lane); continue; } r -= I_SQ;
            if (r < I_SQ) { p0_transpose_item(w_pg, D, D, WpgT, scr, r, F.lane); continue; } r -= I_SQ;
            if (r < I_Q) { p0_transpose_item(pk_wq, D, 2048, WqT, scr, r, F.lane); continue; } r -= I_Q;
            p0_transpose_item(w_pp, PLE, D, WppT, scr, r, F.lane);
        }
        convert_rows(x, XB, (size_t)T * D, gtid, NT);
        convert_rows(p, PB, (size_t)T * PLE, gtid, NT);
        convert_rows(pk_sk, SKB, (size_t)PKH * 2 * NKEYS * 128, gtid, NT);
    }
    SEAM(0);
    if (IN(1)) { EpiStore E{Zhg, 4096}; run_gemm(F, XB, WinT, T, 4096, D, E); }
    SEAM(1);
    if (IN(2)) {
        LAS float* scr = (LAS float*)(F.lds + F.wave * 16384);
        for (int w = F.wave * F.G + F.vcu; w < 64; w += NWAVES * F.G) {
            const int b = w >> 5, h = (w >> 2) & 7, dvb = w & 3, kh = F.lane >> 5, dv = dvb * 32 + (F.lane & 31);
            float S[64];
#pragma unroll
            for (int k = 0; k < 64; ++k) S[k] = 0.f;
            float lbv[2];
#pragma unroll
            for (int j = 0; j < 2; ++j) { const int k = h * 128 + F.lane + 64 * j; lbv[j] = 1.0f / (1.0f + expf(lb_param[1024 + k] - lb_param[k])); }
            LAS float* sf = scr; LAS float* sk = scr + 128; LAS float* sq = scr + 256;
            for (int t = 0; t < SEQ; ++t) {
                const size_t row = (size_t)b * SEQ + t;
                const bf16* zrow = Zhg + row * 4096;
#pragma unroll
                for (int j = 0; j < 2; ++j) { const int k = F.lane + 64 * j;
                    const float q = bf2f(zrow[h * 128 + k]) * 0.08838834764831845f, fz = bf2f(zrow[1024 + h * 128 + k]);
                    const float sg = 1.0f / (1.0f + expf(-fz));
                    sf[k] = lbv[j] + (1.0f - lbv[j]) * sg; sk[k] = (1.0f - lbv[j]) * (1.0f - sg); sq[k] = q; }
                const float v = bf2f(zrow[2048 + h * 128 + dv]);
                LDS_WAIT(); asm volatile("" ::: "memory");
                float o = 0.f;
#pragma unroll
                for (int k4 = 0; k4 < 16; ++k4) {
                    const f32x4 f4 = ((const LAS f32x4*)sf)[kh * 16 + k4], kk4 = ((const LAS f32x4*)sk)[kh * 16 + k4], q4 = ((const LAS f32x4*)sq)[kh * 16 + k4];
                    S[4 * k4 + 0] = f4.x * S[4 * k4 + 0] + kk4.x * v; o += S[4 * k4 + 0] * q4.x;
                    S[4 * k4 + 1] = f4.y * S[4 * k4 + 1] + kk4.y * v; o += S[4 * k4 + 1] * q4.y;
                    S[4 * k4 + 2] = f4.z * S[4 * k4 + 2] + kk4.z * v; o += S[4 * k4 + 2] * q4.z;
                    S[4 * k4 + 3] = f4.w * S[4 * k4 + 3] + kk4.w * v; o += S[4 * k4 + 3] * q4.w;
                }
                o += __shfl_xor(o, 32);
                if (kh == 0) ORAW[row * D + h * 128 + dv] = o;
                LDS_WAIT(); asm volatile("" ::: "memory");
            }
        }
    }
    SEAM(2);
    if (IN(3)) {
        for (int row = gw; row < T; row += NGW) {
            const int c0 = F.lane * 16;
            float o[16];
#pragma unroll
            for (int j = 0; j < 4; ++j) { const f32x4 a = *(const f32x4*)(ORAW + (size_t)row * D + c0 + 4 * j); o[4 * j] = a.x; o[4 * j + 1] = a.y; o[4 * j + 2] = a.z; o[4 * j + 3] = a.w; }
            float ss = 0.f;
#pragma unroll
            for (int j = 0; j < 16; ++j) ss += o[j] * o[j];
            ss += __shfl_xor(ss, 1); ss += __shfl_xor(ss, 2); ss += __shfl_xor(ss, 4);
            const float r = 1.0f / sqrtf(ss * (1.0f / 128.0f) + RMS_EPS);
            float og[16]; { float t0[8], t1[8]; unpack8(*(const v4u*)(Zhg + (size_t)row * 4096 + 3072 + c0), t0); unpack8(*(const v4u*)(Zhg + (size_t)row * 4096 + 3072 + c0 + 8), t1);
#pragma unroll
                for (int j = 0; j < 8; ++j) { og[j] = t0[j]; og[8 + j] = t1[j]; } }
            float res[16];
#pragma unroll
            for (int j = 0; j < 16; ++j) { const float gg = hg_norm_g[c0 + j]; const float sl = og[j] / (1.0f + expf(-og[j])); res[j] = o[j] * r * gg * sl; }
            float r0[8], r1[8];
#pragma unroll
            for (int j = 0; j < 8; ++j) { r0[j] = res[j]; r1[j] = res[8 + j]; }
            *(v4u*)(OA + (size_t)row * D + c0) = pack8(r0); *(v4u*)(OA + (size_t)row * D + c0 + 8) = pack8(r1);
        }
    }
    SEAM(3);
    if (IN(4)) { EpiStore E{Zcg, 5120}; run_gemm(F, XB, WinT + (size_t)4096 * D, T, 5120, D, E); }
    SEAM(4);
    if (IN(5)) {
        for (int i = gtid; i < T * (D / 8); i += NT) {
            const int row = i / (D / 8), c0 = (i % (D / 8)) * 8, t = row % SEQ;
            float cb[8], u0[8], u1[8], u2[8], a[8], b[8];
            unpack8(*(const v4u*)(Zcg + (size_t)row * 5120 + c0), cb);
            unpack8(*(const v4u*)(Zcg + (size_t)row * 5120 + 1024 + c0), a); unpack8(*(const v4u*)(Zcg + (size_t)row * 5120 + 2048 + c0), b);
#pragma unroll
            for (int j = 0; j < 8; ++j) u2[j] = a[j] * b[j];
            if (t >= 1) { unpack8(*(const v4u*)(Zcg + (size_t)(row - 1) * 5120 + 1024 + c0), a); unpack8(*(const v4u*)(Zcg + (size_t)(row - 1) * 5120 + 2048 + c0), b);
#pragma unroll
                for (int j = 0; j < 8; ++j) u1[j] = a[j] * b[j]; }
            else {
#pragma unroll
                for (int j = 0; j < 8; ++j) u1[j] = 0.f; }
            if (t >= 2) { unpack8(*(const v4u*)(Zcg + (size_t)(row - 2) * 5120 + 1024 + c0), a); unpack8(*(const v4u*)(Zcg + (size_t)(row - 2) * 5120 + 2048 + c0), b);
#pragma unroll
                for (int j = 0; j < 8; ++j) u0[j] = a[j] * b[j]; }
            else {
#pragma unroll
                for (int j = 0; j < 8; ++j) u0[j] = 0.f; }
            float y[8];
#pragma unroll
            for (int j = 0; j < 8; ++j) { const int c = c0 + j; y[j] = cb[j] * (conv_b[c] + conv_w[c] * u0[j] + conv_w[1024 + c] * u1[j] + conv_w[2048 + c] * u2[j]); }
            *(v4u*)(YC + (size_t)row * D + c0) = pack8(y);
        }
    }
    SEAM(5);
    if (IN(6)) { EpiGateA E{TMP, Zcg}; run_gemm(F, OA, WaT, T, D, D, E); }
    SEAM(6);
    if (IN(7)) { EpiGateB E{TMP, Zcg, MERGED}; run_gemm(F, YC, WbT, T, D, D, E); }
    SEAM(7);
    if (IN(8)) { EpiResid E{x, Y}; run_gemm(F, MERGED, WoT, T, D, D, E); }
    SEAM(8);
    if (IN(9)) {
        for (int row = gw; row < T; row += NGW) {
            f32x4 v[4];
#pragma unroll
            for (int j = 0; j < 4; ++j) v[j] = *(const f32x4*)(Y + (size_t)row * D + 4 * F.lane + 256 * j);
            ln_row_store(v, ln1_g, ln1_b, X1 + (size_t)row * D, X1B + (size_t)row * D, F.lane);
        }
    }
    SEAM(9);
    if (IN(10)) {
        { EpiStore E{QP, 2048}; run_gemm(F, X1B, WqT, T, 2048, D, E); }
        { EpiStore E{PP, D}; run_gemm(F, PB, WppT, T, D, PLE, E); }
    }
    SEAM(10);
    if (IN(11)) {
        LAS float* sq = (LAS float*)(F.lds + F.wave * 16384);
        const float NEG = -3.0e38f;
        for (int task = gw; task < T * PKH; task += NGW) {
            const int t = task >> 3, h = task & 7, lane = F.lane;
            { const unsigned long long w = *(const unsigned long long*)(QP + (size_t)t * 2048 + h * 256 + lane * 4);
              sq[lane * 4 + 0] = bflo((unsigned)w); sq[lane * 4 + 1] = bfhi((unsigned)w); sq[lane * 4 + 2] = bflo((unsigned)(w >> 32)); sq[lane * 4 + 3] = bfhi((unsigned)(w >> 32)); }
            LDS_WAIT(); asm volatile("" ::: "memory");
            float s[2][2];
#pragma unroll
            for (int pp = 0; pp < 2; ++pp)
#pragma unroll
                for (int j = 0; j < 2; ++j) {
                    const bf16* krow = SKB + ((size_t)((h * 2 + pp) * 128 + lane + 64 * j)) * 128;
                    float a = 0.f;
#pragma unroll 4
                    for (int d8 = 0; d8 < 16; ++d8) { float kv[8]; unpack8(*(const v4u*)(krow + d8 * 8), kv);
                        const f32x4 q0 = *(const LAS f32x4*)(sq + pp * 128 + d8 * 8), q1 = *(const LAS f32x4*)(sq + pp * 128 + d8 * 8 + 4);
                        a += q0.x * kv[0] + q0.y * kv[1] + q0.z * kv[2] + q0.w * kv[3] + q1.x * kv[4] + q1.y * kv[5] + q1.z * kv[6] + q1.w * kv[7]; }
                    s[pp][j] = a;
                }
            float myv[2] = {0.f, 0.f}; int myi[2] = {0, 0};
#pragma unroll
            for (int pp = 0; pp < 2; ++pp) {
                float a0 = s[pp][0], a1 = s[pp][1];
                for (int it = 0; it < TOPK; ++it) {
                    float bv; int bi;
                    if (a0 >= a1) { bv = a0; bi = lane; } else { bv = a1; bi = lane + 64; }
#pragma unroll
                    for (int off = 32; off >= 1; off >>= 1) { const float ov = __shfl_xor(bv, off); const int oi = __shfl_xor(bi, off);
                        if (ov > bv || (ov == bv && oi < bi)) { bv = ov; bi = oi; } }
                    if (lane == it) { myv[pp] = bv; myi[pp] = bi; }
                    if (bi == lane) a0 = NEG; if (bi == lane + 64) a1 = NEG;
                }
            }
            float cv[4];
            { const int a = lane >> 2; const float s1 = __shfl(myv[0], a);
#pragma unroll
              for (int j = 0; j < 4; ++j) { const int b = (lane & 3) * 4 + j; cv[j] = s1 + __shfl(myv[1], b); } }
            float topv = 0.f; int tope = 0;
            for (int it = 0; it < TOPK; ++it) {
                float bv = cv[0]; int bi = lane * 4;
#pragma unroll
                for (int j = 1; j < 4; ++j) if (cv[j] > bv) { bv = cv[j]; bi = lane * 4 + j; }
#pragma unroll
                for (int off = 32; off >= 1; off >>= 1) { const float ov = __shfl_xor(bv, off); const int oi = __shfl_xor(bi, off);
                    if (ov > bv || (ov == bv && oi < bi)) { bv = ov; bi = oi; } }
                const int e = __shfl(myi[0], bi >> 4) * 128 + __shfl(myi[1], bi & 15);
                if (lane == it) { topv = bv; tope = e; }
#pragma unroll
                for (int j = 0; j < 4; ++j) if (bi == lane * 4 + j) cv[j] = NEG;
            }
            const float mx = __shfl(topv, 0);
            float ev = (lane < TOPK) ? expf(topv - mx) : 0.f;
            float sum = ev; sum += __shfl_xor(sum, 1); sum += __shfl_xor(sum, 2); sum += __shfl_xor(sum, 4); sum += __shfl_xor(sum, 8);
            if (lane < TOPK) { IDS[(size_t)t * 128 + h * 16 + lane] = tope; GW[(size_t)t * 128 + h * 16 + lane] = ev / sum; }
            LDS_WAIT(); asm volatile("" ::: "memory");
        }
    }
    SEAM(11);
    if (IN(12)) {
        for (int t = gw; t < T; t += NGW) {
            const int lane = F.lane;
            f32x4 xv[4];
#pragma unroll
            for (int j = 0; j < 4; ++j) xv[j] = *(const f32x4*)(X1 + (size_t)t * D + 4 * lane + 256 * j);
            const int id0 = IDS[(size_t)t * 128 + lane], id1 = IDS[(size_t)t * 128 + 64 + lane];
            const float g0 = GW[(size_t)t * 128 + lane], g1 = GW[(size_t)t * 128 + 64 + lane];
            f32x4 acc[4];
#pragma unroll
            for (int j = 0; j < 4; ++j) acc[j] = (f32x4){0.f, 0.f, 0.f, 0.f};
            for (int i = 0; i < 128; ++i) {
                const int e = __shfl(i < 64 ? id0 : id1, i & 63); const float g = __shfl(i < 64 ? g0 : g1, i & 63);
                const float* ur = pk_u + (size_t)e * D; const float* vr = pk_v + (size_t)e * D;
                float d = 0.f;
#pragma unroll
                for (int j = 0; j < 4; ++j) { const f32x4 u4 = *(const f32x4*)(ur + 4 * lane + 256 * j); d += (u4.x * xv[j].x + u4.y * xv[j].y) + (u4.z * xv[j].z + u4.w * xv[j].w); }
                d = wave_sum(d);
                const float wgt = g * gelu_erf(d);
#pragma unroll
                for (int j = 0; j < 4; ++j) { const f32x4 v4 = *(const f32x4*)(vr + 4 * lane + 256 * j); acc[j] = acc[j] + v4 * wgt; }
            }
#pragma unroll
            for (int j = 0; j < 4; ++j) acc[j] = xv[j] * ALPHA + acc[j];
            ln_row_store(acc, ln2_g, ln2_b, X1 + (size_t)t * D, X2B + (size_t)t * D, lane);
        }
    }
    SEAM(12);
    if (IN(13)) { EpiFinal E{X1, PP, out}; run_gemm(F, X2B, WpgT, T, D, D, E); }
#undef IN
#undef SEAM
}

extern "C" void kernel_launch(void* const* d_in, const int* in_sizes, int n_in, void* d_out, int out_size, void* d_ws, size_t ws_size, hipStream_t stream) {
    static int grid = 0;
    if (grid == 0) {
        if (n_in != 20 || out_size != T * D || ws_size < WS_END) { fprintf(stderr, "kernel_launch: unexpected shapes (n_in %d out %d ws %zu)\n", n_in, out_size, ws_size); grid = -1; return; }
        int dev = 0, cus = 0;
        if (hipGetDevice(&dev) != hipSuccess || hipDeviceGetAttribute(&cus, hipDeviceAttributeMultiprocessorCount, dev) != hipSuccess) { grid = -1; return; }
        if (hipFuncSetAttribute((const void*)skel_fwd, hipFuncAttributeMaxDynamicSharedMemorySize, LDS_BYTES) != hipSuccess) { fprintf(stderr, "kernel_launch: hipFuncSetAttribute failed\n"); grid = -1; return; }
        (void)hipGetLastError();
        grid = cus;
    }
    if (grid < 0) return;
    if (hipMemsetAsync((char*)d_ws + WS_CTL, 0, CTL_ZERO_BYTES, stream) != hipSuccess) return;
    Args a{};
    for (int i = 0; i < 20; ++i) a.in[i] = (const float*)d_in[i];
    a.out = (float*)d_out; a.ws = (unsigned char*)d_ws;
    if (N_LAUNCHES == 1) {
        a.ph_lo = 0; a.ph_hi = NPHASES; a.li = 0;
        hipLaunchKernelGGL(skel_fwd, dim3(grid), dim3(NWAVES * 64), LDS_BYTES, stream, a);
    } else {
        for (int li = 0; li < NPHASES; ++li) {
            a.ph_lo = li; a.ph_hi = li + 1; a.li = li;
            hipLaunchKernelGGL(skel_fwd, dim3(grid), dim3(NWAVES * 64), LDS_BYTES, stream, a);
        }
    }
}
```

```cpp
#include <hip/hip_runtime.h>
#include <cstdio>
#include <cstdint>
#include <cmath>

#ifndef MK_N_LAUNCHES
#define MK_N_LAUNCHES 1
#endif

constexpr int BATCH = 2, SEQ = 8192, D = 1024, T = BATCH * SEQ;
constexpr int PROJ_W = 9216;
constexpr int NHEAD = 8, DK = 128;
constexpr int PKH = 8, PKD = 256, NKEYS = 128, TOPK = 16;
constexpr int PLE = 256;
constexpr float LN_EPS = 1e-5f, RMS_EPS = 1e-6f;
constexpr float ALPHA = 1.189207115002721f;
constexpr int NWAVES = 8;
constexpr int NPHASES = 16;
constexpr int N_LAUNCHES = MK_N_LAUNCHES;

constexpr size_t MiB = 1u << 20;
constexpr size_t WS_CTL = 0, CTL_ZERO_BYTES = 1 * MiB;
constexpr size_t WS_WIN = 1 * MiB;
constexpr size_t WS_WA = 19 * MiB, WS_WB = 21 * MiB, WS_WO = 23 * MiB, WS_WPG = 25 * MiB;
constexpr size_t WS_WQ = 27 * MiB;
constexpr size_t WS_SK = 31 * MiB;
constexpr size_t WS_WPP = 31 * MiB + 512 * 1024;
constexpr size_t WS_XB = 32 * MiB;
constexpr size_t WS_BIG = 64 * MiB;
constexpr size_t WS_VT = 160 * MiB;
constexpr size_t WS_KET = 192 * MiB;
constexpr size_t WS_X1 = 128 * MiB;
constexpr size_t WS_X1B = 192 * MiB;
constexpr size_t WS_OA = 224 * MiB;
constexpr size_t WS_PB = 256 * MiB;
constexpr size_t WS_DEC = 264 * MiB;
constexpr size_t WS_END = 265 * MiB;
constexpr size_t WS_YC = WS_XB;
constexpr size_t WS_IDS = WS_XB;
constexpr size_t WS_GW = WS_XB + 8 * MiB;
constexpr size_t WS_Y = WS_BIG;
constexpr size_t WS_QP = WS_BIG;
constexpr size_t WS_X2B = WS_BIG;
constexpr int CW_BAR = 4096;

constexpr int LDS_BYTES = 147456;
constexpr int RING_BYTES = 131072, LDSCTL_OFF = RING_BYTES, MISC_OFF = LDSCTL_OFF + 320;

#define GAS __attribute__((address_space(1)))
#define LAS __attribute__((address_space(3)))
typedef unsigned short bf16;
typedef unsigned v4u __attribute__((ext_vector_type(4)));
typedef float f32x4 __attribute__((ext_vector_type(4)));
typedef short bf16x8 __attribute__((ext_vector_type(8)));
typedef GAS unsigned gu32;
#define RLX_AGENT __ATOMIC_RELAXED, __HIP_MEMORY_SCOPE_AGENT
#define LDS_WAIT() asm volatile("s_waitcnt lgkmcnt(0)" ::: "memory")

__device__ __forceinline__ unsigned f2bf(float f) { unsigned u = __builtin_bit_cast(unsigned, f); return (u + 0x7fffu + ((u >> 16) & 1u)) >> 16; }
__device__ __forceinline__ unsigned pk2(float lo, float hi) { return f2bf(lo) | (f2bf(hi) << 16); }
__device__ __forceinline__ float bf2f(unsigned short h) { return __builtin_bit_cast(float, (unsigned)h << 16); }
__device__ __forceinline__ float bflo(unsigned w) { return __builtin_bit_cast(float, w << 16); }
__device__ __forceinline__ float bfhi(unsigned w) { return __builtin_bit_cast(float, w & 0xffff0000u); }
__device__ __forceinline__ void unpack8(const v4u w, float (&o)[8]) { o[0] = bflo(w.x); o[1] = bfhi(w.x); o[2] = bflo(w.y); o[3] = bfhi(w.y); o[4] = bflo(w.z); o[5] = bfhi(w.z); o[6] = bflo(w.w); o[7] = bfhi(w.w); }
__device__ __forceinline__ v4u pack8(const float (&v)[8]) { v4u w; w.x = pk2(v[0], v[1]); w.y = pk2(v[2], v[3]); w.z = pk2(v[4], v[5]); w.w = pk2(v[6], v[7]); return w; }
__device__ __forceinline__ float sigmoidf_(float x) { return 1.0f / (1.0f + __expf(-x)); }
__device__ __forceinline__ float wave_sum(float v) {
#pragma unroll
    for (int o = 1; o < 64; o <<= 1) v += __shfl_xor(v, o);
    return v;
}

#define XB_TMO      128
#define XB_XCNT(j)  (256  + 64 * (j))
#define XB_XSUB(j)  (1280 + 64 * (j))
#define XB_XGEN(j)  (2304 + 64 * (j))
#define XB_TOP      3328
#define XB_TOPGEN   3392
#define XCD_BAR_WORDS 3456
#define XB_SPIN_CAP (1u << 26)

__device__ __forceinline__ unsigned xb_ld(unsigned* p)              { return __hip_atomic_load(p, __ATOMIC_RELAXED, __HIP_MEMORY_SCOPE_AGENT); }
__device__ __forceinline__ unsigned xb_add(unsigned* p, unsigned v) { return __hip_atomic_fetch_add(p, v, __ATOMIC_RELAXED, __HIP_MEMORY_SCOPE_AGENT); }
__device__ __forceinline__ unsigned xb_xcc_id() { return (unsigned)__builtin_amdgcn_s_getreg((3 << 11) | 20) & 0xFu; }
#define XB_SPIN(cond, bar) do { unsigned _sp = 0; while (cond) { __builtin_amdgcn_s_sleep(1); \
    if ((++_sp & 255u) == 0u) { if (xb_ld(&(bar)[XB_TMO])) break; if (_sp > XB_SPIN_CAP) { atomicAdd(&(bar)[XB_TMO], 1u); break; } } } } while (0)

struct XcdBarrier { unsigned* bar; unsigned x; volatile LAS unsigned* st; };

__device__ __forceinline__ XcdBarrier xcd_barrier_post(unsigned* bar, volatile LAS unsigned* st) {
    XcdBarrier b; b.bar = bar; b.x = xb_xcc_id(); b.st = st;
    if (threadIdx.x == 0) (void)xb_add(&bar[XB_XCNT(b.x)], 1u);
    return b;
}
__device__ __forceinline__ void xcd_barrier_complete(unsigned* bar, unsigned x, unsigned& nloc, unsigned& nx) {
    const unsigned G = gridDim.x * gridDim.y * gridDim.z;
    unsigned sum, cnt, mine, sp = 0u;
    for (;;) {
        sum = 0u; cnt = 0u; mine = 0u;
#pragma unroll
        for (unsigned j = 0; j < 16; ++j) { const unsigned c = xb_ld(&bar[XB_XCNT(j)]); sum += c; cnt += (c > 0u) ? 1u : 0u; mine = (j == x) ? c : mine; }
        if (sum == G) break;
        __builtin_amdgcn_s_sleep(1);
        if ((++sp & 255u) == 0u) { if (xb_ld(&bar[XB_TMO])) break; if (sp > XB_SPIN_CAP) { atomicAdd(&bar[XB_TMO], 1u); break; } }
    }
    nloc = mine > 0u ? mine : 1u; nx = cnt > 0u ? cnt : 1u;
}
__device__ __forceinline__ void xcd_barrier(const XcdBarrier& b) {
    asm volatile("s_waitcnt vmcnt(0)" ::: "memory");
    __syncthreads();
    if (threadIdx.x == 0) {
        unsigned* bar = b.bar;
        __builtin_amdgcn_s_waitcnt(0);
        unsigned nloc = b.st[0], nx = b.st[1];
        if (nloc == 0u) { xcd_barrier_complete(bar, b.x, nloc, nx); b.st[0] = nloc; b.st[1] = nx; }
        const unsigned old = xb_add(&bar[XB_XSUB(b.x)], 1u);
        const unsigned gen = old / nloc;
        if (old + 1u == (gen + 1u) * nloc) {
            __builtin_amdgcn_fence(__ATOMIC_RELEASE, "agent");
            asm volatile("s_waitcnt vmcnt(0)" ::: "memory");
            const unsigned og = xb_add(&bar[XB_TOP], 1u);
            const unsigned tg = og / nx;
            if (og + 1u == (tg + 1u) * nx) xb_add(&bar[XB_TOPGEN], 1u);
            else XB_SPIN(xb_ld(&bar[XB_TOPGEN]) == tg, bar);
            __builtin_amdgcn_fence(__ATOMIC_ACQUIRE, "agent");
            xb_add(&bar[XB_XGEN(b.x)], 1u);
            asm volatile("s_waitcnt vmcnt(0)" ::: "memory");
        } else {
            XB_SPIN(xb_ld(&bar[XB_XGEN(b.x)]) == gen, bar);
            __builtin_amdgcn_fence(__ATOMIC_ACQUIRE, "agent");
            asm volatile("s_waitcnt vmcnt(0)" ::: "memory");
        }
    }
    __syncthreads();
}

struct Frame {
    LAS unsigned char* lds;
    int tid, lane, wave, vcu, G;
};

struct Args {
    const float* in[20]; float* out; unsigned char* ws; int ph_lo, ph_hi, li, pad;
};

__device__ __forceinline__ void p0_transpose_item(const float* W, int K, int N, bf16* WT, LAS float* scr, int item, int lane) {
    const int nblk = N / 32, kb = item / nblk, nb = item % nblk, k0 = 64 * kb, n0 = 32 * nb;
#pragma unroll 8
    for (int i = 0; i < 32; ++i) { const int kk = 2 * i + (lane >> 5); scr[kk * 33 + (lane & 31)] = W[(size_t)(k0 + kk) * N + n0 + (lane & 31)]; }
    LDS_WAIT(); asm volatile("" ::: "memory");
    const int c = lane & 7;
#pragma unroll
    for (int j = 0; j < 4; ++j) { const int n = (lane >> 3) + 8 * j; const LAS float* s = scr + (8 * c) * 33 + n;
        v4u o; o.x = pk2(s[0 * 33], s[1 * 33]); o.y = pk2(s[2 * 33], s[3 * 33]); o.z = pk2(s[4 * 33], s[5 * 33]); o.w = pk2(s[6 * 33], s[7 * 33]);
        *(v4u*)(WT + (size_t)(n0 + n) * K + k0 + 8 * c) = o; }
    LDS_WAIT(); asm volatile("" ::: "memory");
}
__device__ __forceinline__ void convert_rows(const float* src, bf16* dst, size_t n, int gtid, int nthreads) {
    for (size_t i = (size_t)gtid * 8; i < n; i += (size_t)nthreads * 8) {
        const f32x4 a = *(const f32x4*)(src + i), b = *(const f32x4*)(src + i + 4);
        v4u o; o.x = pk2(a.x, a.y); o.y = pk2(a.z, a.w); o.z = pk2(b.x, b.y); o.w = pk2(b.z, b.w);
        *(v4u*)(dst + i) = o;
    }
}

namespace pg8 {
#define PG8_LAS __attribute__((address_space(3)))
typedef unsigned short bf16_t;
typedef short bf16x8 __attribute__((ext_vector_type(8)));
typedef float f32x4 __attribute__((ext_vector_type(4)));
typedef unsigned u32x4 __attribute__((ext_vector_type(4)));
constexpr int BM = 256, BK = 64, HALF = 128, HTB = HALF * BK * 2  , STAGE_BYTES = 8 * HTB, NXCD = 8, WGM = 8;

__host__ __device__ __forceinline__ int lds_byte(int r, int c) { const int st = (r >> 4) * 2 + (c >> 5), rr = r & 15, cc = c & 31, ob = rr * 64 + cc * 2; return st * 1024 + (ob ^ (((ob >> 9) & 1) << 5)); }
__host__ __device__ __forceinline__ void stage_rc(int b, int& R, int& C) { const int st = b / 1024, sb = b % 1024, swz = sb ^ (((sb >> 9) & 1) << 5); R = (st >> 1) * 16 + swz / 64; C = (st & 1) * 32 + (swz % 64) / 2; }
__host__ __device__ __forceinline__ int perm32(int rho) { const int n = rho >> 4, i = rho & 15; return 8 * (i >> 2) + 4 * n + (i & 3); }

struct Unit { int pm, pn; };
struct Gemm { const bf16_t* A; const bf16_t* Bt; int M, N, K; };

struct StaticOrder {
    int nM, nN, nwg, G, c;
    __host__ __device__ void init(int M, int N, int G_, int c_) { nM = M / BM; nN = N / BM; nwg = nM * nN; G = G_; c = c_; }
    __host__ __device__ bool next(int i, Unit& u) const {
        const long L = (long)i * G + c; if (L >= nwg) return false;
        int wgid = (int)L; { const int q = nwg / NXCD, r = nwg % NXCD, xcd = wgid % NXCD, off = wgid / NXCD; wgid = (xcd < r ? xcd * (q + 1) : r * (q + 1) + (xcd - r) * q) + off; }
        const int nig = WGM * nN, gid = wgid / nig, fm = gid * WGM, gsz = (nM - fm) < WGM ? (nM - fm) : WGM;
        u.pm = fm + ((wgid % nig) % gsz); u.pn = (wgid % nig) / gsz; return true;
    }
    __device__ __forceinline__ void a_ready(const Unit&) const {}
    __device__ __forceinline__ void done(const Unit&) const {}
};

__device__ __forceinline__ unsigned cvt_pk_bf16(float lo, float hi) { unsigned r; asm volatile("v_cvt_pk_bf16_f32 %0, %1, %2" : "=v"(r) : "v"(lo), "v"(hi)); return r; }
typedef float f32x2 __attribute__((ext_vector_type(2)));
template <class Epi, class Sched, bool ALIGN_EPI = false, bool SP2 = false>
__device__ __forceinline__ void gemm_phase(PG8_LAS unsigned char* lds, const Gemm g, const Sched& S, const Epi& E) {
    const int tid = threadIdx.x, wid = __builtin_amdgcn_readfirstlane(tid >> 6), lane = tid & 63, wr = wid >> 2, wc = wid & 3, fr = lane & 15, fq = lane >> 4;
    const int K = g.K, nt = K / BK;
    unsigned voffA[2], voffB[2];
#pragma unroll
    for (int i = 0; i < 2; ++i) { int R, C; stage_rc(tid * 16 + i * 8192, R, C); const int Rb = Epi::PERM ? ((R & ~31) + perm32(R & 31)) : R;
        voffA[i] = (unsigned)(R * K + C) * 2u; voffB[i] = (unsigned)(Rb * K + C) * 2u; }
    const size_t kstep = (size_t)(BK * 2);
    const size_t hstep = (size_t)HALF * K * 2;
    const size_t tstep = 2 * hstep;
    const unsigned ldsw = (unsigned)wid * 1024u;
    const int aoff = lds_byte(wr * 64 + fr, fq * 8), boff = lds_byte(wc * 32 + fr, fq * 8);
#define PG8_SA(b, h) (((b) * 2 + (h)) * HTB)
#define PG8_SB(b, h) ((4 + (b) * 2 + (h)) * HTB)
#define PG8_STAGE(bufoff, gbase, voff) do { _Pragma("unroll") for (int _i = 0; _i < 2; ++_i) \
        __builtin_amdgcn_global_load_lds((const unsigned*)((const char*)(gbase) + (voff)[_i]), (PG8_LAS unsigned*)(lds + (bufoff) + ldsw + _i * 8192), 16, 0, 0); } while (0)
#define PG8_LDA(dst, b, h) do { _Pragma("unroll") for (int m = 0; m < 4; ++m) _Pragma("unroll") for (int k = 0; k < 2; ++k) dst[m][k] = *(const PG8_LAS bf16x8*)(lds + PG8_SA(b, h) + aoff + m * 2048 + k * 1024); } while (0)
#define PG8_LDB(dst, b, h) do { _Pragma("unroll") for (int n = 0; n < 2; ++n) _Pragma("unroll") for (int k = 0; k < 2; ++k) dst[n][k] = *(const PG8_LAS bf16x8*)(lds + PG8_SB(b, h) + boff + n * 2048 + k * 1024); } while (0)
#define PG8_MMA(ai, bj, At, Bt) do { __builtin_amdgcn_s_setprio(1); _Pragma("unroll") for (int m = 0; m < 4; ++m) _Pragma("unroll") for (int n = 0; n < 2; ++n) _Pragma("unroll") for (int k = 0; k < 2; ++k) \
        acc[ai][bj][m][n] = __builtin_amdgcn_mfma_f32_16x16x32_bf16(Bt[n][k], At[m][k], acc[ai][bj][m][n], 0, 0, 0); __builtin_amdgcn_s_setprio(0); } while (0)
#define PG8_WAIT_V(n) asm volatile("s_waitcnt vmcnt(" #n ")" ::: "memory")
#define PG8_WAIT_L(n) asm volatile("s_waitcnt lgkmcnt(" #n ")" ::: "memory")
#define PG8_BAR __builtin_amdgcn_s_barrier()
#define PG8_SCHED __builtin_amdgcn_sched_barrier(0)
    Unit cur, nxt; int ui = 0;
    if (!S.next(0, cur)) return;
    f32x4 acc[2][2][4][2];
#pragma unroll
    for (int a = 0; a < 2; ++a)
#pragma unroll
        for (int b = 0; b < 2; ++b)
#pragma unroll
            for (int m = 0; m < 4; ++m)
#pragma unroll
                for (int n = 0; n < 2; ++n) acc[a][b][m][n] = (f32x4){0.f, 0.f, 0.f, 0.f};
    bf16x8 At[4][2], B0[2][2], B1[2][2];
    const char* cA = (const char*)g.A + (size_t)cur.pm * tstep; const char* cB = (const char*)g.Bt + (size_t)cur.pn * tstep;
    S.a_ready(cur);
    if constexpr (SP2) {
        PG8_STAGE(PG8_SB(0, 0), cB, voffB); PG8_STAGE(PG8_SB(0, 1), cB + hstep, voffB); PG8_STAGE(PG8_SA(0, 0), cA, voffA); PG8_STAGE(PG8_SA(0, 1), cA + hstep, voffA);
        if (wr == 1) PG8_BAR;
        PG8_WAIT_V(2); PG8_BAR;
        PG8_STAGE(PG8_SB(1, 0), cB + kstep, voffB); PG8_STAGE(PG8_SA(1, 0), cA + kstep, voffA); PG8_STAGE(PG8_SB(1, 1), cB + hstep + kstep, voffB);
        PG8_WAIT_V(6); PG8_BAR;
    } else {
        PG8_STAGE(PG8_SB(0, 0), cB, voffB); PG8_STAGE(PG8_SA(0, 0), cA, voffA); PG8_STAGE(PG8_SB(0, 1), cB + hstep, voffB); PG8_STAGE(PG8_SA(0, 1), cA + hstep, voffA);
        if (wr == 1) PG8_BAR;
        PG8_WAIT_V(4); PG8_BAR;
        PG8_STAGE(PG8_SB(1, 0), cB + kstep, voffB); PG8_STAGE(PG8_SA(1, 0), cA + kstep, voffA); PG8_STAGE(PG8_SB(1, 1), cB + hstep + kstep, voffB);
        PG8_WAIT_V(6); PG8_BAR;
    }
    for (;;) {
        const bool has_next = S.next(ui + 1, nxt);
        const char* nA = has_next ? (const char*)g.A + (size_t)nxt.pm * tstep : cA; const char* nB = has_next ? (const char*)g.Bt + (size_t)nxt.pn * tstep : cB;
        for (int t = 0; t < nt; t += 2) {
            const bool last = (t == nt - 2);
            const char* a1 = cA + (size_t)(t + 1) * kstep;
            const char* a2 = last ? nA : cA + (size_t)(t + 2) * kstep; const char* b2 = last ? nB : cB + (size_t)(t + 2) * kstep;
            const char* a3 = a2 + kstep; const char* b3 = b2 + kstep;
            if (last && has_next) S.a_ready(nxt);
            if constexpr (SP2) {
            PG8_LDB(B0, 0, 0); PG8_LDB(B1, 0, 1); PG8_SCHED; PG8_LDA(At, 0, 0); PG8_STAGE(PG8_SA(1, 1), a1 + hstep, voffA);
            PG8_WAIT_V(8); PG8_WAIT_L(0); PG8_BAR; PG8_MMA(0, 0, At, B0); PG8_MMA(0, 1, At, B1); PG8_BAR; PG8_SCHED;
            PG8_LDA(At, 0, 1); PG8_STAGE(PG8_SB(0, 0), b2, voffB); PG8_STAGE(PG8_SB(0, 1), b2 + hstep, voffB); PG8_STAGE(PG8_SA(0, 0), a2, voffA);
            PG8_WAIT_V(8); PG8_WAIT_L(0); PG8_BAR; PG8_MMA(1, 0, At, B0); PG8_MMA(1, 1, At, B1); PG8_BAR; PG8_SCHED;
            PG8_LDB(B0, 1, 0); PG8_LDB(B1, 1, 1); PG8_SCHED; PG8_LDA(At, 1, 0); PG8_STAGE(PG8_SA(0, 1), a2 + hstep, voffA);
            PG8_WAIT_V(8); PG8_WAIT_L(0); PG8_BAR; PG8_MMA(0, 0, At, B0); PG8_MMA(0, 1, At, B1); PG8_BAR; PG8_SCHED;
            PG8_LDA(At, 1, 1); PG8_STAGE(PG8_SB(1, 0), b3, voffB); PG8_STAGE(PG8_SB(1, 1), b3 + hstep, voffB); PG8_STAGE(PG8_SA(1, 0), a3, voffA);
            PG8_WAIT_V(8); PG8_WAIT_L(0); PG8_BAR; PG8_MMA(1, 0, At, B0); PG8_MMA(1, 1, At, B1); PG8_BAR; PG8_SCHED;
            } else {
            PG8_LDB(B0, 0, 0); PG8_SCHED; PG8_LDA(At, 0, 0); PG8_STAGE(PG8_SA(1, 1), a1 + hstep, voffA);
            PG8_WAIT_L(8); PG8_BAR; PG8_WAIT_L(0); PG8_MMA(0, 0, At, B0); PG8_BAR; PG8_SCHED;
            PG8_LDB(B1, 0, 1); PG8_STAGE(PG8_SB(0, 0), b2, voffB);
            PG8_BAR; PG8_WAIT_L(0); PG8_MMA(0, 1, At, B1); PG8_BAR;
            PG8_LDA(At, 0, 1); PG8_STAGE(PG8_SA(0, 0), a2, voffA);
            PG8_BAR; PG8_WAIT_L(0); PG8_MMA(1, 0, At, B0); PG8_BAR; PG8_SCHED;
            PG8_STAGE(PG8_SB(0, 1), b2 + hstep, voffB);
            PG8_WAIT_V(6); PG8_BAR; PG8_MMA(1, 1, At, B1); PG8_BAR;
            PG8_LDB(B0, 1, 0); PG8_SCHED; PG8_LDA(At, 1, 0); PG8_STAGE(PG8_SA(0, 1), a2 + hstep, voffA);
            PG8_WAIT_L(8); PG8_BAR; PG8_WAIT_L(0); PG8_MMA(0, 0, At, B0); PG8_BAR; PG8_SCHED;
            PG8_LDB(B1, 1, 1); PG8_STAGE(PG8_SB(1, 0), b3, voffB);
            PG8_BAR; PG8_WAIT_L(0); PG8_MMA(0, 1, At, B1); PG8_BAR;
            PG8_LDA(At, 1, 1); PG8_STAGE(PG8_SA(1, 0), a3, voffA);
            PG8_BAR; PG8_WAIT_L(0); PG8_MMA(1, 0, At, B0); PG8_BAR; PG8_SCHED;
            PG8_STAGE(PG8_SB(1, 1), b3 + hstep, voffB);
            PG8_WAIT_V(6); PG8_BAR; PG8_MMA(1, 1, At, B1); PG8_BAR;
            }
        }
        if constexpr (ALIGN_EPI) { if (wr == 0) PG8_BAR; }
        if constexpr (!Epi::AFTER_DRAIN) { E(acc, cur, wr, wc, fr, fq); S.done(cur); }
        if (!has_next) break;
#pragma unroll
        for (int a = 0; a < 2; ++a)
#pragma unroll
            for (int b = 0; b < 2; ++b)
#pragma unroll
                for (int m = 0; m < 4; ++m)
#pragma unroll
                    for (int n = 0; n < 2; ++n) acc[a][b][m][n] = (f32x4){0.f, 0.f, 0.f, 0.f};
        cur = nxt; cA = nA; cB = nB; ++ui;
        if constexpr (ALIGN_EPI) { if (wr == 1) PG8_BAR; }
    }
    PG8_WAIT_V(0);
    if constexpr (!ALIGN_EPI) { if (wr == 0) PG8_BAR; }
    PG8_BAR;
    if constexpr (Epi::AFTER_DRAIN) { E.fused(acc, cur, wr, wc, fr, fq, lds, wid, lane); S.done(cur); }
#undef PG8_SA
#undef PG8_SB
#undef PG8_STAGE
#undef PG8_LDA
#undef PG8_LDB
#undef PG8_MMA
#undef PG8_WAIT_V
#undef PG8_WAIT_L
#undef PG8_BAR
#undef PG8_SCHED
}

template <class Fn> struct EpiRow8 {
    static constexpr bool PERM = true, AFTER_DRAIN = false; Fn f;
    __device__ __forceinline__ void operator()(const f32x4 (&acc)[2][2][4][2], const Unit& u, int wr, int wc, int fr, int fq) const {
#pragma unroll
        for (int ai = 0; ai < 2; ++ai)
#pragma unroll
            for (int m = 0; m < 4; ++m) { const int r = u.pm * BM + ai * HALF + wr * 64 + m * 16 + fr;
#pragma unroll
                for (int bj = 0; bj < 2; ++bj) { const int c0 = u.pn * BM + bj * HALF + wc * 32 + 8 * fq;
                    const f32x4 v0 = acc[ai][bj][m][0], v1 = acc[ai][bj][m][1];
                    const float v[8] = {v0[0], v0[1], v0[2], v0[3], v1[0], v1[1], v1[2], v1[3]};
                    f.row8(r, c0, v); } }
    }
};
}

template <class Epi>
__device__ __forceinline__ void naive_gemm(const Frame& F, const bf16* A, const bf16* Bt, int M, int N, int K, const Epi& E) {
    LAS float* As = (LAS float*)F.lds;
    LAS float* Bs = As + 32 * 132;
    const int tid = F.tid, tr = tid >> 4, tc = tid & 15;
    const int ntn = N / 128, nt = (M / 128) * ntn;
    for (int tile = F.vcu; tile < nt; tile += F.G) {
        const int tm = tile / ntn, tn = tile % ntn;
        float acc[4][8];
#pragma unroll
        for (int i = 0; i < 4; ++i)
#pragma unroll
            for (int j = 0; j < 8; ++j) acc[i][j] = 0.f;
        for (int k0 = 0; k0 < K; k0 += 32) {
            { const int r = tid >> 2, kc = (tid & 3) * 8;
              const v4u a = *(const v4u*)(A + (size_t)(tm * 128 + r) * K + k0 + kc);
              const v4u b = *(const v4u*)(Bt + (size_t)(tn * 128 + r) * K + k0 + kc);
              float fa[8], fb[8]; unpack8(a, fa); unpack8(b, fb);
#pragma unroll
              for (int j = 0; j < 8; ++j) { As[(kc + j) * 132 + r] = fa[j]; Bs[(kc + j) * 132 + r] = fb[j]; } }
            __syncthreads();
#pragma unroll 8
            for (int k = 0; k < 32; ++k) {
                const f32x4 a = *(const LAS f32x4*)(As + k * 132 + tr * 4);
                const f32x4 b0 = *(const LAS f32x4*)(Bs + k * 132 + tc * 8), b1 = *(const LAS f32x4*)(Bs + k * 132 + tc * 8 + 4);
#pragma unroll
                for (int i = 0; i < 4; ++i) {
                    acc[i][0] += a[i] * b0.x; acc[i][1] += a[i] * b0.y; acc[i][2] += a[i] * b0.z; acc[i][3] += a[i] * b0.w;
                    acc[i][4] += a[i] * b1.x; acc[i][5] += a[i] * b1.y; acc[i][6] += a[i] * b1.z; acc[i][7] += a[i] * b1.w; }
            }
            __syncthreads();
        }
#pragma unroll
        for (int i = 0; i < 4; ++i) E.row8(tm * 128 + tr * 4 + i, tn * 128 + tc * 8, acc[i]);
    }
}

struct EpiStore { bf16* O; int ldc;
    __device__ __forceinline__ void row8(int r, int c0, const float (&v)[8]) const { *(v4u*)(O + (size_t)r * ldc + c0) = pack8(v); } };
struct EpiZ2 { bf16* ONOA; bf16* Zcg;
    __device__ __forceinline__ void row8(int r, int c0, const float (&v)[8]) const {
        if (c0 < 1024) { float on[8], o[8]; unpack8(*(const v4u*)(ONOA + (size_t)r * D + c0), on);
#pragma unroll
            for (int j = 0; j < 8; ++j) o[j] = on[j] * (v[j] / (1.0f + __expf(-v[j])));
            *(v4u*)(ONOA + (size_t)r * D + c0) = pack8(o); }
        else *(v4u*)(Zcg + (size_t)r * 5120 + (c0 - 1024)) = pack8(v); } };
struct EpiGateA { float* TMP; const bf16* Zcg;
    __device__ __forceinline__ void row8(int r, int c0, const float (&v)[8]) const {
        float g[8]; unpack8(*(const v4u*)(Zcg + (size_t)r * 5120 + 3072 + c0), g);
        f32x4 o0, o1; o0.x = sigmoidf_(g[0]) * v[0]; o0.y = sigmoidf_(g[1]) * v[1]; o0.z = sigmoidf_(g[2]) * v[2]; o0.w = sigmoidf_(g[3]) * v[3];
        o1.x = sigmoidf_(g[4]) * v[4]; o1.y = sigmoidf_(g[5]) * v[5]; o1.z = sigmoidf_(g[6]) * v[6]; o1.w = sigmoidf_(g[7]) * v[7];
        *(f32x4*)(TMP + (size_t)r * D + c0) = o0; *(f32x4*)(TMP + (size_t)r * D + c0 + 4) = o1; } };
struct EpiGateB { const float* TMP; const bf16* Zcg; bf16* MERGED;
    __device__ __forceinline__ void row8(int r, int c0, const float (&v)[8]) const {
        float g[8]; unpack8(*(const v4u*)(Zcg + (size_t)r * 5120 + 4096 + c0), g);
        const f32x4 t0 = *(const f32x4*)(TMP + (size_t)r * D + c0), t1 = *(const f32x4*)(TMP + (size_t)r * D + c0 + 4);
        float o[8]; o[0] = t0.x + sigmoidf_(g[0]) * v[0]; o[1] = t0.y + sigmoidf_(g[1]) * v[1]; o[2] = t0.z + sigmoidf_(g[2]) * v[2]; o[3] = t0.w + sigmoidf_(g[3]) * v[3];
        o[4] = t1.x + sigmoidf_(g[4]) * v[4]; o[5] = t1.y + sigmoidf_(g[5]) * v[5]; o[6] = t1.z + sigmoidf_(g[6]) * v[6]; o[7] = t1.w + sigmoidf_(g[7]) * v[7];
        *(v4u*)(MERGED + (size_t)r * D + c0) = pack8(o); } };
struct EpiResid { const float* X; float* Y;
    __device__ __forceinline__ void row8(int r, int c0, const float (&v)[8]) const {
        const f32x4 x0 = *(const f32x4*)(X + (size_t)r * D + c0), x1 = *(const f32x4*)(X + (size_t)r * D + c0 + 4);
        f32x4 o0, o1; o0.x = ALPHA * x0.x + v[0]; o0.y = ALPHA * x0.y + v[1]; o0.z = ALPHA * x0.z + v[2]; o0.w = ALPHA * x0.w + v[3];
        o1.x = ALPHA * x1.x + v[4]; o1.y = ALPHA * x1.y + v[5]; o1.z = ALPHA * x1.z + v[6]; o1.w = ALPHA * x1.w + v[7];
        *(f32x4*)(Y + (size_t)r * D + c0) = o0; *(f32x4*)(Y + (size_t)r * D + c0 + 4) = o1; } };
struct EpiFinal { const float* X2; const bf16* PP; float* OUT;
    __device__ __forceinline__ void row8(int r, int c0, const float (&v)[8]) const {
        float p[8]; unpack8(*(const v4u*)(PP + (size_t)r * D + c0), p);
        const f32x4 x0 = *(const f32x4*)(X2 + (size_t)r * D + c0), x1 = *(const f32x4*)(X2 + (size_t)r * D + c0 + 4);
        f32x4 o0, o1; o0.x = x0.x + sigmoidf_(v[0]) * p[0]; o0.y = x0.y + sigmoidf_(v[1]) * p[1]; o0.z = x0.z + sigmoidf_(v[2]) * p[2]; o0.w = x0.w + sigmoidf_(v[3]) * p[3];
        o1.x = x1.x + sigmoidf_(v[4]) * p[4]; o1.y = x1.y + sigmoidf_(v[5]) * p[5]; o1.z = x1.z + sigmoidf_(v[6]) * p[6]; o1.w = x1.w + sigmoidf_(v[7]) * p[7];
        *(f32x4*)(OUT + (size_t)r * D + c0) = o0; *(f32x4*)(OUT + (size_t)r * D + c0 + 4) = o1; } };


template <class Fn>
__device__ __forceinline__ void run_gemm(const Frame& F, const bf16* A, const bf16* Bt, int M, int N, int K, const Fn& fn) {
    pg8::Gemm g{A, Bt, M, N, K}; pg8::StaticOrder S; S.init(M, N, F.G, (int)blockIdx.x);
    pg8::EpiRow8<Fn> E{fn};
    pg8::gemm_phase<pg8::EpiRow8<Fn>, pg8::StaticOrder, true, true>(F.lds, g, S, E);
}

__device__ __forceinline__ void ln_row_store(f32x4 (&v)[4], const float* g, const float* b, float* orow, bf16* obrow, int lane) {
    float s = 0.f;
#pragma unroll
    for (int j = 0; j < 4; ++j) s += (v[j].x + v[j].y) + (v[j].z + v[j].w);
    const float mean = wave_sum(s) * (1.f / D); float s2 = 0.f;
#pragma unroll
    for (int j = 0; j < 4; ++j) { v[j] = v[j] - mean; s2 += (v[j].x * v[j].x + v[j].y * v[j].y) + (v[j].z * v[j].z + v[j].w * v[j].w); }
    const float rstd = 1.f / sqrtf(wave_sum(s2) * (1.f / D) + LN_EPS);
#pragma unroll
    for (int j = 0; j < 4; ++j) {
        const f32x4 gg = *(const f32x4*)(g + 4 * lane + 256 * j), bb = *(const f32x4*)(b + 4 * lane + 256 * j);
        const f32x4 o = v[j] * rstd * gg + bb;
        *(f32x4*)(orow + 4 * lane + 256 * j) = o;
        unsigned long long w = (unsigned long long)pk2(o.x, o.y) | ((unsigned long long)pk2(o.z, o.w) << 32);
        *(unsigned long long*)(obrow + 4 * lane + 256 * j) = w;
    }
}
__device__ __forceinline__ float gelu_erf(float x) { return 0.5f * x * (1.0f + erff(x * 0.70710678118654752f)); }

__global__ void __launch_bounds__(NWAVES * 64, 2) skel_fwd(Args args) {
    extern __shared__ __attribute__((aligned(16))) unsigned char lds[];
    Frame F;
    F.lds = (LAS unsigned char*)lds;
    F.tid = threadIdx.x; F.lane = F.tid & 63; F.wave = __builtin_amdgcn_readfirstlane(F.tid >> 6);
    F.G = gridDim.x; { const int bx = blockIdx.x; F.vcu = (F.G % 8 == 0) ? (bx % 8) * (F.G / 8) + bx / 8 : bx; }
    unsigned char* ws = args.ws;
    volatile LAS unsigned* MISC = (volatile LAS unsigned*)(F.lds + MISC_OFF);
    for (int u = F.tid; u < (LDS_BYTES - LDSCTL_OFF) / 4; u += NWAVES * 64) ((LAS unsigned*)(F.lds + LDSCTL_OFF))[u] = 0u;
    __syncthreads();
    XcdBarrier bar; bar.bar = (unsigned*)(ws + WS_CTL) + CW_BAR; bar.x = 0; bar.st = nullptr;
    if (N_LAUNCHES == 1) bar = xcd_barrier_post((unsigned*)(ws + WS_CTL) + CW_BAR, MISC + 8);
    const int lo = args.ph_lo, hi = args.ph_hi;
#define IN(k) (lo <= (k) && (k) < hi)
#define SEAM(k) do { if (IN(k) && IN((k) + 1)) xcd_barrier(bar); } while (0)

    const float* x = args.in[0]; const float* p = args.in[1]; const float* w_in = args.in[2]; const float* lb_param = args.in[3];
    const float* hg_norm_g = args.in[4]; const float* conv_w = args.in[5]; const float* conv_b = args.in[6];
    const float* w_a = args.in[7]; const float* w_b = args.in[8]; const float* w_out = args.in[9];
    const float* ln1_g = args.in[10]; const float* ln1_b = args.in[11]; const float* pk_wq = args.in[12]; const float* pk_sk = args.in[13];
    const float* pk_u = args.in[14]; const float* pk_v = args.in[15]; const float* ln2_g = args.in[16]; const float* ln2_b = args.in[17];
    const float* w_pg = args.in[18]; const float* w_pp = args.in[19];
    float* out = args.out;
    bf16* WinT = (bf16*)(ws + WS_WIN); bf16* WaT = (bf16*)(ws + WS_WA); bf16* WbT = (bf16*)(ws + WS_WB); bf16* WoT = (bf16*)(ws + WS_WO);
    bf16* WpgT = (bf16*)(ws + WS_WPG); bf16* WqT = (bf16*)(ws + WS_WQ); bf16* SKB = (bf16*)(ws + WS_SK); bf16* WppT = (bf16*)(ws + WS_WPP);
    bf16* XB = (bf16*)(ws + WS_XB); bf16* PB = (bf16*)(ws + WS_PB);
    bf16* Zhg = (bf16*)(ws + WS_BIG); bf16* Zcg = (bf16*)(ws + WS_BIG);
    bf16* ST = (bf16*)out;
    bf16* VT = (bf16*)(ws + WS_VT); bf16* KET = (bf16*)(ws + WS_KET); float* DEC = (float*)(ws + WS_DEC); bf16* ON = (bf16*)(ws + WS_OA);
    bf16* OA = (bf16*)(ws + WS_OA); bf16* YC = (bf16*)(ws + WS_YC);
    float* TMP = out;
    bf16* MERGED = (bf16*)(ws + WS_OA);
    float* Y = (float*)(ws + WS_Y); float* X1 = (float*)(ws + WS_X1); bf16* X1B = (bf16*)(ws + WS_X1B);
    bf16* QP = (bf16*)(ws + WS_QP); bf16* PP = (bf16*)(ws + WS_OA);
    int* IDS = (int*)(ws + WS_IDS); float* GW = (float*)(ws + WS_GW);
    bf16* X2B = (bf16*)(ws + WS_X2B);

    const int gtid = F.vcu * (NWAVES * 64) + F.tid, NT = F.G * NWAVES * 64;
    const int gw = F.vcu * NWAVES + F.wave, NGW = F.G * NWAVES;

    if (IN(0)) {
        LAS float* scr = (LAS float*)(F.lds + F.wave * 16384);
        constexpr int I_IN = (D / 64) * (PROJ_W / 32), I_SQ = (D / 64) * (D / 32), I_Q = (D / 64) * (2048 / 32), I_PP = (PLE / 64) * (D / 32);
        constexpr int NITEMS = I_IN + 4 * I_SQ + I_Q + I_PP;
        for (int it = gw; it < NITEMS; it += NGW) {
            int r = it;
            if (r < I_IN) { p0_transpose_item(w_in, D, PROJ_W, WinT, scr, r, F.lane); continue; } r -= I_IN;
            if (r < I_SQ) { p0_transpose_item(w_a, D, D, WaT, scr, r, F.lane); continue; } r -= I_SQ;
            if (r < I_SQ) { p0_transpose_item(w_b, D, D, WbT, scr, r, F.lane); continue; } r -= I_SQ;
            if (r < I_SQ) { p0_transpose_item(w_out, D, D, WoT, scr, r, F.lane); continue; } r -= I_SQ;
            if (r < I_SQ) { p0_transpose_item(w_pg, D, D, WpgT, scr, r, F.lane); continue; } r -= I_SQ;
            if (r < I_Q) { p0_transpose_item(pk_wq, D, 2048, WqT, scr, r, F.lane); continue; } r -= I_Q;
            p0_transpose_item(w_pp, PLE, D, WppT, scr, r, F.lane);
        }
        convert_rows(x, XB, (size_t)T * D, gtid, NT);
        convert_rows(p, PB, (size_t)T * PLE, gtid, NT);
        convert_rows(pk_sk, SKB, (size_t)PKH * 2 * NKEYS * 128, gtid, NT);
    }
    SEAM(0);
    if (IN(1)) { EpiStore E{Zhg, 3072}; run_gemm(F, XB, WinT, T, 3072, D, E); }
    SEAM(1);
    if (IN(2)) {
        LAS float* tot = (LAS float*)F.lds;
        for (int unit = F.vcu; unit < 2048; unit += F.G) {
            const int n = unit >> 3, h = unit & 7, row0 = n * 64;
            const int c = F.tid & 127, sgm = F.tid >> 7, ch = h * 128 + c;
            const float lb = 1.0f / (1.0f + expf(lb_param[1024 + ch] - lb_param[ch]));
            float lf[16], kk[16];
            float run = 0.f;
#pragma unroll
            for (int i = 0; i < 16; ++i) { const size_t tok = (size_t)row0 + sgm * 16 + i;
                const float fz = bf2f(Zhg[tok * 3072 + 1024 + ch]); const float sg = 1.0f / (1.0f + expf(-fz));
                const float f = lb + (1.0f - lb) * sg; kk[i] = (1.0f - lb) * (1.0f - sg); run += logf(f); lf[i] = run; }
            tot[sgm * 128 + c] = run;
            __syncthreads();
            float off = 0.f, total = 0.f;
#pragma unroll
            for (int s2 = 0; s2 < 4; ++s2) { const float tv = tot[s2 * 128 + c]; total += tv; if (s2 < sgm) off += tv; }
            __syncthreads();
            float kev[16], vv[16];
#pragma unroll
            for (int i = 0; i < 16; ++i) { const size_t tok = (size_t)row0 + sgm * 16 + i; const float bc = lf[i] + off;
                const float q = bf2f(Zhg[tok * 3072 + ch]) * 0.08838834764831845f;
                const float qe = q * expf(bc), ke = kk[i] * expf(-bc);
                vv[i] = bf2f(Zhg[tok * 3072 + 2048 + ch]);
                Zhg[tok * 3072 + ch] = (bf16)f2bf(qe); Zhg[tok * 3072 + 1024 + ch] = (bf16)f2bf(ke); kev[i] = ke; }
            { float t0[8], t1[8];
#pragma unroll
              for (int i = 0; i < 8; ++i) { t0[i] = kev[i]; t1[i] = kev[8 + i]; }
              bf16* dst = KET + ((size_t)unit * 128 + c) * 64 + sgm * 16; *(v4u*)dst = pack8(t0); *(v4u*)(dst + 8) = pack8(t1);
#pragma unroll
              for (int i = 0; i < 8; ++i) { t0[i] = vv[i]; t1[i] = vv[8 + i]; }
              dst = VT + ((size_t)unit * 128 + c) * 64 + sgm * 16; *(v4u*)dst = pack8(t0); *(v4u*)(dst + 8) = pack8(t1); }
            if (sgm == 0) DEC[(size_t)n * 1024 + ch] = expf(total);
        }
    }
    SEAM(2);
    if (IN(3)) {
        const int q4 = F.lane >> 4, l15 = F.lane & 15;
        for (int unit = gw; unit < 2048; unit += NGW) {
            const int n = unit >> 3, h = unit & 7;
            const bf16* ket = KET + (size_t)unit * 128 * 64; const bf16* vt = VT + (size_t)unit * 128 * 64;
            bf16x8 a[8][2];
#pragma unroll
            for (int t = 0; t < 8; ++t)
#pragma unroll
                for (int s2 = 0; s2 < 2; ++s2) a[t][s2] = *(const bf16x8*)(ket + (16 * t + l15) * 64 + 32 * s2 + 8 * q4);
            f32x4 dc[8];
#pragma unroll
            for (int t = 0; t < 8; ++t) dc[t] = *(const f32x4*)(DEC + (size_t)n * 1024 + h * 128 + 16 * t + 4 * q4);
            for (int qd = 0; qd < 4; ++qd) {
                bf16x8 b[2][2];
#pragma unroll
                for (int cc = 0; cc < 2; ++cc)
#pragma unroll
                    for (int s2 = 0; s2 < 2; ++s2) b[cc][s2] = *(const bf16x8*)(vt + (32 * qd + 16 * cc + l15) * 64 + 32 * s2 + 8 * q4);
#pragma unroll
                for (int t = 0; t < 8; ++t)
#pragma unroll
                    for (int cc = 0; cc < 2; ++cc) {
                        f32x4 acc = (f32x4){0.f, 0.f, 0.f, 0.f};
                        acc = __builtin_amdgcn_mfma_f32_16x16x32_bf16(a[t][0], b[cc][0], acc, 0, 0, 0);
                        acc = __builtin_amdgcn_mfma_f32_16x16x32_bf16(a[t][1], b[cc][1], acc, 0, 0, 0);
                        acc = acc * dc[t];
                        const int dv = 32 * qd + 16 * cc + l15;
                        unsigned long long w = (unsigned long long)pk2(acc[0], acc[1]) | ((unsigned long long)pk2(acc[2], acc[3]) << 32);
                        *(unsigned long long*)(ST + ((size_t)unit * 128 + dv) * 128 + 16 * t + 4 * q4) = w;
                    }
            }
        }
    }
    SEAM(3);
    if (IN(4)) {
        for (int i = gtid; i < 65536; i += NT) {
            const int dk4 = i & 31, dv = (i >> 5) & 127, h = (i >> 12) & 7, b = i >> 15;
            f32x4 st = (f32x4){0.f, 0.f, 0.f, 0.f};
#pragma unroll 8
            for (int cn = 0; cn < 128; ++cn) {
                const int n = b * 128 + cn; const size_t unit = (size_t)n * 8 + h;
                unsigned long long* ptr = (unsigned long long*)(ST + (unit * 128 + dv) * 128 + dk4 * 4);
                const unsigned long long d = *ptr;
                const f32x4 dc = *(const f32x4*)(DEC + (size_t)n * 1024 + h * 128 + dk4 * 4);
                *ptr = (unsigned long long)pk2(st[0], st[1]) | ((unsigned long long)pk2(st[2], st[3]) << 32);
                const f32x4 dd = (f32x4){bflo((unsigned)d), bfhi((unsigned)d), bflo((unsigned)(d >> 32)), bfhi((unsigned)(d >> 32))};
                st = dc * st + dd;
            }
        }
    }
    SEAM(4);
    if (IN(5)) {
        const int q4 = F.lane >> 4, l15 = F.lane & 15;
        LAS bf16* Pl = (LAS bf16*)(F.lds + F.wave * 8192);
        for (int unit = gw; unit < 2048; unit += NGW) {
            const int n = unit >> 3, h = unit & 7, row0 = n * 64;
            const bf16* st = ST + (size_t)unit * 128 * 128; const bf16* vt = VT + (size_t)unit * 128 * 64;
            for (int half = 0; half < 2; ++half) {
                const int i0 = half * 32;
                bf16x8 qf[2][4];
#pragma unroll
                for (int it = 0; it < 2; ++it)
#pragma unroll
                    for (int ks = 0; ks < 4; ++ks) qf[it][ks] = *(const bf16x8*)(Zhg + (size_t)(row0 + i0 + 16 * it + l15) * 3072 + h * 128 + 32 * ks + 8 * q4);
                f32x4 acc[8][2];
#pragma unroll
                for (int dvt = 0; dvt < 8; ++dvt) { acc[dvt][0] = (f32x4){0.f, 0.f, 0.f, 0.f}; acc[dvt][1] = (f32x4){0.f, 0.f, 0.f, 0.f}; }
#pragma unroll
                for (int dvt = 0; dvt < 8; ++dvt)
#pragma unroll
                    for (int ks = 0; ks < 4; ++ks) { const bf16x8 a = *(const bf16x8*)(st + (16 * dvt + l15) * 128 + 32 * ks + 8 * q4);
                        acc[dvt][0] = __builtin_amdgcn_mfma_f32_16x16x32_bf16(a, qf[0][ks], acc[dvt][0], 0, 0, 0);
                        acc[dvt][1] = __builtin_amdgcn_mfma_f32_16x16x32_bf16(a, qf[1][ks], acc[dvt][1], 0, 0, 0); }
                const int njt = 2 * (half + 1);
                for (int jt = 0; jt < njt; ++jt) {
                    f32x4 p0 = (f32x4){0.f, 0.f, 0.f, 0.f}, p1 = (f32x4){0.f, 0.f, 0.f, 0.f};
#pragma unroll
                    for (int ks = 0; ks < 4; ++ks) { const bf16x8 a = *(const bf16x8*)(Zhg + (size_t)(row0 + 16 * jt + l15) * 3072 + 1024 + h * 128 + 32 * ks + 8 * q4);
                        p0 = __builtin_amdgcn_mfma_f32_16x16x32_bf16(a, qf[0][ks], p0, 0, 0, 0);
                        p1 = __builtin_amdgcn_mfma_f32_16x16x32_bf16(a, qf[1][ks], p1, 0, 0, 0); }
                    const int jb = 16 * jt + 4 * q4;
                    { const int ii = i0 + l15;
                      const float m0 = (jb + 0 <= ii) ? p0[0] : 0.f, m1 = (jb + 1 <= ii) ? p0[1] : 0.f, m2 = (jb + 2 <= ii) ? p0[2] : 0.f, m3 = (jb + 3 <= ii) ? p0[3] : 0.f;
                      *(LAS unsigned long long*)(Pl + l15 * 72 + jb) = (unsigned long long)pk2(m0, m1) | ((unsigned long long)pk2(m2, m3) << 32); }
                    { const int ii = i0 + 16 + l15;
                      const float m0 = (jb + 0 <= ii) ? p1[0] : 0.f, m1 = (jb + 1 <= ii) ? p1[1] : 0.f, m2 = (jb + 2 <= ii) ? p1[2] : 0.f, m3 = (jb + 3 <= ii) ? p1[3] : 0.f;
                      *(LAS unsigned long long*)(Pl + (16 + l15) * 72 + jb) = (unsigned long long)pk2(m0, m1) | ((unsigned long long)pk2(m2, m3) << 32); }
                }
                LDS_WAIT(); asm volatile("" ::: "memory");
                const int nks = half + 1;
                for (int kj = 0; kj < nks; ++kj) {
                    const bf16x8 b0 = *(const LAS bf16x8*)(Pl + l15 * 72 + 32 * kj + 8 * q4), b1 = *(const LAS bf16x8*)(Pl + (16 + l15) * 72 + 32 * kj + 8 * q4);
#pragma unroll
                    for (int dvt = 0; dvt < 8; ++dvt) { const bf16x8 a = *(const bf16x8*)(vt + (16 * dvt + l15) * 64 + 32 * kj + 8 * q4);
                        acc[dvt][0] = __builtin_amdgcn_mfma_f32_16x16x32_bf16(a, b0, acc[dvt][0], 0, 0, 0);
                        acc[dvt][1] = __builtin_amdgcn_mfma_f32_16x16x32_bf16(a, b1, acc[dvt][1], 0, 0, 0); }
                }
#pragma unroll
                for (int it = 0; it < 2; ++it) {
                    float ss = 0.f;
#pragma unroll
                    for (int dvt = 0; dvt < 8; ++dvt) { const f32x4 v = acc[dvt][it]; ss += (v[0] * v[0] + v[1] * v[1]) + (v[2] * v[2] + v[3] * v[3]); }
                    ss += __shfl_xor(ss, 16); ss += __shfl_xor(ss, 32);
                    const float rinv = 1.0f / sqrtf(ss * (1.0f / 128.0f) + RMS_EPS);
                    const size_t tok = (size_t)row0 + i0 + 16 * it + l15;
#pragma unroll
                    for (int dvt = 0; dvt < 8; ++dvt) { const f32x4 g4 = *(const f32x4*)(hg_norm_g + h * 128 + 16 * dvt + 4 * q4); const f32x4 o = acc[dvt][it] * rinv * g4;
                        *(unsigned long long*)(ON + tok * D + h * 128 + 16 * dvt + 4 * q4) = (unsigned long long)pk2(o[0], o[1]) | ((unsigned long long)pk2(o[2], o[3]) << 32); }
                }
                LDS_WAIT(); asm volatile("" ::: "memory");
            }
        }
    }
    SEAM(5);
    if (IN(6)) { EpiZ2 E{ON, Zcg}; run_gemm(F, XB, WinT + (size_t)3072 * D, T, 6144, D, E); }
    SEAM(6);
    if (IN(7)) {
        for (int i = gtid; i < T * (D / 8); i += NT) {
            const int row = i / (D / 8), c0 = (i % (D / 8)) * 8, t = row % SEQ;
            float cb[8], u0[8], u1[8], u2[8], a[8], b[8];
            unpack8(*(const v4u*)(Zcg + (size_t)row * 5120 + c0), cb);
            unpack8(*(const v4u*)(Zcg + (size_t)row * 5120 + 1024 + c0), a); unpack8(*(const v4u*)(Zcg + (size_t)row * 5120 + 2048 + c0), b);
#pragma unroll
            for (int j = 0; j < 8; ++j) u2[j] = a[j] * b[j];
            if (t >= 1) { unpack8(*(const v4u*)(Zcg + (size_t)(row - 1) * 5120 + 1024 + c0), a); unpack8(*(const v4u*)(Zcg + (size_t)(row - 1) * 5120 + 2048 + c0), b);
#pragma unroll
                for (int j = 0; j < 8; ++j) u1[j] = a[j] * b[j]; }
            else {
#pragma unroll
                for (int j = 0; j < 8; ++j) u1[j] = 0.f; }
            if (t >= 2) { unpack8(*(const v4u*)(Zcg + (size_t)(row - 2) * 5120 + 1024 + c0), a); unpack8(*(const v4u*)(Zcg + (size_t)(row - 2) * 5120 + 2048 + c0), b);
#pragma unroll
                for (int j = 0; j < 8; ++j) u0[j] = a[j] * b[j]; }
            else {
#pragma unroll
                for (int j = 0; j < 8; ++j) u0[j] = 0.f; }
            float y[8];
#pragma unroll
            for (int j = 0; j < 8; ++j) { const int c = c0 + j; y[j] = cb[j] * (conv_b[c] + conv_w[c] * u0[j] + conv_w[1024 + c] * u1[j] + conv_w[2048 + c] * u2[j]); }
            *(v4u*)(YC + (size_t)row * D + c0) = pack8(y);
        }
    }
    SEAM(7);
    if (IN(8)) { EpiGateA E{TMP, Zcg}; run_gemm(F, OA, WaT, T, D, D, E); }
    SEAM(8);
    if (IN(9)) { EpiGateB E{TMP, Zcg, MERGED}; run_gemm(F, YC, WbT, T, D, D, E); }
    SEAM(9);
    if (IN(10)) { EpiResid E{x, Y}; run_gemm(F, MERGED, WoT, T, D, D, E); }
    SEAM(10);
    if (IN(11)) {
        for (int row = gw; row < T; row += NGW) {
            f32x4 v[4];
#pragma unroll
            for (int j = 0; j < 4; ++j) v[j] = *(const f32x4*)(Y + (size_t)row * D + 4 * F.lane + 256 * j);
            ln_row_store(v, ln1_g, ln1_b, X1 + (size_t)row * D, X1B + (size_t)row * D, F.lane);
        }
    }
    SEAM(11);
    if (IN(12)) {
        { EpiStore E{QP, 2048}; run_gemm(F, X1B, WqT, T, 2048, D, E); }
        { EpiStore E{PP, D}; run_gemm(F, PB, WppT, T, D, PLE, E); }
    }
    SEAM(12);
    if (IN(13)) {
        LAS float* sq = (LAS float*)(F.lds + F.wave * 16384);
        const float NEG = -3.0e38f;
        for (int task = gw; task < T * PKH; task += NGW) {
            const int t = task >> 3, h = task & 7, lane = F.lane;
            { const unsigned long long w = *(const unsigned long long*)(QP + (size_t)t * 2048 + h * 256 + lane * 4);
              sq[lane * 4 + 0] = bflo((unsigned)w); sq[lane * 4 + 1] = bfhi((unsigned)w); sq[lane * 4 + 2] = bflo((unsigned)(w >> 32)); sq[lane * 4 + 3] = bfhi((unsigned)(w >> 32)); }
            LDS_WAIT(); asm volatile("" ::: "memory");
            float s[2][2];
#pragma unroll
            for (int pp = 0; pp < 2; ++pp)
#pragma unroll
                for (int j = 0; j < 2; ++j) {
                    const bf16* krow = SKB + ((size_t)((h * 2 + pp) * 128 + lane + 64 * j)) * 128;
                    float a = 0.f;
#pragma unroll 4
                    for (int d8 = 0; d8 < 16; ++d8) { float kv[8]; unpack8(*(const v4u*)(krow + d8 * 8), kv);
                        const f32x4 q0 = *(const LAS f32x4*)(sq + pp * 128 + d8 * 8), q1 = *(const LAS f32x4*)(sq + pp * 128 + d8 * 8 + 4);
                        a += q0.x * kv[0] + q0.y * kv[1] + q0.z * kv[2] + q0.w * kv[3] + q1.x * kv[4] + q1.y * kv[5] + q1.z * kv[6] + q1.w * kv[7]; }
                    s[pp][j] = a;
                }
            float myv[2] = {0.f, 0.f}; int myi[2] = {0, 0};
#pragma unroll
            for (int pp = 0; pp < 2; ++pp) {
                float a0 = s[pp][0], a1 = s[pp][1];
                for (int it = 0; it < TOPK; ++it) {
                    float bv; int bi;
                    if (a0 >= a1) { bv = a0; bi = lane; } else { bv = a1; bi = lane + 64; }
#pragma unroll
                    for (int off = 32; off >= 1; off >>= 1) { const float ov = __shfl_xor(bv, off); const int oi = __shfl_xor(bi, off);
                        if (ov > bv || (ov == bv && oi < bi)) { bv = ov; bi = oi; } }
                    if (lane == it) { myv[pp] = bv; myi[pp] = bi; }
                    if (bi == lane) a0 = NEG; if (bi == lane + 64) a1 = NEG;
                }
            }
            float cv[4];
            { const int a = lane >> 2; const float s1 = __shfl(myv[0], a);
#pragma unroll
              for (int j = 0; j < 4; ++j) { const int b = (lane & 3) * 4 + j; cv[j] = s1 + __shfl(myv[1], b); } }
            float topv = 0.f; int tope = 0;
            for (int it = 0; it < TOPK; ++it) {
                float bv = cv[0]; int bi = lane * 4;
#pragma unroll
                for (int j = 1; j < 4; ++j) if (cv[j] > bv) { bv = cv[j]; bi = lane * 4 + j; }
#pragma unroll
                for (int off = 32; off >= 1; off >>= 1) { const float ov = __shfl_xor(bv, off); const int oi = __shfl_xor(bi, off);
                    if (ov > bv || (ov == bv && oi < bi)) { bv = ov; bi = oi; } }
                const int e = __shfl(myi[0], bi >> 4) * 128 + __shfl(myi[1], bi & 15);
                if (lane == it) { topv = bv; tope = e; }
#pragma unroll
                for (int j = 0; j < 4; ++j) if (bi == lane * 4 + j) cv[j] = NEG;
            }
            const float mx = __shfl(topv, 0);
            float ev = (lane < TOPK) ? expf(topv - mx) : 0.f;
            float sum = ev; sum += __shfl_xor(sum, 1); sum += __shfl_xor(sum, 2); sum += __shfl_xor(sum, 4); sum += __shfl_xor(sum, 8);
            if (lane < TOPK) { IDS[(size_t)t * 128 + h * 16 + lane] = tope; GW[(size_t)t * 128 + h * 16 + lane] = ev / sum; }
            LDS_WAIT(); asm volatile("" ::: "memory");
        }
    }
    SEAM(13);
    if (IN(14)) {
        for (int t = gw; t < T; t += NGW) {
            const int lane = F.lane;
            f32x4 xv[4];
#pragma unroll
            for (int j = 0; j < 4; ++j) xv[j] = *(const f32x4*)(X1 + (size_t)t * D + 4 * lane + 256 * j);
            const int id0 = IDS[(size_t)t * 128 + lane], id1 = IDS[(size_t)t * 128 + 64 + lane];
            const float g0 = GW[(size_t)t * 128 + lane], g1 = GW[(size_t)t * 128 + 64 + lane];
            f32x4 acc[4];
#pragma unroll
            for (int j = 0; j < 4; ++j) acc[j] = (f32x4){0.f, 0.f, 0.f, 0.f};
            for (int i = 0; i < 128; ++i) {
                const int e = __shfl(i < 64 ? id0 : id1, i & 63); const float g = __shfl(i < 64 ? g0 : g1, i & 63);
                const float* ur = pk_u + (size_t)e * D; const float* vr = pk_v + (size_t)e * D;
                float d = 0.f;
#pragma unroll
                for (int j = 0; j < 4; ++j) { const f32x4 u4 = *(const f32x4*)(ur + 4 * lane + 256 * j); d += (u4.x * xv[j].x + u4.y * xv[j].y) + (u4.z * xv[j].z + u4.w * xv[j].w); }
                d = wave_sum(d);
                const float wgt = g * gelu_erf(d);
#pragma unroll
                for (int j = 0; j < 4; ++j) { const f32x4 v4 = *(const f32x4*)(vr + 4 * lane + 256 * j); acc[j] = acc[j] + v4 * wgt; }
            }
#pragma unroll
            for (int j = 0; j < 4; ++j) acc[j] = xv[j] * ALPHA + acc[j];
            ln_row_store(acc, ln2_g, ln2_b, X1 + (size_t)t * D, X2B + (size_t)t * D, lane);
        }
    }
    SEAM(14);
    if (IN(15)) { EpiFinal E{X1, PP, out}; run_gemm(F, X2B, WpgT, T, D, D, E); }
#undef IN
#undef SEAM
}

extern "C" void kernel_launch(void* const* d_in, const int* in_sizes, int n_in, void* d_out, int out_size, void* d_ws, size_t ws_size, hipStream_t stream) {
    static int grid = 0;
    if (grid == 0) {
        if (n_in != 20 || out_size != T * D || ws_size < WS_END) { fprintf(stderr, "kernel_launch: unexpected shapes (n_in %d out %d ws %zu)\n", n_in, out_size, ws_size); grid = -1; return; }
        int dev = 0, cus = 0;
        if (hipGetDevice(&dev) != hipSuccess || hipDeviceGetAttribute(&cus, hipDeviceAttributeMultiprocessorCount, dev) != hipSuccess) { grid = -1; return; }
        if (hipFuncSetAttribute((const void*)skel_fwd, hipFuncAttributeMaxDynamicSharedMemorySize, LDS_BYTES) != hipSuccess) { fprintf(stderr, "kernel_launch: hipFuncSetAttribute failed\n"); grid = -1; return; }
        (void)hipGetLastError();
        grid = cus;
    }
    if (grid < 0) return;
    if (hipMemsetAsync((char*)d_ws + WS_CTL, 0, CTL_ZERO_BYTES, stream) != hipSuccess) return;
    Args a{};
    for (int i = 0; i < 20; ++i) a.in[i] = (const float*)d_in[i];
    a.out = (float*)d_out; a.ws = (unsigned char*)d_ws;
    if (N_LAUNCHES == 1) {
        a.ph_lo = 0; a.ph_hi = NPHASES; a.li = 0;
        hipLaunchKernelGGL(skel_fwd, dim3(grid), dim3(NWAVES * 64), LDS_BYTES, stream, a);
    } else {
        for (int li = 0; li < NPHASES; ++li) {
            a.ph_lo = li; a.ph_hi = li + 1; a.li = li;
            hipLaunchKernelGGL(skel_fwd, dim3(grid), dim3(NWAVES * 64), LDS_BYTES, stream, a);
        }
    }
}
```

```cpp
#include <hip/hip_runtime.h>
#include <cstdio>
#include <cstdint>
#include <cmath>

#ifndef MK_N_LAUNCHES
#define MK_N_LAUNCHES 1
#endif

constexpr int BATCH = 2, SEQ = 8192, D = 1024, T = BATCH * SEQ;
constexpr int PROJ_W = 9216;
constexpr int NHEAD = 8, DK = 128;
constexpr int PKH = 8, PKD = 256, NKEYS = 128, TOPK = 16;
constexpr int PLE = 256;
constexpr float LN_EPS = 1e-5f, RMS_EPS = 1e-6f;
constexpr float ALPHA = 1.189207115002721f;
constexpr int NWAVES = 8;
constexpr int NPHASES = 16;
constexpr int N_LAUNCHES = MK_N_LAUNCHES;

constexpr size_t MiB = 1u << 20;
constexpr size_t WS_CTL = 0, CTL_ZERO_BYTES = 1 * MiB;
constexpr size_t WS_WIN = 1 * MiB;
constexpr size_t WS_WA = 19 * MiB, WS_WB = 21 * MiB, WS_WO = 23 * MiB, WS_WPG = 25 * MiB;
constexpr size_t WS_WQ = 27 * MiB;
constexpr size_t WS_SK = 31 * MiB;
constexpr size_t WS_WPP = 31 * MiB + 512 * 1024;
constexpr size_t WS_XB = 32 * MiB;
constexpr size_t WS_BIG = 64 * MiB;
constexpr size_t WS_ZC = 64 * MiB;
constexpr size_t WS_ZG = 160 * MiB;
constexpr size_t WS_VT = 160 * MiB;
constexpr size_t WS_KET = 192 * MiB;
constexpr size_t WS_X1 = 128 * MiB;
constexpr size_t WS_X1B = 192 * MiB;
constexpr size_t WS_OA = 224 * MiB;
constexpr size_t WS_PB = 256 * MiB;
constexpr size_t WS_DEC = 264 * MiB;
constexpr size_t WS_END = 265 * MiB;
constexpr size_t WS_YC = WS_XB;
constexpr size_t WS_IDS = WS_XB;
constexpr size_t WS_GW = WS_XB + 8 * MiB;
constexpr size_t WS_Y = WS_BIG;
constexpr size_t WS_QP = WS_BIG;
constexpr size_t WS_X2B = WS_BIG;
constexpr int CW_BAR = 4096;

constexpr int LDS_BYTES = 147456;
constexpr int RING_BYTES = 131072, LDSCTL_OFF = RING_BYTES, MISC_OFF = LDSCTL_OFF + 320;

#define GAS __attribute__((address_space(1)))
#define LAS __attribute__((address_space(3)))
typedef unsigned short bf16;
typedef unsigned v4u __attribute__((ext_vector_type(4)));
typedef float f32x4 __attribute__((ext_vector_type(4)));
typedef short bf16x8 __attribute__((ext_vector_type(8)));
typedef GAS unsigned gu32;
#define RLX_AGENT __ATOMIC_RELAXED, __HIP_MEMORY_SCOPE_AGENT
#define LDS_WAIT() asm volatile("s_waitcnt lgkmcnt(0)" ::: "memory")

__device__ __forceinline__ unsigned f2bf(float f) { unsigned u = __builtin_bit_cast(unsigned, f); return (u + 0x7fffu + ((u >> 16) & 1u)) >> 16; }
__device__ __forceinline__ unsigned pk2(float lo, float hi) { return f2bf(lo) | (f2bf(hi) << 16); }
__device__ __forceinline__ float bf2f(unsigned short h) { return __builtin_bit_cast(float, (unsigned)h << 16); }
__device__ __forceinline__ float bflo(unsigned w) { return __builtin_bit_cast(float, w << 16); }
__device__ __forceinline__ float bfhi(unsigned w) { return __builtin_bit_cast(float, w & 0xffff0000u); }
__device__ __forceinline__ void unpack8(const v4u w, float (&o)[8]) { o[0] = bflo(w.x); o[1] = bfhi(w.x); o[2] = bflo(w.y); o[3] = bfhi(w.y); o[4] = bflo(w.z); o[5] = bfhi(w.z); o[6] = bflo(w.w); o[7] = bfhi(w.w); }
__device__ __forceinline__ v4u pack8(const float (&v)[8]) { v4u w; w.x = pk2(v[0], v[1]); w.y = pk2(v[2], v[3]); w.z = pk2(v[4], v[5]); w.w = pk2(v[6], v[7]); return w; }
__device__ __forceinline__ float sigmoidf_(float x) { return 1.0f / (1.0f + __expf(-x)); }
__device__ __forceinline__ float wave_sum(float v) {
#pragma unroll
    for (int o = 1; o < 64; o <<= 1) v += __shfl_xor(v, o);
    return v;
}

#define XB_TMO      128
#define XB_XCNT(j)  (256  + 64 * (j))
#define XB_XSUB(j)  (1280 + 64 * (j))
#define XB_XGEN(j)  (2304 + 64 * (j))
#define XB_TOP      3328
#define XB_TOPGEN   3392
#define XCD_BAR_WORDS 3456
#define XB_SPIN_CAP (1u << 26)

__device__ __forceinline__ unsigned xb_ld(unsigned* p)              { return __hip_atomic_load(p, __ATOMIC_RELAXED, __HIP_MEMORY_SCOPE_AGENT); }
__device__ __forceinline__ unsigned xb_add(unsigned* p, unsigned v) { return __hip_atomic_fetch_add(p, v, __ATOMIC_RELAXED, __HIP_MEMORY_SCOPE_AGENT); }
__device__ __forceinline__ unsigned xb_xcc_id() { return (unsigned)__builtin_amdgcn_s_getreg((3 << 11) | 20) & 0xFu; }
#define XB_SPIN(cond, bar) do { unsigned _sp = 0; while (cond) { __builtin_amdgcn_s_sleep(1); \
    if ((++_sp & 255u) == 0u) { if (xb_ld(&(bar)[XB_TMO])) break; if (_sp > XB_SPIN_CAP) { atomicAdd(&(bar)[XB_TMO], 1u); break; } } } } while (0)

struct XcdBarrier { unsigned* bar; unsigned x; volatile LAS unsigned* st; };

__device__ __forceinline__ XcdBarrier xcd_barrier_post(unsigned* bar, volatile LAS unsigned* st) {
    XcdBarrier b; b.bar = bar; b.x = xb_xcc_id(); b.st = st;
    if (threadIdx.x == 0) (void)xb_add(&bar[XB_XCNT(b.x)], 1u);
    return b;
}
__device__ __forceinline__ void xcd_barrier_complete(unsigned* bar, unsigned x, unsigned& nloc, unsigned& nx) {
    const unsigned G = gridDim.x * gridDim.y * gridDim.z;
    unsigned sum, cnt, mine, sp = 0u;
    for (;;) {
        sum = 0u; cnt = 0u; mine = 0u;
#pragma unroll
        for (unsigned j = 0; j < 16; ++j) { const unsigned c = xb_ld(&bar[XB_XCNT(j)]); sum += c; cnt += (c > 0u) ? 1u : 0u; mine = (j == x) ? c : mine; }
        if (sum == G) break;
        __builtin_amdgcn_s_sleep(1);
        if ((++sp & 255u) == 0u) { if (xb_ld(&bar[XB_TMO])) break; if (sp > XB_SPIN_CAP) { atomicAdd(&bar[XB_TMO], 1u); break; } }
    }
    nloc = mine > 0u ? mine : 1u; nx = cnt > 0u ? cnt : 1u;
}
__device__ __forceinline__ void xcd_barrier(const XcdBarrier& b) {
    asm volatile("s_waitcnt vmcnt(0)" ::: "memory");
    __syncthreads();
    if (threadIdx.x == 0) {
        unsigned* bar = b.bar;
        __builtin_amdgcn_s_waitcnt(0);
        unsigned nloc = b.st[0], nx = b.st[1];
        if (nloc == 0u) { xcd_barrier_complete(bar, b.x, nloc, nx); b.st[0] = nloc; b.st[1] = nx; }
        const unsigned old = xb_add(&bar[XB_XSUB(b.x)], 1u);
        const unsigned gen = old / nloc;
        if (old + 1u == (gen + 1u) * nloc) {
            __builtin_amdgcn_fence(__ATOMIC_RELEASE, "agent");
            asm volatile("s_waitcnt vmcnt(0)" ::: "memory");
            const unsigned og = xb_add(&bar[XB_TOP], 1u);
            const unsigned tg = og / nx;
            if (og + 1u == (tg + 1u) * nx) xb_add(&bar[XB_TOPGEN], 1u);
            else XB_SPIN(xb_ld(&bar[XB_TOPGEN]) == tg, bar);
            __builtin_amdgcn_fence(__ATOMIC_ACQUIRE, "agent");
            xb_add(&bar[XB_XGEN(b.x)], 1u);
            asm volatile("s_waitcnt vmcnt(0)" ::: "memory");
        } else {
            XB_SPIN(xb_ld(&bar[XB_XGEN(b.x)]) == gen, bar);
            __builtin_amdgcn_fence(__ATOMIC_ACQUIRE, "agent");
            asm volatile("s_waitcnt vmcnt(0)" ::: "memory");
        }
    }
    __syncthreads();
}

struct Frame {
    LAS unsigned char* lds;
    int tid, lane, wave, vcu, G;
};

struct Args {
    const float* in[20]; float* out; unsigned char* ws; int ph_lo, ph_hi, li, pad;
};

__device__ __forceinline__ void p0_transpose_item(const float* W, int K, int N, bf16* WT, LAS float* scr, int item, int lane) {
    const int nblk = N / 32, kb = item / nblk, nb = item % nblk, k0 = 64 * kb, n0 = 32 * nb;
#pragma unroll 8
    for (int i = 0; i < 32; ++i) { const int kk = 2 * i + (lane >> 5); scr[kk * 33 + (lane & 31)] = W[(size_t)(k0 + kk) * N + n0 + (lane & 31)]; }
    LDS_WAIT(); asm volatile("" ::: "memory");
    const int c = lane & 7;
#pragma unroll
    for (int j = 0; j < 4; ++j) { const int n = (lane >> 3) + 8 * j; const LAS float* s = scr + (8 * c) * 33 + n;
        v4u o; o.x = pk2(s[0 * 33], s[1 * 33]); o.y = pk2(s[2 * 33], s[3 * 33]); o.z = pk2(s[4 * 33], s[5 * 33]); o.w = pk2(s[6 * 33], s[7 * 33]);
        *(v4u*)(WT + (size_t)(n0 + n) * K + k0 + 8 * c) = o; }
    LDS_WAIT(); asm volatile("" ::: "memory");
}
__device__ __forceinline__ void convert_rows(const float* src, bf16* dst, size_t n, int gtid, int nthreads) {
    for (size_t i = (size_t)gtid * 8; i < n; i += (size_t)nthreads * 8) {
        const f32x4 a = *(const f32x4*)(src + i), b = *(const f32x4*)(src + i + 4);
        v4u o; o.x = pk2(a.x, a.y); o.y = pk2(a.z, a.w); o.z = pk2(b.x, b.y); o.w = pk2(b.z, b.w);
        *(v4u*)(dst + i) = o;
    }
}

namespace pg8 {
#define PG8_LAS __attribute__((address_space(3)))
typedef unsigned short bf16_t;
typedef short bf16x8 __attribute__((ext_vector_type(8)));
typedef float f32x4 __attribute__((ext_vector_type(4)));
typedef unsigned u32x4 __attribute__((ext_vector_type(4)));
constexpr int BM = 256, BK = 64, HALF = 128, HTB = HALF * BK * 2  , STAGE_BYTES = 8 * HTB, NXCD = 8, WGM = 8;

__host__ __device__ __forceinline__ int lds_byte(int r, int c) { const int st = (r >> 4) * 2 + (c >> 5), rr = r & 15, cc = c & 31, ob = rr * 64 + cc * 2; return st * 1024 + (ob ^ (((ob >> 9) & 1) << 5)); }
__host__ __device__ __forceinline__ void stage_rc(int b, int& R, int& C) { const int st = b / 1024, sb = b % 1024, swz = sb ^ (((sb >> 9) & 1) << 5); R = (st >> 1) * 16 + swz / 64; C = (st & 1) * 32 + (swz % 64) / 2; }
__host__ __device__ __forceinline__ int perm32(int rho) { const int n = rho >> 4, i = rho & 15; return 8 * (i >> 2) + 4 * n + (i & 3); }

struct Unit { int pm, pn; };
struct Gemm { const bf16_t* A; const bf16_t* Bt; int M, N, K; };

struct StaticOrder {
    int nM, nN, nwg, G, c;
    __host__ __device__ void init(int M, int N, int G_, int c_) { nM = M / BM; nN = N / BM; nwg = nM * nN; G = G_; c = c_; }
    __host__ __device__ bool next(int i, Unit& u) const {
        const long L = (long)i * G + c; if (L >= nwg) return false;
        int wgid = (int)L; { const int q = nwg / NXCD, r = nwg % NXCD, xcd = wgid % NXCD, off = wgid / NXCD; wgid = (xcd < r ? xcd * (q + 1) : r * (q + 1) + (xcd - r) * q) + off; }
        const int nig = WGM * nN, gid = wgid / nig, fm = gid * WGM, gsz = (nM - fm) < WGM ? (nM - fm) : WGM;
        u.pm = fm + ((wgid % nig) % gsz); u.pn = (wgid % nig) / gsz; return true;
    }
    __device__ __forceinline__ void a_ready(const Unit&) const {}
    __device__ __forceinline__ void done(const Unit&) const {}
};

__device__ __forceinline__ unsigned cvt_pk_bf16(float lo, float hi) { unsigned r; asm volatile("v_cvt_pk_bf16_f32 %0, %1, %2" : "=v"(r) : "v"(lo), "v"(hi)); return r; }
typedef float f32x2 __attribute__((ext_vector_type(2)));
template <class Epi, class Sched, bool ALIGN_EPI = false, bool SP2 = false>
__device__ __forceinline__ void gemm_phase(PG8_LAS unsigned char* lds, const Gemm g, const Sched& S, const Epi& E) {
    const int tid = threadIdx.x, wid = __builtin_amdgcn_readfirstlane(tid >> 6), lane = tid & 63, wr = wid >> 2, wc = wid & 3, fr = lane & 15, fq = lane >> 4;
    const int K = g.K, nt = K / BK;
    unsigned voffA[2], voffB[2];
#pragma unroll
    for (int i = 0; i < 2; ++i) { int R, C; stage_rc(tid * 16 + i * 8192, R, C); const int Rb = Epi::PERM ? ((R & ~31) + perm32(R & 31)) : R;
        voffA[i] = (unsigned)(R * K + C) * 2u; voffB[i] = (unsigned)(Rb * K + C) * 2u; }
    const size_t kstep = (size_t)(BK * 2);
    const size_t hstep = (size_t)HALF * K * 2;
    const size_t tstep = 2 * hstep;
    const unsigned ldsw = (unsigned)wid * 1024u;
    const int aoff = lds_byte(wr * 64 + fr, fq * 8), boff = lds_byte(wc * 32 + fr, fq * 8);
#define PG8_SA(b, h) (((b) * 2 + (h)) * HTB)
#define PG8_SB(b, h) ((4 + (b) * 2 + (h)) * HTB)
#define PG8_STAGE(bufoff, gbase, voff) do { _Pragma("unroll") for (int _i = 0; _i < 2; ++_i) \
        __builtin_amdgcn_global_load_lds((const unsigned*)((const char*)(gbase) + (voff)[_i]), (PG8_LAS unsigned*)(lds + (bufoff) + ldsw + _i * 8192), 16, 0, 0); } while (0)
#define PG8_LDA(dst, b, h) do { _Pragma("unroll") for (int m = 0; m < 4; ++m) _Pragma("unroll") for (int k = 0; k < 2; ++k) dst[m][k] = *(const PG8_LAS bf16x8*)(lds + PG8_SA(b, h) + aoff + m * 2048 + k * 1024); } while (0)
#define PG8_LDB(dst, b, h) do { _Pragma("unroll") for (int n = 0; n < 2; ++n) _Pragma("unroll") for (int k = 0; k < 2; ++k) dst[n][k] = *(const PG8_LAS bf16x8*)(lds + PG8_SB(b, h) + boff + n * 2048 + k * 1024); } while (0)
#define PG8_MMA(ai, bj, At, Bt) do { __builtin_amdgcn_s_setprio(1); _Pragma("unroll") for (int m = 0; m < 4; ++m) _Pragma("unroll") for (int n = 0; n < 2; ++n) _Pragma("unroll") for (int k = 0; k < 2; ++k) \
        acc[ai][bj][m][n] = __builtin_amdgcn_mfma_f32_16x16x32_bf16(Bt[n][k], At[m][k], acc[ai][bj][m][n], 0, 0, 0); __builtin_amdgcn_s_setprio(0); } while (0)
#define PG8_WAIT_V(n) asm volatile("s_waitcnt vmcnt(" #n ")" ::: "memory")
#define PG8_WAIT_L(n) asm volatile("s_waitcnt lgkmcnt(" #n ")" ::: "memory")
#define PG8_BAR __builtin_amdgcn_s_barrier()
#define PG8_SCHED __builtin_amdgcn_sched_barrier(0)
    Unit cur, nxt; int ui = 0;
    if (!S.next(0, cur)) return;
    f32x4 acc[2][2][4][2];
#pragma unroll
    for (int a = 0; a < 2; ++a)
#pragma unroll
        for (int b = 0; b < 2; ++b)
#pragma unroll
            for (int m = 0; m < 4; ++m)
#pragma unroll
                for (int n = 0; n < 2; ++n) acc[a][b][m][n] = (f32x4){0.f, 0.f, 0.f, 0.f};
    bf16x8 At[4][2], B0[2][2], B1[2][2];
    const char* cA = (const char*)g.A + (size_t)cur.pm * tstep; const char* cB = (const char*)g.Bt + (size_t)cur.pn * tstep;
    S.a_ready(cur);
    if constexpr (SP2) {
        PG8_STAGE(PG8_SB(0, 0), cB, voffB); PG8_STAGE(PG8_SB(0, 1), cB + hstep, voffB); PG8_STAGE(PG8_SA(0, 0), cA, voffA); PG8_STAGE(PG8_SA(0, 1), cA + hstep, voffA);
        if (wr == 1) PG8_BAR;
        PG8_WAIT_V(2); PG8_BAR;
        PG8_STAGE(PG8_SB(1, 0), cB + kstep, voffB); PG8_STAGE(PG8_SA(1, 0), cA + kstep, voffA); PG8_STAGE(PG8_SB(1, 1), cB + hstep + kstep, voffB);
        PG8_WAIT_V(6); PG8_BAR;
    } else {
        PG8_STAGE(PG8_SB(0, 0), cB, voffB); PG8_STAGE(PG8_SA(0, 0), cA, voffA); PG8_STAGE(PG8_SB(0, 1), cB + hstep, voffB); PG8_STAGE(PG8_SA(0, 1), cA + hstep, voffA);
        if (wr == 1) PG8_BAR;
        PG8_WAIT_V(4); PG8_BAR;
        PG8_STAGE(PG8_SB(1, 0), cB + kstep, voffB); PG8_STAGE(PG8_SA(1, 0), cA + kstep, voffA); PG8_STAGE(PG8_SB(1, 1), cB + hstep + kstep, voffB);
        PG8_WAIT_V(6); PG8_BAR;
    }
    for (;;) {
        const bool has_next = S.next(ui + 1, nxt);
        const char* nA = has_next ? (const char*)g.A + (size_t)nxt.pm * tstep : cA; const char* nB = has_next ? (const char*)g.Bt + (size_t)nxt.pn * tstep : cB;
        for (int t = 0; t < nt; t += 2) {
            const bool last = (t == nt - 2);
            const char* a1 = cA + (size_t)(t + 1) * kstep;
            const char* a2 = last ? nA : cA + (size_t)(t + 2) * kstep; const char* b2 = last ? nB : cB + (size_t)(t + 2) * kstep;
            const char* a3 = a2 + kstep; const char* b3 = b2 + kstep;
            if (last && has_next) S.a_ready(nxt);
            if constexpr (SP2) {
            PG8_LDB(B0, 0, 0); PG8_LDB(B1, 0, 1); PG8_SCHED; PG8_LDA(At, 0, 0); PG8_STAGE(PG8_SA(1, 1), a1 + hstep, voffA);
            PG8_WAIT_V(8); PG8_WAIT_L(0); PG8_BAR; PG8_MMA(0, 0, At, B0); PG8_MMA(0, 1, At, B1); PG8_BAR; PG8_SCHED;
            PG8_LDA(At, 0, 1); PG8_STAGE(PG8_SB(0, 0), b2, voffB); PG8_STAGE(PG8_SB(0, 1), b2 + hstep, voffB); PG8_STAGE(PG8_SA(0, 0), a2, voffA);
            PG8_WAIT_V(8); PG8_WAIT_L(0); PG8_BAR; PG8_MMA(1, 0, At, B0); PG8_MMA(1, 1, At, B1); PG8_BAR; PG8_SCHED;
            PG8_LDB(B0, 1, 0); PG8_LDB(B1, 1, 1); PG8_SCHED; PG8_LDA(At, 1, 0); PG8_STAGE(PG8_SA(0, 1), a2 + hstep, voffA);
            PG8_WAIT_V(8); PG8_WAIT_L(0); PG8_BAR; PG8_MMA(0, 0, At, B0); PG8_MMA(0, 1, At, B1); PG8_BAR; PG8_SCHED;
            PG8_LDA(At, 1, 1); PG8_STAGE(PG8_SB(1, 0), b3, voffB); PG8_STAGE(PG8_SB(1, 1), b3 + hstep, voffB); PG8_STAGE(PG8_SA(1, 0), a3, voffA);
            PG8_WAIT_V(8); PG8_WAIT_L(0); PG8_BAR; PG8_MMA(1, 0, At, B0); PG8_MMA(1, 1, At, B1); PG8_BAR; PG8_SCHED;
            } else {
            PG8_LDB(B0, 0, 0); PG8_SCHED; PG8_LDA(At, 0, 0); PG8_STAGE(PG8_SA(1, 1), a1 + hstep, voffA);
            PG8_WAIT_L(8); PG8_BAR; PG8_WAIT_L(0); PG8_MMA(0, 0, At, B0); PG8_BAR; PG8_SCHED;
            PG8_LDB(B1, 0, 1); PG8_STAGE(PG8_SB(0, 0), b2, voffB);
            PG8_BAR; PG8_WAIT_L(0); PG8_MMA(0, 1, At, B1); PG8_BAR;
            PG8_LDA(At, 0, 1); PG8_STAGE(PG8_SA(0, 0), a2, voffA);
            PG8_BAR; PG8_WAIT_L(0); PG8_MMA(1, 0, At, B0); PG8_BAR; PG8_SCHED;
            PG8_STAGE(PG8_SB(0, 1), b2 + hstep, voffB);
            PG8_WAIT_V(6); PG8_BAR; PG8_MMA(1, 1, At, B1); PG8_BAR;
            PG8_LDB(B0, 1, 0); PG8_SCHED; PG8_LDA(At, 1, 0); PG8_STAGE(PG8_SA(0, 1), a2 + hstep, voffA);
            PG8_WAIT_L(8); PG8_BAR; PG8_WAIT_L(0); PG8_MMA(0, 0, At, B0); PG8_BAR; PG8_SCHED;
            PG8_LDB(B1, 1, 1); PG8_STAGE(PG8_SB(1, 0), b3, voffB);
            PG8_BAR; PG8_WAIT_L(0); PG8_MMA(0, 1, At, B1); PG8_BAR;
            PG8_LDA(At, 1, 1); PG8_STAGE(PG8_SA(1, 0), a3, voffA);
            PG8_BAR; PG8_WAIT_L(0); PG8_MMA(1, 0, At, B0); PG8_BAR; PG8_SCHED;
            PG8_STAGE(PG8_SB(1, 1), b3 + hstep, voffB);
            PG8_WAIT_V(6); PG8_BAR; PG8_MMA(1, 1, At, B1); PG8_BAR;
            }
        }
        if constexpr (ALIGN_EPI) { if (wr == 0) PG8_BAR; }
        if constexpr (!Epi::AFTER_DRAIN) { E(acc, cur, wr, wc, fr, fq); S.done(cur); }
        if (!has_next) break;
#pragma unroll
        for (int a = 0; a < 2; ++a)
#pragma unroll
            for (int b = 0; b < 2; ++b)
#pragma unroll
                for (int m = 0; m < 4; ++m)
#pragma unroll
                    for (int n = 0; n < 2; ++n) acc[a][b][m][n] = (f32x4){0.f, 0.f, 0.f, 0.f};
        cur = nxt; cA = nA; cB = nB; ++ui;
        if constexpr (ALIGN_EPI) { if (wr == 1) PG8_BAR; }
    }
    PG8_WAIT_V(0);
    if constexpr (!ALIGN_EPI) { if (wr == 0) PG8_BAR; }
    PG8_BAR;
    if constexpr (Epi::AFTER_DRAIN) { E.fused(acc, cur, wr, wc, fr, fq, lds, wid, lane); S.done(cur); }
#undef PG8_SA
#undef PG8_SB
#undef PG8_STAGE
#undef PG8_LDA
#undef PG8_LDB
#undef PG8_MMA
#undef PG8_WAIT_V
#undef PG8_WAIT_L
#undef PG8_BAR
#undef PG8_SCHED
}

template <class Fn> struct EpiRow8 {
    static constexpr bool PERM = true, AFTER_DRAIN = false; Fn f;
    __device__ __forceinline__ void operator()(const f32x4 (&acc)[2][2][4][2], const Unit& u, int wr, int wc, int fr, int fq) const {
#pragma unroll
        for (int ai = 0; ai < 2; ++ai)
#pragma unroll
            for (int m = 0; m < 4; ++m) { const int r = u.pm * BM + ai * HALF + wr * 64 + m * 16 + fr;
#pragma unroll
                for (int bj = 0; bj < 2; ++bj) { const int c0 = u.pn * BM + bj * HALF + wc * 32 + 8 * fq;
                    const f32x4 v0 = acc[ai][bj][m][0], v1 = acc[ai][bj][m][1];
                    const float v[8] = {v0[0], v0[1], v0[2], v0[3], v1[0], v1[1], v1[2], v1[3]};
                    f.row8(r, c0, v); } }
    }
};
}

template <class Epi>
__device__ __forceinline__ void naive_gemm(const Frame& F, const bf16* A, const bf16* Bt, int M, int N, int K, const Epi& E) {
    LAS float* As = (LAS float*)F.lds;
    LAS float* Bs = As + 32 * 132;
    const int tid = F.tid, tr = tid >> 4, tc = tid & 15;
    const int ntn = N / 128, nt = (M / 128) * ntn;
    for (int tile = F.vcu; tile < nt; tile += F.G) {
        const int tm = tile / ntn, tn = tile % ntn;
        float acc[4][8];
#pragma unroll
        for (int i = 0; i < 4; ++i)
#pragma unroll
            for (int j = 0; j < 8; ++j) acc[i][j] = 0.f;
        for (int k0 = 0; k0 < K; k0 += 32) {
            { const int r = tid >> 2, kc = (tid & 3) * 8;
              const v4u a = *(const v4u*)(A + (size_t)(tm * 128 + r) * K + k0 + kc);
              const v4u b = *(const v4u*)(Bt + (size_t)(tn * 128 + r) * K + k0 + kc);
              float fa[8], fb[8]; unpack8(a, fa); unpack8(b, fb);
#pragma unroll
              for (int j = 0; j < 8; ++j) { As[(kc + j) * 132 + r] = fa[j]; Bs[(kc + j) * 132 + r] = fb[j]; } }
            __syncthreads();
#pragma unroll 8
            for (int k = 0; k < 32; ++k) {
                const f32x4 a = *(const LAS f32x4*)(As + k * 132 + tr * 4);
                const f32x4 b0 = *(const LAS f32x4*)(Bs + k * 132 + tc * 8), b1 = *(const LAS f32x4*)(Bs + k * 132 + tc * 8 + 4);
#pragma unroll
                for (int i = 0; i < 4; ++i) {
                    acc[i][0] += a[i] * b0.x; acc[i][1] += a[i] * b0.y; acc[i][2] += a[i] * b0.z; acc[i][3] += a[i] * b0.w;
                    acc[i][4] += a[i] * b1.x; acc[i][5] += a[i] * b1.y; acc[i][6] += a[i] * b1.z; acc[i][7] += a[i] * b1.w; }
            }
            __syncthreads();
        }
#pragma unroll
        for (int i = 0; i < 4; ++i) E.row8(tm * 128 + tr * 4 + i, tn * 128 + tc * 8, acc[i]);
    }
}

struct EpiStore { bf16* O; int ldc;
    __device__ __forceinline__ void row8(int r, int c0, const float (&v)[8]) const { *(v4u*)(O + (size_t)r * ldc + c0) = pack8(v); } };
struct EpiZ2 { bf16* ONOA; bf16* Zc; bf16* Zg;
    __device__ __forceinline__ void row8(int r, int c0, const float (&v)[8]) const {
        if (c0 < 1024) { float on[8], o[8]; unpack8(*(const v4u*)(ONOA + (size_t)r * D + c0), on);
#pragma unroll
            for (int j = 0; j < 8; ++j) o[j] = on[j] * (v[j] / (1.0f + __expf(-v[j])));
            *(v4u*)(ONOA + (size_t)r * D + c0) = pack8(o); }
        else if (c0 < 4096) *(v4u*)(Zc + (size_t)r * 3072 + (c0 - 1024)) = pack8(v);
        else *(v4u*)(Zg + (size_t)r * 2048 + (c0 - 4096)) = pack8(v); } };
struct EpiGateA { float* TMP; const bf16* Zg;
    __device__ __forceinline__ void row8(int r, int c0, const float (&v)[8]) const {
        float g[8]; unpack8(*(const v4u*)(Zg + (size_t)r * 2048 + c0), g);
        f32x4 o0, o1; o0.x = sigmoidf_(g[0]) * v[0]; o0.y = sigmoidf_(g[1]) * v[1]; o0.z = sigmoidf_(g[2]) * v[2]; o0.w = sigmoidf_(g[3]) * v[3];
        o1.x = sigmoidf_(g[4]) * v[4]; o1.y = sigmoidf_(g[5]) * v[5]; o1.z = sigmoidf_(g[6]) * v[6]; o1.w = sigmoidf_(g[7]) * v[7];
        *(f32x4*)(TMP + (size_t)r * D + c0) = o0; *(f32x4*)(TMP + (size_t)r * D + c0 + 4) = o1; } };
struct EpiGateB { const float* TMP; const bf16* Zg; bf16* MERGED;
    __device__ __forceinline__ void row8(int r, int c0, const float (&v)[8]) const {
        float g[8]; unpack8(*(const v4u*)(Zg + (size_t)r * 2048 + 1024 + c0), g);
        const f32x4 t0 = *(const f32x4*)(TMP + (size_t)r * D + c0), t1 = *(const f32x4*)(TMP + (size_t)r * D + c0 + 4);
        float o[8]; o[0] = t0.x + sigmoidf_(g[0]) * v[0]; o[1] = t0.y + sigmoidf_(g[1]) * v[1]; o[2] = t0.z + sigmoidf_(g[2]) * v[2]; o[3] = t0.w + sigmoidf_(g[3]) * v[3];
        o[4] = t1.x + sigmoidf_(g[4]) * v[4]; o[5] = t1.y + sigmoidf_(g[5]) * v[5]; o[6] = t1.z + sigmoidf_(g[6]) * v[6]; o[7] = t1.w + sigmoidf_(g[7]) * v[7];
        *(v4u*)(MERGED + (size_t)r * D + c0) = pack8(o); } };
struct EpiResid { const float* X; float* Y;
    __device__ __forceinline__ void row8(int r, int c0, const float (&v)[8]) const {
        const f32x4 x0 = *(const f32x4*)(X + (size_t)r * D + c0), x1 = *(const f32x4*)(X + (size_t)r * D + c0 + 4);
        f32x4 o0, o1; o0.x = ALPHA * x0.x + v[0]; o0.y = ALPHA * x0.y + v[1]; o0.z = ALPHA * x0.z + v[2]; o0.w = ALPHA * x0.w + v[3];
        o1.x = ALPHA * x1.x + v[4]; o1.y = ALPHA * x1.y + v[5]; o1.z = ALPHA * x1.z + v[6]; o1.w = ALPHA * x1.w + v[7];
        *(f32x4*)(Y + (size_t)r * D + c0) = o0; *(f32x4*)(Y + (size_t)r * D + c0 + 4) = o1; } };
struct EpiFinal { const float* X2; const bf16* PP; float* OUT;
    __device__ __forceinline__ void row8(int r, int c0, const float (&v)[8]) const {
        float p[8]; unpack8(*(const v4u*)(PP + (size_t)r * D + c0), p);
        const f32x4 x0 = *(const f32x4*)(X2 + (size_t)r * D + c0), x1 = *(const f32x4*)(X2 + (size_t)r * D + c0 + 4);
        f32x4 o0, o1; o0.x = x0.x + sigmoidf_(v[0]) * p[0]; o0.y = x0.y + sigmoidf_(v[1]) * p[1]; o0.z = x0.z + sigmoidf_(v[2]) * p[2]; o0.w = x0.w + sigmoidf_(v[3]) * p[3];
        o1.x = x1.x + sigmoidf_(v[4]) * p[4]; o1.y = x1.y + sigmoidf_(v[5]) * p[5]; o1.z = x1.z + sigmoidf_(v[6]) * p[6]; o1.w = x1.w + sigmoidf_(v[7]) * p[7];
        *(f32x4*)(OUT + (size_t)r * D + c0) = o0; *(f32x4*)(OUT + (size_t)r * D + c0 + 4) = o1; } };


template <class Fn>
__device__ __forceinline__ void run_gemm(const Frame& F, const bf16* A, const bf16* Bt, int M, int N, int K, const Fn& fn) {
    pg8::Gemm g{A, Bt, M, N, K}; pg8::StaticOrder S; S.init(M, N, F.G, (int)blockIdx.x);
    pg8::EpiRow8<Fn> E{fn};
    pg8::gemm_phase<pg8::EpiRow8<Fn>, pg8::StaticOrder, true, true>(F.lds, g, S, E);
}

__device__ __forceinline__ void ln_row_store(f32x4 (&v)[4], const float* g, const float* b, float* orow, bf16* obrow, int lane) {
    float s = 0.f;
#pragma unroll
    for (int j = 0; j < 4; ++j) s += (v[j].x + v[j].y) + (v[j].z + v[j].w);
    const float mean = wave_sum(s) * (1.f / D); float s2 = 0.f;
#pragma unroll
    for (int j = 0; j < 4; ++j) { v[j] = v[j] - mean; s2 += (v[j].x * v[j].x + v[j].y * v[j].y) + (v[j].z * v[j].z + v[j].w * v[j].w); }
    const float rstd = 1.f / sqrtf(wave_sum(s2) * (1.f / D) + LN_EPS);
#pragma unroll
    for (int j = 0; j < 4; ++j) {
        const f32x4 gg = *(const f32x4*)(g + 4 * lane + 256 * j), bb = *(const f32x4*)(b + 4 * lane + 256 * j);
        const f32x4 o = v[j] * rstd * gg + bb;
        *(f32x4*)(orow + 4 * lane + 256 * j) = o;
        unsigned long long w = (unsigned long long)pk2(o.x, o.y) | ((unsigned long long)pk2(o.z, o.w) << 32);
        *(unsigned long long*)(obrow + 4 * lane + 256 * j) = w;
    }
}
__device__ __forceinline__ float gelu_erf(float x) { return 0.5f * x * (1.0f + erff(x * 0.70710678118654752f)); }

__global__ void __launch_bounds__(NWAVES * 64, 2) skel_fwd(Args args) {
    extern __shared__ __attribute__((aligned(16))) unsigned char lds[];
    Frame F;
    F.lds = (LAS unsigned char*)lds;
    F.tid = threadIdx.x; F.lane = F.tid & 63; F.wave = __builtin_amdgcn_readfirstlane(F.tid >> 6);
    F.G = gridDim.x; { const int bx = blockIdx.x; F.vcu = (F.G % 8 == 0) ? (bx % 8) * (F.G / 8) + bx / 8 : bx; }
    unsigned char* ws = args.ws;
    volatile LAS unsigned* MISC = (volatile LAS unsigned*)(F.lds + MISC_OFF);
    for (int u = F.tid; u < (LDS_BYTES - LDSCTL_OFF) / 4; u += NWAVES * 64) ((LAS unsigned*)(F.lds + LDSCTL_OFF))[u] = 0u;
    __syncthreads();
    XcdBarrier bar; bar.bar = (unsigned*)(ws + WS_CTL) + CW_BAR; bar.x = 0; bar.st = nullptr;
    if (N_LAUNCHES == 1) bar = xcd_barrier_post((unsigned*)(ws + WS_CTL) + CW_BAR, MISC + 8);
    const int lo = args.ph_lo, hi = args.ph_hi;
#define IN(k) (lo <= (k) && (k) < hi)
#define SEAM(k) do { if (IN(k) && IN((k) + 1)) xcd_barrier(bar); } while (0)

    const float* x = args.in[0]; const float* p = args.in[1]; const float* w_in = args.in[2]; const float* lb_param = args.in[3];
    const float* hg_norm_g = args.in[4]; const float* conv_w = args.in[5]; const float* conv_b = args.in[6];
    const float* w_a = args.in[7]; const float* w_b = args.in[8]; const float* w_out = args.in[9];
    const float* ln1_g = args.in[10]; const float* ln1_b = args.in[11]; const float* pk_wq = args.in[12]; const float* pk_sk = args.in[13];
    const float* pk_u = args.in[14]; const float* pk_v = args.in[15]; const float* ln2_g = args.in[16]; const float* ln2_b = args.in[17];
    const float* w_pg = args.in[18]; const float* w_pp = args.in[19];
    float* out = args.out;
    bf16* WinT = (bf16*)(ws + WS_WIN); bf16* WaT = (bf16*)(ws + WS_WA); bf16* WbT = (bf16*)(ws + WS_WB); bf16* WoT = (bf16*)(ws + WS_WO);
    bf16* WpgT = (bf16*)(ws + WS_WPG); bf16* WqT = (bf16*)(ws + WS_WQ); bf16* SKB = (bf16*)(ws + WS_SK); bf16* WppT = (bf16*)(ws + WS_WPP);
    bf16* XB = (bf16*)(ws + WS_XB); bf16* PB = (bf16*)(ws + WS_PB);
    bf16* Zhg = (bf16*)(ws + WS_BIG); bf16* Zc = (bf16*)(ws + WS_ZC); bf16* Zg = (bf16*)(ws + WS_ZG);
    bf16* UB = (bf16*)out; bf16* VB = (bf16*)out + (size_t)16384 * D;
    bf16* ST = (bf16*)out;
    bf16* VT = (bf16*)(ws + WS_VT); bf16* KET = (bf16*)(ws + WS_KET); float* DEC = (float*)(ws + WS_DEC); bf16* ON = (bf16*)(ws + WS_OA);
    bf16* OA = (bf16*)(ws + WS_OA); bf16* YC = (bf16*)(ws + WS_YC);
    float* TMP = (float*)(ws + WS_ZC);
    bf16* MERGED = (bf16*)(ws + WS_OA);
    float* Y = (float*)(ws + WS_Y); float* X1 = (float*)(ws + WS_X1); bf16* X1B = (bf16*)(ws + WS_X1B);
    bf16* QP = (bf16*)(ws + WS_QP); bf16* PP = (bf16*)(ws + WS_OA);
    int* IDS = (int*)(ws + WS_IDS); float* GW = (float*)(ws + WS_GW);
    bf16* X2B = (bf16*)(ws + WS_X2B);

    const int gtid = F.vcu * (NWAVES * 64) + F.tid, NT = F.G * NWAVES * 64;
    const int gw = F.vcu * NWAVES + F.wave, NGW = F.G * NWAVES;

    if (IN(0)) {
        LAS float* scr = (LAS float*)(F.lds + F.wave * 16384);
        constexpr int I_IN = (D / 64) * (PROJ_W / 32), I_SQ = (D / 64) * (D / 32), I_Q = (D / 64) * (2048 / 32), I_PP = (PLE / 64) * (D / 32);
        constexpr int NITEMS = I_IN + 4 * I_SQ + I_Q + I_PP;
        for (int it = gw; it < NITEMS; it += NGW) {
            int r = it;
            if (r < I_IN) { p0_transpose_item(w_in, D, PROJ_W, WinT, scr, r, F.lane); continue; } r -= I_IN;
            if (r < I_SQ) { p0_transpose_item(w_a, D, D, WaT, scr, r, F.lane); continue; } r -= I_SQ;
            if (r < I_SQ) { p0_transpose_item(w_b, D, D, WbT, scr, r, F.lane); continue; } r -= I_SQ;
            if (r < I_SQ) { p0_transpose_item(w_out, D, D, WoT, scr, r, F.lane); continue; } r -= I_SQ;
            if (r < I_SQ) { p0_transpose_item(w_pg, D, D, WpgT, scr, r, F.lane); continue; } r -= I_SQ;
            if (r < I_Q) { p0_transpose_item(pk_wq, D, 2048, WqT, scr, r, F.lane); continue; } r -= I_Q;
            p0_transpose_item(w_pp, PLE, D, WppT, scr, r, F.lane);
        }
        convert_rows(x, XB, (size_t)T * D, gtid, NT);
        convert_rows(p, PB, (size_t)T * PLE, gtid, NT);
        convert_rows(pk_sk, SKB, (size_t)PKH * 2 * NKEYS * 128, gtid, NT);
    }
    SEAM(0);
    if (IN(1)) { EpiStore E{Zhg, 3072}; run_gemm(F, XB, WinT, T, 3072, D, E); }
    SEAM(1);
    if (IN(2)) {
        LAS float* tot = (LAS float*)F.lds;
        for (int unit = F.vcu; unit < 2048; unit += F.G) {
            const int n = unit >> 3, h = unit & 7, row0 = n * 64;
            const int c = F.tid & 127, sgm = F.tid >> 7, ch = h * 128 + c;
            const float lb = 1.0f / (1.0f + expf(lb_param[1024 + ch] - lb_param[ch]));
            float lf[16], kk[16];
            float run = 0.f;
#pragma unroll
            for (int i = 0; i < 16; ++i) { const size_t tok = (size_t)row0 + sgm * 16 + i;
                const float fz = bf2f(Zhg[tok * 3072 + 1024 + ch]); const float sg = 1.0f / (1.0f + expf(-fz));
                const float f = lb + (1.0f - lb) * sg; kk[i] = (1.0f - lb) * (1.0f - sg); run += logf(f); lf[i] = run; }
            tot[sgm * 128 + c] = run;
            __syncthreads();
            float off = 0.f, total = 0.f;
#pragma unroll
            for (int s2 = 0; s2 < 4; ++s2) { const float tv = tot[s2 * 128 + c]; total += tv; if (s2 < sgm) off += tv; }
            __syncthreads();
            float kev[16], vv[16];
#pragma unroll
            for (int i = 0; i < 16; ++i) { const size_t tok = (size_t)row0 + sgm * 16 + i; const float bc = lf[i] + off;
                const float q = bf2f(Zhg[tok * 3072 + ch]) * 0.08838834764831845f;
                const float qe = q * expf(bc), ke = kk[i] * expf(-bc);
                vv[i] = bf2f(Zhg[tok * 3072 + 2048 + ch]);
                Zhg[tok * 3072 + ch] = (bf16)f2bf(qe); Zhg[tok * 3072 + 1024 + ch] = (bf16)f2bf(ke); kev[i] = ke; }
            { float t0[8], t1[8];
#pragma unroll
              for (int i = 0; i < 8; ++i) { t0[i] = kev[i]; t1[i] = kev[8 + i]; }
              bf16* dst = KET + ((size_t)unit * 128 + c) * 64 + sgm * 16; *(v4u*)dst = pack8(t0); *(v4u*)(dst + 8) = pack8(t1);
#pragma unroll
              for (int i = 0; i < 8; ++i) { t0[i] = vv[i]; t1[i] = vv[8 + i]; }
              dst = VT + ((size_t)unit * 128 + c) * 64 + sgm * 16; *(v4u*)dst = pack8(t0); *(v4u*)(dst + 8) = pack8(t1); }
            if (sgm == 0) DEC[(size_t)n * 1024 + ch] = expf(total);
        }
    }
    SEAM(2);
    if (IN(3)) {
        const int q4 = F.lane >> 4, l15 = F.lane & 15;
        for (int unit = gw; unit < 2048; unit += NGW) {
            const int n = unit >> 3, h = unit & 7;
            const bf16* ket = KET + (size_t)unit * 128 * 64; const bf16* vt = VT + (size_t)unit * 128 * 64;
            bf16x8 a[8][2];
#pragma unroll
            for (int t = 0; t < 8; ++t)
#pragma unroll
                for (int s2 = 0; s2 < 2; ++s2) a[t][s2] = *(const bf16x8*)(ket + (16 * t + l15) * 64 + 32 * s2 + 8 * q4);
            f32x4 dc[8];
#pragma unroll
            for (int t = 0; t < 8; ++t) dc[t] = *(const f32x4*)(DEC + (size_t)n * 1024 + h * 128 + 16 * t + 4 * q4);
            for (int qd = 0; qd < 4; ++qd) {
                bf16x8 b[2][2];
#pragma unroll
                for (int cc = 0; cc < 2; ++cc)
#pragma unroll
                    for (int s2 = 0; s2 < 2; ++s2) b[cc][s2] = *(const bf16x8*)(vt + (32 * qd + 16 * cc + l15) * 64 + 32 * s2 + 8 * q4);
#pragma unroll
                for (int t = 0; t < 8; ++t)
#pragma unroll
                    for (int cc = 0; cc < 2; ++cc) {
                        f32x4 acc = (f32x4){0.f, 0.f, 0.f, 0.f};
                        acc = __builtin_amdgcn_mfma_f32_16x16x32_bf16(a[t][0], b[cc][0], acc, 0, 0, 0);
                        acc = __builtin_amdgcn_mfma_f32_16x16x32_bf16(a[t][1], b[cc][1], acc, 0, 0, 0);
                        acc = acc * dc[t];
                        const int dv = 32 * qd + 16 * cc + l15;
                        unsigned long long w = (unsigned long long)pk2(acc[0], acc[1]) | ((unsigned long long)pk2(acc[2], acc[3]) << 32);
                        *(unsigned long long*)(ST + ((size_t)unit * 128 + dv) * 128 + 16 * t + 4 * q4) = w;
                    }
            }
        }
    }
    SEAM(3);
    if (IN(4)) {
        for (int i = gtid; i < 65536; i += NT) {
            const int dk4 = i & 31, dv = (i >> 5) & 127, h = (i >> 12) & 7, b = i >> 15;
            f32x4 st = (f32x4){0.f, 0.f, 0.f, 0.f};
#pragma unroll 8
            for (int cn = 0; cn < 128; ++cn) {
                const int n = b * 128 + cn; const size_t unit = (size_t)n * 8 + h;
                unsigned long long* ptr = (unsigned long long*)(ST + (unit * 128 + dv) * 128 + dk4 * 4);
                const unsigned long long d = *ptr;
                const f32x4 dc = *(const f32x4*)(DEC + (size_t)n * 1024 + h * 128 + dk4 * 4);
                *ptr = (unsigned long long)pk2(st[0], st[1]) | ((unsigned long long)pk2(st[2], st[3]) << 32);
                const f32x4 dd = (f32x4){bflo((unsigned)d), bfhi((unsigned)d), bflo((unsigned)(d >> 32)), bfhi((unsigned)(d >> 32))};
                st = dc * st + dd;
            }
        }
    }
    SEAM(4);
    if (IN(5)) {
        const int q4 = F.lane >> 4, l15 = F.lane & 15;
        LAS bf16* Pl = (LAS bf16*)(F.lds + F.wave * 8192);
        for (int unit = gw; unit < 2048; unit += NGW) {
            const int n = unit >> 3, h = unit & 7, row0 = n * 64;
            const bf16* st = ST + (size_t)unit * 128 * 128; const bf16* vt = VT + (size_t)unit * 128 * 64;
            for (int half = 0; half < 2; ++half) {
                const int i0 = half * 32;
                bf16x8 qf[2][4];
#pragma unroll
                for (int it = 0; it < 2; ++it)
#pragma unroll
                    for (int ks = 0; ks < 4; ++ks) qf[it][ks] = *(const bf16x8*)(Zhg + (size_t)(row0 + i0 + 16 * it + l15) * 3072 + h * 128 + 32 * ks + 8 * q4);
                f32x4 acc[8][2];
#pragma unroll
                for (int dvt = 0; dvt < 8; ++dvt) { acc[dvt][0] = (f32x4){0.f, 0.f, 0.f, 0.f}; acc[dvt][1] = (f32x4){0.f, 0.f, 0.f, 0.f}; }
#pragma unroll
                for (int dvt = 0; dvt < 8; ++dvt)
#pragma unroll
                    for (int ks = 0; ks < 4; ++ks) { const bf16x8 a = *(const bf16x8*)(st + (16 * dvt + l15) * 128 + 32 * ks + 8 * q4);
                        acc[dvt][0] = __builtin_amdgcn_mfma_f32_16x16x32_bf16(a, qf[0][ks], acc[dvt][0], 0, 0, 0);
                        acc[dvt][1] = __builtin_amdgcn_mfma_f32_16x16x32_bf16(a, qf[1][ks], acc[dvt][1], 0, 0, 0); }
                const int njt = 2 * (half + 1);
                for (int jt = 0; jt < njt; ++jt) {
                    f32x4 p0 = (f32x4){0.f, 0.f, 0.f, 0.f}, p1 = (f32x4){0.f, 0.f, 0.f, 0.f};
#pragma unroll
                    for (int ks = 0; ks < 4; ++ks) { const bf16x8 a = *(const bf16x8*)(Zhg + (size_t)(row0 + 16 * jt + l15) * 3072 + 1024 + h * 128 + 32 * ks + 8 * q4);
                        p0 = __builtin_amdgcn_mfma_f32_16x16x32_bf16(a, qf[0][ks], p0, 0, 0, 0);
                        p1 = __builtin_amdgcn_mfma_f32_16x16x32_bf16(a, qf[1][ks], p1, 0, 0, 0); }
                    const int jb = 16 * jt + 4 * q4;
                    { const int ii = i0 + l15;
                      const float m0 = (jb + 0 <= ii) ? p0[0] : 0.f, m1 = (jb + 1 <= ii) ? p0[1] : 0.f, m2 = (jb + 2 <= ii) ? p0[2] : 0.f, m3 = (jb + 3 <= ii) ? p0[3] : 0.f;
                      *(LAS unsigned long long*)(Pl + l15 * 72 + jb) = (unsigned long long)pk2(m0, m1) | ((unsigned long long)pk2(m2, m3) << 32); }
                    { const int ii = i0 + 16 + l15;
                      const float m0 = (jb + 0 <= ii) ? p1[0] : 0.f, m1 = (jb + 1 <= ii) ? p1[1] : 0.f, m2 = (jb + 2 <= ii) ? p1[2] : 0.f, m3 = (jb + 3 <= ii) ? p1[3] : 0.f;
                      *(LAS unsigned long long*)(Pl + (16 + l15) * 72 + jb) = (unsigned long long)pk2(m0, m1) | ((unsigned long long)pk2(m2, m3) << 32); }
                }
                LDS_WAIT(); asm volatile("" ::: "memory");
                const int nks = half + 1;
                for (int kj = 0; kj < nks; ++kj) {
                    const bf16x8 b0 = *(const LAS bf16x8*)(Pl + l15 * 72 + 32 * kj + 8 * q4), b1 = *(const LAS bf16x8*)(Pl + (16 + l15) * 72 + 32 * kj + 8 * q4);
#pragma unroll
                    for (int dvt = 0; dvt < 8; ++dvt) { const bf16x8 a = *(const bf16x8*)(vt + (16 * dvt + l15) * 64 + 32 * kj + 8 * q4);
                        acc[dvt][0] = __builtin_amdgcn_mfma_f32_16x16x32_bf16(a, b0, acc[dvt][0], 0, 0, 0);
                        acc[dvt][1] = __builtin_amdgcn_mfma_f32_16x16x32_bf16(a, b1, acc[dvt][1], 0, 0, 0); }
                }
#pragma unroll
                for (int it = 0; it < 2; ++it) {
                    float ss = 0.f;
#pragma unroll
                    for (int dvt = 0; dvt < 8; ++dvt) { const f32x4 v = acc[dvt][it]; ss += (v[0] * v[0] + v[1] * v[1]) + (v[2] * v[2] + v[3] * v[3]); }
                    ss += __shfl_xor(ss, 16); ss += __shfl_xor(ss, 32);
                    const float rinv = 1.0f / sqrtf(ss * (1.0f / 128.0f) + RMS_EPS);
                    const size_t tok = (size_t)row0 + i0 + 16 * it + l15;
#pragma unroll
                    for (int dvt = 0; dvt < 8; ++dvt) { const f32x4 g4 = *(const f32x4*)(hg_norm_g + h * 128 + 16 * dvt + 4 * q4); const f32x4 o = acc[dvt][it] * rinv * g4;
                        *(unsigned long long*)(ON + tok * D + h * 128 + 16 * dvt + 4 * q4) = (unsigned long long)pk2(o[0], o[1]) | ((unsigned long long)pk2(o[2], o[3]) << 32); }
                }
                LDS_WAIT(); asm volatile("" ::: "memory");
            }
        }
    }
    SEAM(5);
    if (IN(6)) { EpiZ2 E{ON, Zc, Zg}; run_gemm(F, XB, WinT + (size_t)3072 * D, T, 6144, D, E); }
    SEAM(6);
    if (IN(7)) {
        for (int i = gtid; i < T * (D / 8); i += NT) {
            const int row = i / (D / 8), c0 = (i % (D / 8)) * 8, t = row % SEQ;
            float cb[8], u0[8], u1[8], u2[8], a[8], b[8];
            unpack8(*(const v4u*)(Zc + (size_t)row * 3072 + c0), cb);
            unpack8(*(const v4u*)(Zc + (size_t)row * 3072 + 1024 + c0), a); unpack8(*(const v4u*)(Zc + (size_t)row * 3072 + 2048 + c0), b);
#pragma unroll
            for (int j = 0; j < 8; ++j) u2[j] = a[j] * b[j];
            if (t >= 1) { unpack8(*(const v4u*)(Zc + (size_t)(row - 1) * 3072 + 1024 + c0), a); unpack8(*(const v4u*)(Zc + (size_t)(row - 1) * 3072 + 2048 + c0), b);
#pragma unroll
                for (int j = 0; j < 8; ++j) u1[j] = a[j] * b[j]; }
            else {
#pragma unroll
                for (int j = 0; j < 8; ++j) u1[j] = 0.f; }
            if (t >= 2) { unpack8(*(const v4u*)(Zc + (size_t)(row - 2) * 3072 + 1024 + c0), a); unpack8(*(const v4u*)(Zc + (size_t)(row - 2) * 3072 + 2048 + c0), b);
#pragma unroll
                for (int j = 0; j < 8; ++j) u0[j] = a[j] * b[j]; }
            else {
#pragma unroll
                for (int j = 0; j < 8; ++j) u0[j] = 0.f; }
            float y[8];
#pragma unroll
            for (int j = 0; j < 8; ++j) { const int c = c0 + j; y[j] = cb[j] * (conv_b[c] + conv_w[c] * u0[j] + conv_w[1024 + c] * u1[j] + conv_w[2048 + c] * u2[j]); }
            *(v4u*)(YC + (size_t)row * D + c0) = pack8(y);
        }
        convert_rows(pk_u, UB, (size_t)16384 * D, gtid, NT);
        convert_rows(pk_v, VB, (size_t)16384 * D, gtid, NT);
    }
    SEAM(7);
    if (IN(8)) { EpiGateA E{TMP, Zg}; run_gemm(F, OA, WaT, T, D, D, E); }
    SEAM(8);
    if (IN(9)) { EpiGateB E{TMP, Zg, MERGED}; run_gemm(F, YC, WbT, T, D, D, E); }
    SEAM(9);
    if (IN(10)) { EpiResid E{x, Y}; run_gemm(F, MERGED, WoT, T, D, D, E); }
    SEAM(10);
    if (IN(11)) {
        for (int row = gw; row < T; row += NGW) {
            f32x4 v[4];
#pragma unroll
            for (int j = 0; j < 4; ++j) v[j] = *(const f32x4*)(Y + (size_t)row * D + 4 * F.lane + 256 * j);
            ln_row_store(v, ln1_g, ln1_b, X1 + (size_t)row * D, X1B + (size_t)row * D, F.lane);
        }
    }
    SEAM(11);
    if (IN(12)) {
        { EpiStore E{QP, 2048}; run_gemm(F, X1B, WqT, T, 2048, D, E); }
        { EpiStore E{PP, D}; run_gemm(F, PB, WppT, T, D, PLE, E); }
    }
    SEAM(12);
    if (IN(13)) {
        LAS float* sq = (LAS float*)(F.lds + F.wave * 16384);
        const float NEG = -3.0e38f;
        for (int task = gw; task < T * PKH; task += NGW) {
            const int t = task >> 3, h = task & 7, lane = F.lane;
            { const unsigned long long w = *(const unsigned long long*)(QP + (size_t)t * 2048 + h * 256 + lane * 4);
              sq[lane * 4 + 0] = bflo((unsigned)w); sq[lane * 4 + 1] = bfhi((unsigned)w); sq[lane * 4 + 2] = bflo((unsigned)(w >> 32)); sq[lane * 4 + 3] = bfhi((unsigned)(w >> 32)); }
            LDS_WAIT(); asm volatile("" ::: "memory");
            float s[2][2];
#pragma unroll
            for (int pp = 0; pp < 2; ++pp)
#pragma unroll
                for (int j = 0; j < 2; ++j) {
                    const bf16* krow = SKB + ((size_t)((h * 2 + pp) * 128 + lane + 64 * j)) * 128;
                    float a = 0.f;
#pragma unroll 4
                    for (int d8 = 0; d8 < 16; ++d8) { float kv[8]; unpack8(*(const v4u*)(krow + d8 * 8), kv);
                        const f32x4 q0 = *(const LAS f32x4*)(sq + pp * 128 + d8 * 8), q1 = *(const LAS f32x4*)(sq + pp * 128 + d8 * 8 + 4);
                        a += q0.x * kv[0] + q0.y * kv[1] + q0.z * kv[2] + q0.w * kv[3] + q1.x * kv[4] + q1.y * kv[5] + q1.z * kv[6] + q1.w * kv[7]; }
                    s[pp][j] = a;
                }
            float myv[2] = {0.f, 0.f}; int myi[2] = {0, 0};
#pragma unroll
            for (int pp = 0; pp < 2; ++pp) {
                float a0 = s[pp][0], a1 = s[pp][1];
                for (int it = 0; it < TOPK; ++it) {
                    float bv; int bi;
                    if (a0 >= a1) { bv = a0; bi = lane; } else { bv = a1; bi = lane + 64; }
#pragma unroll
                    for (int off = 32; off >= 1; off >>= 1) { const float ov = __shfl_xor(bv, off); const int oi = __shfl_xor(bi, off);
                        if (ov > bv || (ov == bv && oi < bi)) { bv = ov; bi = oi; } }
                    if (lane == it) { myv[pp] = bv; myi[pp] = bi; }
                    if (bi == lane) a0 = NEG; if (bi == lane + 64) a1 = NEG;
                }
            }
            float cv[4];
            { const int a = lane >> 2; const float s1 = __shfl(myv[0], a);
#pragma unroll
              for (int j = 0; j < 4; ++j) { const int b = (lane & 3) * 4 + j; cv[j] = s1 + __shfl(myv[1], b); } }
            float topv = 0.f; int tope = 0;
            for (int it = 0; it < TOPK; ++it) {
                float bv = cv[0]; int bi = lane * 4;
#pragma unroll
                for (int j = 1; j < 4; ++j) if (cv[j] > bv) { bv = cv[j]; bi = lane * 4 + j; }
#pragma unroll
                for (int off = 32; off >= 1; off >>= 1) { const float ov = __shfl_xor(bv, off); const int oi = __shfl_xor(bi, off);
                    if (ov > bv || (ov == bv && oi < bi)) { bv = ov; bi = oi; } }
                const int e = __shfl(myi[0], bi >> 4) * 128 + __shfl(myi[1], bi & 15);
                if (lane == it) { topv = bv; tope = e; }
#pragma unroll
                for (int j = 0; j < 4; ++j) if (bi == lane * 4 + j) cv[j] = NEG;
            }
            const float mx = __shfl(topv, 0);
            float ev = (lane < TOPK) ? expf(topv - mx) : 0.f;
            float sum = ev; sum += __shfl_xor(sum, 1); sum += __shfl_xor(sum, 2); sum += __shfl_xor(sum, 4); sum += __shfl_xor(sum, 8);
            if (lane < TOPK) { IDS[(size_t)t * 128 + h * 16 + lane] = tope; GW[(size_t)t * 128 + h * 16 + lane] = ev / sum; }
            LDS_WAIT(); asm volatile("" ::: "memory");
        }
    }
    SEAM(13);
    if (IN(14)) {
        const int lane = F.lane, q4 = lane >> 4, l15 = lane & 15;
        LAS bf16* xs = (LAS bf16*)(F.lds + F.wave * 4096);
        for (int t = gw; t < T; t += NGW) {
            { const v4u a = *(const v4u*)(X1B + (size_t)t * D + lane * 16), b = *(const v4u*)(X1B + (size_t)t * D + lane * 16 + 8);
              *(LAS v4u*)(xs + lane * 16) = a; *(LAS v4u*)(xs + lane * 16 + 8) = b; }
            const int id0 = IDS[(size_t)t * 128 + lane], id1 = IDS[(size_t)t * 128 + 64 + lane];
            const bf16* urow[8];
#pragma unroll
            for (int bb = 0; bb < 8; ++bb) { const int e = __shfl(bb < 4 ? id0 : id1, (bb & 3) * 16 + l15); urow[bb] = UB + (size_t)e * D + 8 * q4; }
            f32x4 hacc[8];
#pragma unroll
            for (int bb = 0; bb < 8; ++bb) hacc[bb] = (f32x4){0.f, 0.f, 0.f, 0.f};
            LDS_WAIT(); asm volatile("" ::: "memory");
            for (int sp = 0; sp < 16; ++sp) {
                const bf16x8 b0 = *(const LAS bf16x8*)(xs + 64 * sp + 8 * q4), b1 = *(const LAS bf16x8*)(xs + 64 * sp + 32 + 8 * q4);
                bf16x8 a0[8], a1[8];
#pragma unroll
                for (int bb = 0; bb < 8; ++bb) { a0[bb] = *(const bf16x8*)(urow[bb] + 64 * sp); a1[bb] = *(const bf16x8*)(urow[bb] + 64 * sp + 32); }
#pragma unroll
                for (int bb = 0; bb < 8; ++bb) { hacc[bb] = __builtin_amdgcn_mfma_f32_16x16x32_bf16(a0[bb], b0, hacc[bb], 0, 0, 0);
                                                  hacc[bb] = __builtin_amdgcn_mfma_f32_16x16x32_bf16(a1[bb], b1, hacc[bb], 0, 0, 0); }
            }
#pragma unroll
            for (int bb = 0; bb < 8; ++bb) { const f32x4 g4 = *(const f32x4*)(GW + (size_t)t * 128 + bb * 16 + 4 * q4);
#pragma unroll
                for (int r = 0; r < 4; ++r) hacc[bb][r] = g4[r] * gelu_erf(hacc[bb][r]); }
            float o[16];
#pragma unroll
            for (int j = 0; j < 16; ++j) o[j] = 0.f;
#pragma unroll
            for (int bb = 0; bb < 8; ++bb) {
#pragma unroll
                for (int qq = 0; qq < 4; ++qq)
#pragma unroll
                    for (int r = 0; r < 4; ++r) {
                        const int i = bb * 16 + qq * 4 + r;
                        const float hv = hacc[bb][r];
                        const float w = __builtin_bit_cast(float, __builtin_amdgcn_readlane(__builtin_bit_cast(int, hv), qq * 16));
                        const int e = __builtin_amdgcn_readlane(i < 64 ? id0 : id1, i & 63);
                        const bf16* vr = VB + (size_t)e * D + lane * 16;
                        const v4u v0 = *(const v4u*)vr, v1 = *(const v4u*)(vr + 8);
                        o[0] += w * bflo(v0.x); o[1] += w * bfhi(v0.x); o[2] += w * bflo(v0.y); o[3] += w * bfhi(v0.y);
                        o[4] += w * bflo(v0.z); o[5] += w * bfhi(v0.z); o[6] += w * bflo(v0.w); o[7] += w * bfhi(v0.w);
                        o[8] += w * bflo(v1.x); o[9] += w * bfhi(v1.x); o[10] += w * bflo(v1.y); o[11] += w * bfhi(v1.y);
                        o[12] += w * bflo(v1.z); o[13] += w * bfhi(v1.z); o[14] += w * bflo(v1.w); o[15] += w * bfhi(v1.w);
                    }
            }
            float* xrow = X1 + (size_t)t * D + lane * 16;
            float sm = 0.f;
#pragma unroll
            for (int j = 0; j < 4; ++j) { const f32x4 xv = *(const f32x4*)(xrow + 4 * j);
                o[4 * j] += ALPHA * xv.x; o[4 * j + 1] += ALPHA * xv.y; o[4 * j + 2] += ALPHA * xv.z; o[4 * j + 3] += ALPHA * xv.w; }
#pragma unroll
            for (int j = 0; j < 16; ++j) sm += o[j];
            const float mean = wave_sum(sm) * (1.f / D); float s2 = 0.f;
#pragma unroll
            for (int j = 0; j < 16; ++j) { o[j] -= mean; s2 += o[j] * o[j]; }
            const float rstd = 1.f / sqrtf(wave_sum(s2) * (1.f / D) + LN_EPS);
            float res[16];
#pragma unroll
            for (int j = 0; j < 4; ++j) { const f32x4 gg = *(const f32x4*)(ln2_g + lane * 16 + 4 * j), bb4 = *(const f32x4*)(ln2_b + lane * 16 + 4 * j);
                f32x4 r4; r4.x = o[4 * j] * rstd * gg.x + bb4.x; r4.y = o[4 * j + 1] * rstd * gg.y + bb4.y; r4.z = o[4 * j + 2] * rstd * gg.z + bb4.z; r4.w = o[4 * j + 3] * rstd * gg.w + bb4.w;
                *(f32x4*)(xrow + 4 * j) = r4; res[4 * j] = r4.x; res[4 * j + 1] = r4.y; res[4 * j + 2] = r4.z; res[4 * j + 3] = r4.w; }
            { float r0[8], r1[8];
#pragma unroll
              for (int j = 0; j < 8; ++j) { r0[j] = res[j]; r1[j] = res[8 + j]; }
              *(v4u*)(X2B + (size_t)t * D + lane * 16) = pack8(r0); *(v4u*)(X2B + (size_t)t * D + lane * 16 + 8) = pack8(r1); }
            LDS_WAIT(); asm volatile("" ::: "memory");
        }
    }
    SEAM(14);
    if (IN(15)) { EpiFinal E{X1, PP, out}; run_gemm(F, X2B, WpgT, T, D, D, E); }
#undef IN
#undef SEAM
}

extern "C" void kernel_launch(void* const* d_in, const int* in_sizes, int n_in, void* d_out, int out_size, void* d_ws, size_t ws_size, hipStream_t stream) {
    static int grid = 0;
    if (grid == 0) {
        if (n_in != 20 || out_size != T * D || ws_size < WS_END) { fprintf(stderr, "kernel_launch: unexpected shapes (n_in %d out %d ws %zu)\n", n_in, out_size, ws_size); grid = -1; return; }
        int dev = 0, cus = 0;
        if (hipGetDevice(&dev) != hipSuccess || hipDeviceGetAttribute(&cus, hipDeviceAttributeMultiprocessorCount, dev) != hipSuccess) { grid = -1; return; }
        if (hipFuncSetAttribute((const void*)skel_fwd, hipFuncAttributeMaxDynamicSharedMemorySize, LDS_BYTES) != hipSuccess) { fprintf(stderr, "kernel_launch: hipFuncSetAttribute failed\n"); grid = -1; return; }
        (void)hipGetLastError();
        grid = cus;
    }
    if (grid < 0) return;
    if (hipMemsetAsync((char*)d_ws + WS_CTL, 0, CTL_ZERO_BYTES, stream) != hipSuccess) return;
    Args a{};
    for (int i = 0; i < 20; ++i) a.in[i] = (const float*)d_in[i];
    a.out = (float*)d_out; a.ws = (unsigned char*)d_ws;
    if (N_LAUNCHES == 1) {
        a.ph_lo = 0; a.ph_hi = NPHASES; a.li = 0;
        hipLaunchKernelGGL(skel_fwd, dim3(grid), dim3(NWAVES * 64), LDS_BYTES, stream, a);
    } else {
        for (int li = 0; li < NPHASES; ++li) {
            a.ph_lo = li; a.ph_hi = li + 1; a.li = li;
            hipLaunchKernelGGL(skel_fwd, dim3(grid), dim3(NWAVES * 64), LDS_BYTES, stream, a);
        }
    }
}
```

```cpp
#include <hip/hip_runtime.h>
#include <cstdio>
#include <cstdint>
#include <cmath>

#ifndef MK_N_LAUNCHES
#define MK_N_LAUNCHES 1
#endif

constexpr int BATCH = 2, SEQ = 8192, D = 1024, T = BATCH * SEQ;
constexpr int PROJ_W = 9216;
constexpr int NHEAD = 8, DK = 128;
constexpr int PKH = 8, PKD = 256, NKEYS = 128, TOPK = 16;
constexpr int PLE = 256;
constexpr float LN_EPS = 1e-5f, RMS_EPS = 1e-6f;
constexpr float ALPHA = 1.189207115002721f;
constexpr int NWAVES = 8;
constexpr int NPHASES = 16;
constexpr int N_LAUNCHES = MK_N_LAUNCHES;

constexpr size_t MiB = 1u << 20;
constexpr size_t WS_CTL = 0, CTL_ZERO_BYTES = 1 * MiB;
constexpr size_t WS_WIN = 1 * MiB;
constexpr size_t WS_WA = 19 * MiB, WS_WB = 21 * MiB, WS_WO = 23 * MiB, WS_WPG = 25 * MiB;
constexpr size_t WS_WQ = 27 * MiB;
constexpr size_t WS_SK = 31 * MiB;
constexpr size_t WS_WPP = 31 * MiB + 512 * 1024;
constexpr size_t WS_XB = 32 * MiB;
constexpr size_t WS_BIG = 64 * MiB;
constexpr size_t WS_ZC = 64 * MiB;
constexpr size_t WS_ZG = 160 * MiB;
constexpr size_t WS_VT = 160 * MiB;
constexpr size_t WS_KET = 192 * MiB;
constexpr size_t WS_X1 = 128 * MiB;
constexpr size_t WS_X1B = 192 * MiB;
constexpr size_t WS_OA = 224 * MiB;
constexpr size_t WS_PB = 256 * MiB;
constexpr size_t WS_DEC = 264 * MiB;
constexpr size_t WS_END = 265 * MiB;
constexpr size_t WS_YC = WS_XB;
constexpr size_t WS_IDS = WS_XB;
constexpr size_t WS_GW = WS_XB + 8 * MiB;
constexpr size_t WS_Y = WS_BIG;
constexpr size_t WS_QP = WS_BIG;
constexpr size_t WS_X2B = WS_BIG;
constexpr int CW_BAR = 4096;

constexpr int LDS_BYTES = 147456;
constexpr int RING_BYTES = 131072, LDSCTL_OFF = RING_BYTES, MISC_OFF = LDSCTL_OFF + 320;

#define GAS __attribute__((address_space(1)))
#define LAS __attribute__((address_space(3)))
typedef unsigned short bf16;
typedef unsigned v4u __attribute__((ext_vector_type(4)));
typedef float f32x4 __attribute__((ext_vector_type(4)));
typedef short bf16x8 __attribute__((ext_vector_type(8)));
typedef float f32x16 __attribute__((ext_vector_type(16)));
typedef GAS unsigned gu32;
#define RLX_AGENT __ATOMIC_RELAXED, __HIP_MEMORY_SCOPE_AGENT
#define LDS_WAIT() asm volatile("s_waitcnt lgkmcnt(0)" ::: "memory")

__device__ __forceinline__ unsigned f2bf(float f) { unsigned u = __builtin_bit_cast(unsigned, f); return (u + 0x7fffu + ((u >> 16) & 1u)) >> 16; }
__device__ __forceinline__ unsigned pk2(float lo, float hi) { return f2bf(lo) | (f2bf(hi) << 16); }
__device__ __forceinline__ float bf2f(unsigned short h) { return __builtin_bit_cast(float, (unsigned)h << 16); }
__device__ __forceinline__ float bflo(unsigned w) { return __builtin_bit_cast(float, w << 16); }
__device__ __forceinline__ float bfhi(unsigned w) { return __builtin_bit_cast(float, w & 0xffff0000u); }
__device__ __forceinline__ void unpack8(const v4u w, float (&o)[8]) { o[0] = bflo(w.x); o[1] = bfhi(w.x); o[2] = bflo(w.y); o[3] = bfhi(w.y); o[4] = bflo(w.z); o[5] = bfhi(w.z); o[6] = bflo(w.w); o[7] = bfhi(w.w); }
__device__ __forceinline__ v4u pack8(const float (&v)[8]) { v4u w; w.x = pk2(v[0], v[1]); w.y = pk2(v[2], v[3]); w.z = pk2(v[4], v[5]); w.w = pk2(v[6], v[7]); return w; }
__device__ __forceinline__ float sigmoidf_(float x) { return 1.0f / (1.0f + __expf(-x)); }
__device__ __forceinline__ float wave_sum(float v) {
#pragma unroll
    for (int o = 1; o < 64; o <<= 1) v += __shfl_xor(v, o);
    return v;
}

#define XB_TMO      128
#define XB_XCNT(j)  (256  + 64 * (j))
#define XB_XSUB(j)  (1280 + 64 * (j))
#define XB_XGEN(j)  (2304 + 64 * (j))
#define XB_TOP      3328
#define XB_TOPGEN   3392
#define XCD_BAR_WORDS 3456
#define XB_SPIN_CAP (1u << 26)

__device__ __forceinline__ unsigned xb_ld(unsigned* p)              { return __hip_atomic_load(p, __ATOMIC_RELAXED, __HIP_MEMORY_SCOPE_AGENT); }
__device__ __forceinline__ unsigned xb_add(unsigned* p, unsigned v) { return __hip_atomic_fetch_add(p, v, __ATOMIC_RELAXED, __HIP_MEMORY_SCOPE_AGENT); }
__device__ __forceinline__ unsigned xb_xcc_id() { return (unsigned)__builtin_amdgcn_s_getreg((3 << 11) | 20) & 0xFu; }
#define XB_SPIN(cond, bar) do { unsigned _sp = 0; while (cond) { __builtin_amdgcn_s_sleep(1); \
    if ((++_sp & 255u) == 0u) { if (xb_ld(&(bar)[XB_TMO])) break; if (_sp > XB_SPIN_CAP) { atomicAdd(&(bar)[XB_TMO], 1u); break; } } } } while (0)

struct XcdBarrier { unsigned* bar; unsigned x; volatile LAS unsigned* st; };

__device__ __forceinline__ XcdBarrier xcd_barrier_post(unsigned* bar, volatile LAS unsigned* st) {
    XcdBarrier b; b.bar = bar; b.x = xb_xcc_id(); b.st = st;
    if (threadIdx.x == 0) (void)xb_add(&bar[XB_XCNT(b.x)], 1u);
    return b;
}
__device__ __forceinline__ void xcd_barrier_complete(unsigned* bar, unsigned x, unsigned& nloc, unsigned& nx) {
    const unsigned G = gridDim.x * gridDim.y * gridDim.z;
    unsigned sum, cnt, mine, sp = 0u;
    for (;;) {
        sum = 0u; cnt = 0u; mine = 0u;
#pragma unroll
        for (unsigned j = 0; j < 16; ++j) { const unsigned c = xb_ld(&bar[XB_XCNT(j)]); sum += c; cnt += (c > 0u) ? 1u : 0u; mine = (j == x) ? c : mine; }
        if (sum == G) break;
        __builtin_amdgcn_s_sleep(1);
        if ((++sp & 255u) == 0u) { if (xb_ld(&bar[XB_TMO])) break; if (sp > XB_SPIN_CAP) { atomicAdd(&bar[XB_TMO], 1u); break; } }
    }
    nloc = mine > 0u ? mine : 1u; nx = cnt > 0u ? cnt : 1u;
}
__device__ __forceinline__ void xcd_barrier(const XcdBarrier& b) {
    asm volatile("s_waitcnt vmcnt(0)" ::: "memory");
    __syncthreads();
    if (threadIdx.x == 0) {
        unsigned* bar = b.bar;
        __builtin_amdgcn_s_waitcnt(0);
        unsigned nloc = b.st[0], nx = b.st[1];
        if (nloc == 0u) { xcd_barrier_complete(bar, b.x, nloc, nx); b.st[0] = nloc; b.st[1] = nx; }
        const unsigned old = xb_add(&bar[XB_XSUB(b.x)], 1u);
        const unsigned gen = old / nloc;
        if (old + 1u == (gen + 1u) * nloc) {
            __builtin_amdgcn_fence(__ATOMIC_RELEASE, "agent");
            asm volatile("s_waitcnt vmcnt(0)" ::: "memory");
            const unsigned og = xb_add(&bar[XB_TOP], 1u);
            const unsigned tg = og / nx;
            if (og + 1u == (tg + 1u) * nx) xb_add(&bar[XB_TOPGEN], 1u);
            else XB_SPIN(xb_ld(&bar[XB_TOPGEN]) == tg, bar);
            __builtin_amdgcn_fence(__ATOMIC_ACQUIRE, "agent");
            xb_add(&bar[XB_XGEN(b.x)], 1u);
            asm volatile("s_waitcnt vmcnt(0)" ::: "memory");
        } else {
            XB_SPIN(xb_ld(&bar[XB_XGEN(b.x)]) == gen, bar);
            __builtin_amdgcn_fence(__ATOMIC_ACQUIRE, "agent");
            asm volatile("s_waitcnt vmcnt(0)" ::: "memory");
        }
    }
    __syncthreads();
}

struct Frame {
    LAS unsigned char* lds;
    int tid, lane, wave, vcu, G;
};

struct Args {
    const float* in[20]; float* out; unsigned char* ws; int ph_lo, ph_hi, li, pad;
};

__device__ __forceinline__ void p0_transpose_item(const float* W, int K, int N, bf16* WT, LAS float* scr, int item, int lane) {
    const int nblk = N / 32, kb = item / nblk, nb = item % nblk, k0 = 64 * kb, n0 = 32 * nb;
#pragma unroll 8
    for (int i = 0; i < 32; ++i) { const int kk = 2 * i + (lane >> 5); scr[kk * 33 + (lane & 31)] = W[(size_t)(k0 + kk) * N + n0 + (lane & 31)]; }
    LDS_WAIT(); asm volatile("" ::: "memory");
    const int c = lane & 7;
#pragma unroll
    for (int j = 0; j < 4; ++j) { const int n = (lane >> 3) + 8 * j; const LAS float* s = scr + (8 * c) * 33 + n;
        v4u o; o.x = pk2(s[0 * 33], s[1 * 33]); o.y = pk2(s[2 * 33], s[3 * 33]); o.z = pk2(s[4 * 33], s[5 * 33]); o.w = pk2(s[6 * 33], s[7 * 33]);
        *(v4u*)(WT + (size_t)(n0 + n) * K + k0 + 8 * c) = o; }
    LDS_WAIT(); asm volatile("" ::: "memory");
}
__device__ __forceinline__ void convert_rows(const float* src, bf16* dst, size_t n, int gtid, int nthreads) {
    for (size_t i = (size_t)gtid * 8; i < n; i += (size_t)nthreads * 8) {
        const f32x4 a = *(const f32x4*)(src + i), b = *(const f32x4*)(src + i + 4);
        v4u o; o.x = pk2(a.x, a.y); o.y = pk2(a.z, a.w); o.z = pk2(b.x, b.y); o.w = pk2(b.z, b.w);
        *(v4u*)(dst + i) = o;
    }
}

namespace pg8 {
#define PG8_LAS __attribute__((address_space(3)))
typedef unsigned short bf16_t;
typedef short bf16x8 __attribute__((ext_vector_type(8)));
typedef float f32x4 __attribute__((ext_vector_type(4)));
typedef unsigned u32x4 __attribute__((ext_vector_type(4)));
constexpr int BM = 256, BK = 64, HALF = 128, HTB = HALF * BK * 2  , STAGE_BYTES = 8 * HTB, NXCD = 8, WGM = 8;

__host__ __device__ __forceinline__ int lds_byte(int r, int c) { const int st = (r >> 4) * 2 + (c >> 5), rr = r & 15, cc = c & 31, ob = rr * 64 + cc * 2; return st * 1024 + (ob ^ (((ob >> 9) & 1) << 5)); }
__host__ __device__ __forceinline__ void stage_rc(int b, int& R, int& C) { const int st = b / 1024, sb = b % 1024, swz = sb ^ (((sb >> 9) & 1) << 5); R = (st >> 1) * 16 + swz / 64; C = (st & 1) * 32 + (swz % 64) / 2; }
__host__ __device__ __forceinline__ int perm32(int rho) { const int n = rho >> 4, i = rho & 15; return 8 * (i >> 2) + 4 * n + (i & 3); }

struct Unit { int pm, pn; };
struct Gemm { const bf16_t* A; const bf16_t* Bt; int M, N, K; };

struct StaticOrder {
    int nM, nN, nwg, G, c;
    __host__ __device__ void init(int M, int N, int G_, int c_) { nM = M / BM; nN = N / BM; nwg = nM * nN; G = G_; c = c_; }
    __host__ __device__ bool next(int i, Unit& u) const {
        const long L = (long)i * G + c; if (L >= nwg) return false;
        int wgid = (int)L; { const int q = nwg / NXCD, r = nwg % NXCD, xcd = wgid % NXCD, off = wgid / NXCD; wgid = (xcd < r ? xcd * (q + 1) : r * (q + 1) + (xcd - r) * q) + off; }
        const int nig = WGM * nN, gid = wgid / nig, fm = gid * WGM, gsz = (nM - fm) < WGM ? (nM - fm) : WGM;
        u.pm = fm + ((wgid % nig) % gsz); u.pn = (wgid % nig) / gsz; return true;
    }
    __device__ __forceinline__ void a_ready(const Unit&) const {}
    __device__ __forceinline__ void done(const Unit&) const {}
};

__device__ __forceinline__ unsigned cvt_pk_bf16(float lo, float hi) { unsigned r; asm volatile("v_cvt_pk_bf16_f32 %0, %1, %2" : "=v"(r) : "v"(lo), "v"(hi)); return r; }
typedef float f32x2 __attribute__((ext_vector_type(2)));
template <class Epi, class Sched, bool ALIGN_EPI = false, bool SP2 = false>
__device__ __forceinline__ void gemm_phase(PG8_LAS unsigned char* lds, const Gemm g, const Sched& S, const Epi& E) {
    const int tid = threadIdx.x, wid = __builtin_amdgcn_readfirstlane(tid >> 6), lane = tid & 63, wr = wid >> 2, wc = wid & 3, fr = lane & 15, fq = lane >> 4;
    const int K = g.K, nt = K / BK;
    unsigned voffA[2], voffB[2];
#pragma unroll
    for (int i = 0; i < 2; ++i) { int R, C; stage_rc(tid * 16 + i * 8192, R, C); const int Rb = Epi::PERM ? ((R & ~31) + perm32(R & 31)) : R;
        voffA[i] = (unsigned)(R * K + C) * 2u; voffB[i] = (unsigned)(Rb * K + C) * 2u; }
    const size_t kstep = (size_t)(BK * 2);
    const size_t hstep = (size_t)HALF * K * 2;
    const size_t tstep = 2 * hstep;
    const unsigned ldsw = (unsigned)wid * 1024u;
    const int aoff = lds_byte(wr * 64 + fr, fq * 8), boff = lds_byte(wc * 32 + fr, fq * 8);
#define PG8_SA(b, h) (((b) * 2 + (h)) * HTB)
#define PG8_SB(b, h) ((4 + (b) * 2 + (h)) * HTB)
#define PG8_STAGE(bufoff, gbase, voff) do { _Pragma("unroll") for (int _i = 0; _i < 2; ++_i) \
        __builtin_amdgcn_global_load_lds((const unsigned*)((const char*)(gbase) + (voff)[_i]), (PG8_LAS unsigned*)(lds + (bufoff) + ldsw + _i * 8192), 16, 0, 0); } while (0)
#define PG8_LDA(dst, b, h) do { _Pragma("unroll") for (int m = 0; m < 4; ++m) _Pragma("unroll") for (int k = 0; k < 2; ++k) dst[m][k] = *(const PG8_LAS bf16x8*)(lds + PG8_SA(b, h) + aoff + m * 2048 + k * 1024); } while (0)
#define PG8_LDB(dst, b, h) do { _Pragma("unroll") for (int n = 0; n < 2; ++n) _Pragma("unroll") for (int k = 0; k < 2; ++k) dst[n][k] = *(const PG8_LAS bf16x8*)(lds + PG8_SB(b, h) + boff + n * 2048 + k * 1024); } while (0)
#define PG8_MMA(ai, bj, At, Bt) do { __builtin_amdgcn_s_setprio(1); _Pragma("unroll") for (int m = 0; m < 4; ++m) _Pragma("unroll") for (int n = 0; n < 2; ++n) _Pragma("unroll") for (int k = 0; k < 2; ++k) \
        acc[ai][bj][m][n] = __builtin_amdgcn_mfma_f32_16x16x32_bf16(Bt[n][k], At[m][k], acc[ai][bj][m][n], 0, 0, 0); __builtin_amdgcn_s_setprio(0); } while (0)
#define PG8_WAIT_V(n) asm volatile("s_waitcnt vmcnt(" #n ")" ::: "memory")
#define PG8_WAIT_L(n) asm volatile("s_waitcnt lgkmcnt(" #n ")" ::: "memory")
#define PG8_BAR __builtin_amdgcn_s_barrier()
#define PG8_SCHED __builtin_amdgcn_sched_barrier(0)
    Unit cur, nxt; int ui = 0;
    if (!S.next(0, cur)) return;
    f32x4 acc[2][2][4][2];
#pragma unroll
    for (int a = 0; a < 2; ++a)
#pragma unroll
        for (int b = 0; b < 2; ++b)
#pragma unroll
            for (int m = 0; m < 4; ++m)
#pragma unroll
                for (int n = 0; n < 2; ++n) acc[a][b][m][n] = (f32x4){0.f, 0.f, 0.f, 0.f};
    bf16x8 At[4][2], B0[2][2], B1[2][2];
    const char* cA = (const char*)g.A + (size_t)cur.pm * tstep; const char* cB = (const char*)g.Bt + (size_t)cur.pn * tstep;
    S.a_ready(cur);
    if constexpr (SP2) {
        PG8_STAGE(PG8_SB(0, 0), cB, voffB); PG8_STAGE(PG8_SB(0, 1), cB + hstep, voffB); PG8_STAGE(PG8_SA(0, 0), cA, voffA); PG8_STAGE(PG8_SA(0, 1), cA + hstep, voffA);
        if (wr == 1) PG8_BAR;
        PG8_WAIT_V(2); PG8_BAR;
        PG8_STAGE(PG8_SB(1, 0), cB + kstep, voffB); PG8_STAGE(PG8_SA(1, 0), cA + kstep, voffA); PG8_STAGE(PG8_SB(1, 1), cB + hstep + kstep, voffB);
        PG8_WAIT_V(6); PG8_BAR;
    } else {
        PG8_STAGE(PG8_SB(0, 0), cB, voffB); PG8_STAGE(PG8_SA(0, 0), cA, voffA); PG8_STAGE(PG8_SB(0, 1), cB + hstep, voffB); PG8_STAGE(PG8_SA(0, 1), cA + hstep, voffA);
        if (wr == 1) PG8_BAR;
        PG8_WAIT_V(4); PG8_BAR;
        PG8_STAGE(PG8_SB(1, 0), cB + kstep, voffB); PG8_STAGE(PG8_SA(1, 0), cA + kstep, voffA); PG8_STAGE(PG8_SB(1, 1), cB + hstep + kstep, voffB);
        PG8_WAIT_V(6); PG8_BAR;
    }
    for (;;) {
        const bool has_next = S.next(ui + 1, nxt);
        const char* nA = has_next ? (const char*)g.A + (size_t)nxt.pm * tstep : cA; const char* nB = has_next ? (const char*)g.Bt + (size_t)nxt.pn * tstep : cB;
        for (int t = 0; t < nt; t += 2) {
            const bool last = (t == nt - 2);
            const char* a1 = cA + (size_t)(t + 1) * kstep;
            const char* a2 = last ? nA : cA + (size_t)(t + 2) * kstep; const char* b2 = last ? nB : cB + (size_t)(t + 2) * kstep;
            const char* a3 = a2 + kstep; const char* b3 = b2 + kstep;
            if (last && has_next) S.a_ready(nxt);
            if constexpr (SP2) {
            PG8_LDB(B0, 0, 0); PG8_LDB(B1, 0, 1); PG8_SCHED; PG8_LDA(At, 0, 0); PG8_STAGE(PG8_SA(1, 1), a1 + hstep, voffA);
            PG8_WAIT_V(8); PG8_WAIT_L(0); PG8_BAR; PG8_MMA(0, 0, At, B0); PG8_MMA(0, 1, At, B1); PG8_BAR; PG8_SCHED;
            PG8_LDA(At, 0, 1); PG8_STAGE(PG8_SB(0, 0), b2, voffB); PG8_STAGE(PG8_SB(0, 1), b2 + hstep, voffB); PG8_STAGE(PG8_SA(0, 0), a2, voffA);
            PG8_WAIT_V(8); PG8_WAIT_L(0); PG8_BAR; PG8_MMA(1, 0, At, B0); PG8_MMA(1, 1, At, B1); PG8_BAR; PG8_SCHED;
            PG8_LDB(B0, 1, 0); PG8_LDB(B1, 1, 1); PG8_SCHED; PG8_LDA(At, 1, 0); PG8_STAGE(PG8_SA(0, 1), a2 + hstep, voffA);
            PG8_WAIT_V(8); PG8_WAIT_L(0); PG8_BAR; PG8_MMA(0, 0, At, B0); PG8_MMA(0, 1, At, B1); PG8_BAR; PG8_SCHED;
            PG8_LDA(At, 1, 1); PG8_STAGE(PG8_SB(1, 0), b3, voffB); PG8_STAGE(PG8_SB(1, 1), b3 + hstep, voffB); PG8_STAGE(PG8_SA(1, 0), a3, voffA);
            PG8_WAIT_V(8); PG8_WAIT_L(0); PG8_BAR; PG8_MMA(1, 0, At, B0); PG8_MMA(1, 1, At, B1); PG8_BAR; PG8_SCHED;
            } else {
            PG8_LDB(B0, 0, 0); PG8_SCHED; PG8_LDA(At, 0, 0); PG8_STAGE(PG8_SA(1, 1), a1 + hstep, voffA);
            PG8_WAIT_L(8); PG8_BAR; PG8_WAIT_L(0); PG8_MMA(0, 0, At, B0); PG8_BAR; PG8_SCHED;
            PG8_LDB(B1, 0, 1); PG8_STAGE(PG8_SB(0, 0), b2, voffB);
            PG8_BAR; PG8_WAIT_L(0); PG8_MMA(0, 1, At, B1); PG8_BAR;
            PG8_LDA(At, 0, 1); PG8_STAGE(PG8_SA(0, 0), a2, voffA);
            PG8_BAR; PG8_WAIT_L(0); PG8_MMA(1, 0, At, B0); PG8_BAR; PG8_SCHED;
            PG8_STAGE(PG8_SB(0, 1), b2 + hstep, voffB);
            PG8_WAIT_V(6); PG8_BAR; PG8_MMA(1, 1, At, B1); PG8_BAR;
            PG8_LDB(B0, 1, 0); PG8_SCHED; PG8_LDA(At, 1, 0); PG8_STAGE(PG8_SA(0, 1), a2 + hstep, voffA);
            PG8_WAIT_L(8); PG8_BAR; PG8_WAIT_L(0); PG8_MMA(0, 0, At, B0); PG8_BAR; PG8_SCHED;
            PG8_LDB(B1, 1, 1); PG8_STAGE(PG8_SB(1, 0), b3, voffB);
            PG8_BAR; PG8_WAIT_L(0); PG8_MMA(0, 1, At, B1); PG8_BAR;
            PG8_LDA(At, 1, 1); PG8_STAGE(PG8_SA(1, 0), a3, voffA);
            PG8_BAR; PG8_WAIT_L(0); PG8_MMA(1, 0, At, B0); PG8_BAR; PG8_SCHED;
            PG8_STAGE(PG8_SB(1, 1), b3 + hstep, voffB);
            PG8_WAIT_V(6); PG8_BAR; PG8_MMA(1, 1, At, B1); PG8_BAR;
            }
        }
        if constexpr (ALIGN_EPI) { if (wr == 0) PG8_BAR; }
        if constexpr (!Epi::AFTER_DRAIN) { E(acc, cur, wr, wc, fr, fq); S.done(cur); }
        if (!has_next) break;
#pragma unroll
        for (int a = 0; a < 2; ++a)
#pragma unroll
            for (int b = 0; b < 2; ++b)
#pragma unroll
                for (int m = 0; m < 4; ++m)
#pragma unroll
                    for (int n = 0; n < 2; ++n) acc[a][b][m][n] = (f32x4){0.f, 0.f, 0.f, 0.f};
        cur = nxt; cA = nA; cB = nB; ++ui;
        if constexpr (ALIGN_EPI) { if (wr == 1) PG8_BAR; }
    }
    PG8_WAIT_V(0);
    if constexpr (!ALIGN_EPI) { if (wr == 0) PG8_BAR; }
    PG8_BAR;
    if constexpr (Epi::AFTER_DRAIN) { E.fused(acc, cur, wr, wc, fr, fq, lds, wid, lane); S.done(cur); }
#undef PG8_SA
#undef PG8_SB
#undef PG8_STAGE
#undef PG8_LDA
#undef PG8_LDB
#undef PG8_MMA
#undef PG8_WAIT_V
#undef PG8_WAIT_L
#undef PG8_BAR
#undef PG8_SCHED
}

template <class Fn> struct EpiRow8 {
    static constexpr bool PERM = true, AFTER_DRAIN = false; Fn f;
    __device__ __forceinline__ void operator()(const f32x4 (&acc)[2][2][4][2], const Unit& u, int wr, int wc, int fr, int fq) const {
#pragma unroll
        for (int ai = 0; ai < 2; ++ai)
#pragma unroll
            for (int m = 0; m < 4; ++m) { const int r = u.pm * BM + ai * HALF + wr * 64 + m * 16 + fr;
#pragma unroll
                for (int bj = 0; bj < 2; ++bj) { const int c0 = u.pn * BM + bj * HALF + wc * 32 + 8 * fq;
                    const f32x4 v0 = acc[ai][bj][m][0], v1 = acc[ai][bj][m][1];
                    const float v[8] = {v0[0], v0[1], v0[2], v0[3], v1[0], v1[1], v1[2], v1[3]};
                    f.row8(r, c0, v); } }
    }
};
}

template <class Epi>
__device__ __forceinline__ void naive_gemm(const Frame& F, const bf16* A, const bf16* Bt, int M, int N, int K, const Epi& E) {
    LAS float* As = (LAS float*)F.lds;
    LAS float* Bs = As + 32 * 132;
    const int tid = F.tid, tr = tid >> 4, tc = tid & 15;
    const int ntn = N / 128, nt = (M / 128) * ntn;
    for (int tile = F.vcu; tile < nt; tile += F.G) {
        const int tm = tile / ntn, tn = tile % ntn;
        float acc[4][8];
#pragma unroll
        for (int i = 0; i < 4; ++i)
#pragma unroll
            for (int j = 0; j < 8; ++j) acc[i][j] = 0.f;
        for (int k0 = 0; k0 < K; k0 += 32) {
            { const int r = tid >> 2, kc = (tid & 3) * 8;
              const v4u a = *(const v4u*)(A + (size_t)(tm * 128 + r) * K + k0 + kc);
              const v4u b = *(const v4u*)(Bt + (size_t)(tn * 128 + r) * K + k0 + kc);
              float fa[8], fb[8]; unpack8(a, fa); unpack8(b, fb);
#pragma unroll
              for (int j = 0; j < 8; ++j) { As[(kc + j) * 132 + r] = fa[j]; Bs[(kc + j) * 132 + r] = fb[j]; } }
            __syncthreads();
#pragma unroll 8
            for (int k = 0; k < 32; ++k) {
                const f32x4 a = *(const LAS f32x4*)(As + k * 132 + tr * 4);
                const f32x4 b0 = *(const LAS f32x4*)(Bs + k * 132 + tc * 8), b1 = *(const LAS f32x4*)(Bs + k * 132 + tc * 8 + 4);
#pragma unroll
                for (int i = 0; i < 4; ++i) {
                    acc[i][0] += a[i] * b0.x; acc[i][1] += a[i] * b0.y; acc[i][2] += a[i] * b0.z; acc[i][3] += a[i] * b0.w;
                    acc[i][4] += a[i] * b1.x; acc[i][5] += a[i] * b1.y; acc[i][6] += a[i] * b1.z; acc[i][7] += a[i] * b1.w; }
            }
            __syncthreads();
        }
#pragma unroll
        for (int i = 0; i < 4; ++i) E.row8(tm * 128 + tr * 4 + i, tn * 128 + tc * 8, acc[i]);
    }
}

struct EpiStore { bf16* O; int ldc;
    __device__ __forceinline__ void row8(int r, int c0, const float (&v)[8]) const { *(v4u*)(O + (size_t)r * ldc + c0) = pack8(v); } };
struct EpiZ2 { bf16* ONOA; bf16* Zc; bf16* Zg;
    __device__ __forceinline__ void row8(int r, int c0, const float (&v)[8]) const {
        if (c0 < 1024) { float on[8], o[8]; unpack8(*(const v4u*)(ONOA + (size_t)r * D + c0), on);
#pragma unroll
            for (int j = 0; j < 8; ++j) o[j] = on[j] * (v[j] / (1.0f + __expf(-v[j])));
            *(v4u*)(ONOA + (size_t)r * D + c0) = pack8(o); }
        else if (c0 < 4096) *(v4u*)(Zc + (size_t)r * 3072 + (c0 - 1024)) = pack8(v);
        else *(v4u*)(Zg + (size_t)r * 2048 + (c0 - 4096)) = pack8(v); } };
struct EpiGateA { float* TMP; const bf16* Zg;
    __device__ __forceinline__ void row8(int r, int c0, const float (&v)[8]) const {
        float g[8]; unpack8(*(const v4u*)(Zg + (size_t)r * 2048 + c0), g);
        f32x4 o0, o1; o0.x = sigmoidf_(g[0]) * v[0]; o0.y = sigmoidf_(g[1]) * v[1]; o0.z = sigmoidf_(g[2]) * v[2]; o0.w = sigmoidf_(g[3]) * v[3];
        o1.x = sigmoidf_(g[4]) * v[4]; o1.y = sigmoidf_(g[5]) * v[5]; o1.z = sigmoidf_(g[6]) * v[6]; o1.w = sigmoidf_(g[7]) * v[7];
        *(f32x4*)(TMP + (size_t)r * D + c0) = o0; *(f32x4*)(TMP + (size_t)r * D + c0 + 4) = o1; } };
struct EpiGateB { const float* TMP; const bf16* Zg; bf16* MERGED;
    __device__ __forceinline__ void row8(int r, int c0, const float (&v)[8]) const {
        float g[8]; unpack8(*(const v4u*)(Zg + (size_t)r * 2048 + 1024 + c0), g);
        const f32x4 t0 = *(const f32x4*)(TMP + (size_t)r * D + c0), t1 = *(const f32x4*)(TMP + (size_t)r * D + c0 + 4);
        float o[8]; o[0] = t0.x + sigmoidf_(g[0]) * v[0]; o[1] = t0.y + sigmoidf_(g[1]) * v[1]; o[2] = t0.z + sigmoidf_(g[2]) * v[2]; o[3] = t0.w + sigmoidf_(g[3]) * v[3];
        o[4] = t1.x + sigmoidf_(g[4]) * v[4]; o[5] = t1.y + sigmoidf_(g[5]) * v[5]; o[6] = t1.z + sigmoidf_(g[6]) * v[6]; o[7] = t1.w + sigmoidf_(g[7]) * v[7];
        *(v4u*)(MERGED + (size_t)r * D + c0) = pack8(o); } };
struct EpiResid { const float* X; float* Y;
    __device__ __forceinline__ void row8(int r, int c0, const float (&v)[8]) const {
        const f32x4 x0 = *(const f32x4*)(X + (size_t)r * D + c0), x1 = *(const f32x4*)(X + (size_t)r * D + c0 + 4);
        f32x4 o0, o1; o0.x = ALPHA * x0.x + v[0]; o0.y = ALPHA * x0.y + v[1]; o0.z = ALPHA * x0.z + v[2]; o0.w = ALPHA * x0.w + v[3];
        o1.x = ALPHA * x1.x + v[4]; o1.y = ALPHA * x1.y + v[5]; o1.z = ALPHA * x1.z + v[6]; o1.w = ALPHA * x1.w + v[7];
        *(f32x4*)(Y + (size_t)r * D + c0) = o0; *(f32x4*)(Y + (size_t)r * D + c0 + 4) = o1; } };
struct EpiFinal { const float* X2; const bf16* PP; float* OUT;
    __device__ __forceinline__ void row8(int r, int c0, const float (&v)[8]) const {
        float p[8]; unpack8(*(const v4u*)(PP + (size_t)r * D + c0), p);
        const f32x4 x0 = *(const f32x4*)(X2 + (size_t)r * D + c0), x1 = *(const f32x4*)(X2 + (size_t)r * D + c0 + 4);
        f32x4 o0, o1; o0.x = x0.x + sigmoidf_(v[0]) * p[0]; o0.y = x0.y + sigmoidf_(v[1]) * p[1]; o0.z = x0.z + sigmoidf_(v[2]) * p[2]; o0.w = x0.w + sigmoidf_(v[3]) * p[3];
        o1.x = x1.x + sigmoidf_(v[4]) * p[4]; o1.y = x1.y + sigmoidf_(v[5]) * p[5]; o1.z = x1.z + sigmoidf_(v[6]) * p[6]; o1.w = x1.w + sigmoidf_(v[7]) * p[7];
        *(f32x4*)(OUT + (size_t)r * D + c0) = o0; *(f32x4*)(OUT + (size_t)r * D + c0 + 4) = o1; } };


template <class Fn>
__device__ __forceinline__ void run_gemm(const Frame& F, const bf16* A, const bf16* Bt, int M, int N, int K, const Fn& fn) {
    pg8::Gemm g{A, Bt, M, N, K}; pg8::StaticOrder S; S.init(M, N, F.G, (int)blockIdx.x);
    pg8::EpiRow8<Fn> E{fn};
    pg8::gemm_phase<pg8::EpiRow8<Fn>, pg8::StaticOrder, true, true>(F.lds, g, S, E);
}

__device__ __forceinline__ void ln_row_store(f32x4 (&v)[4], const float* g, const float* b, float* orow, bf16* obrow, int lane) {
    float s = 0.f;
#pragma unroll
    for (int j = 0; j < 4; ++j) s += (v[j].x + v[j].y) + (v[j].z + v[j].w);
    const float mean = wave_sum(s) * (1.f / D); float s2 = 0.f;
#pragma unroll
    for (int j = 0; j < 4; ++j) { v[j] = v[j] - mean; s2 += (v[j].x * v[j].x + v[j].y * v[j].y) + (v[j].z * v[j].z + v[j].w * v[j].w); }
    const float rstd = 1.f / sqrtf(wave_sum(s2) * (1.f / D) + LN_EPS);
#pragma unroll
    for (int j = 0; j < 4; ++j) {
        const f32x4 gg = *(const f32x4*)(g + 4 * lane + 256 * j), bb = *(const f32x4*)(b + 4 * lane + 256 * j);
        const f32x4 o = v[j] * rstd * gg + bb;
        *(f32x4*)(orow + 4 * lane + 256 * j) = o;
        unsigned long long w = (unsigned long long)pk2(o.x, o.y) | ((unsigned long long)pk2(o.z, o.w) << 32);
        *(unsigned long long*)(obrow + 4 * lane + 256 * j) = w;
    }
}
__device__ __forceinline__ float gelu_erf(float x) { return 0.5f * x * (1.0f + erff(x * 0.70710678118654752f)); }

__global__ void __launch_bounds__(NWAVES * 64, 2) skel_fwd(Args args) {
    extern __shared__ __attribute__((aligned(16))) unsigned char lds[];
    Frame F;
    F.lds = (LAS unsigned char*)lds;
    F.tid = threadIdx.x; F.lane = F.tid & 63; F.wave = __builtin_amdgcn_readfirstlane(F.tid >> 6);
    F.G = gridDim.x; { const int bx = blockIdx.x; F.vcu = (F.G % 8 == 0) ? (bx % 8) * (F.G / 8) + bx / 8 : bx; }
    unsigned char* ws = args.ws;
    volatile LAS unsigned* MISC = (volatile LAS unsigned*)(F.lds + MISC_OFF);
    for (int u = F.tid; u < (LDS_BYTES - LDSCTL_OFF) / 4; u += NWAVES * 64) ((LAS unsigned*)(F.lds + LDSCTL_OFF))[u] = 0u;
    __syncthreads();
    XcdBarrier bar; bar.bar = (unsigned*)(ws + WS_CTL) + CW_BAR; bar.x = 0; bar.st = nullptr;
    if (N_LAUNCHES == 1) bar = xcd_barrier_post((unsigned*)(ws + WS_CTL) + CW_BAR, MISC + 8);
    const int lo = args.ph_lo, hi = args.ph_hi;
#define IN(k) (lo <= (k) && (k) < hi)
#define SEAM(k) do { if (IN(k) && IN((k) + 1)) xcd_barrier(bar); } while (0)

    const float* x = args.in[0]; const float* p = args.in[1]; const float* w_in = args.in[2]; const float* lb_param = args.in[3];
    const float* hg_norm_g = args.in[4]; const float* conv_w = args.in[5]; const float* conv_b = args.in[6];
    const float* w_a = args.in[7]; const float* w_b = args.in[8]; const float* w_out = args.in[9];
    const float* ln1_g = args.in[10]; const float* ln1_b = args.in[11]; const float* pk_wq = args.in[12]; const float* pk_sk = args.in[13];
    const float* pk_u = args.in[14]; const float* pk_v = args.in[15]; const float* ln2_g = args.in[16]; const float* ln2_b = args.in[17];
    const float* w_pg = args.in[18]; const float* w_pp = args.in[19];
    float* out = args.out;
    bf16* WinT = (bf16*)(ws + WS_WIN); bf16* WaT = (bf16*)(ws + WS_WA); bf16* WbT = (bf16*)(ws + WS_WB); bf16* WoT = (bf16*)(ws + WS_WO);
    bf16* WpgT = (bf16*)(ws + WS_WPG); bf16* WqT = (bf16*)(ws + WS_WQ); bf16* SKB = (bf16*)(ws + WS_SK); bf16* WppT = (bf16*)(ws + WS_WPP);
    bf16* XB = (bf16*)(ws + WS_XB); bf16* PB = (bf16*)(ws + WS_PB);
    bf16* Zhg = (bf16*)(ws + WS_BIG); bf16* Zc = (bf16*)(ws + WS_ZC); bf16* Zg = (bf16*)(ws + WS_ZG);
    bf16* UB = (bf16*)out; bf16* VB = (bf16*)out + (size_t)16384 * D;
    bf16* ST = (bf16*)out;
    bf16* VT = (bf16*)(ws + WS_VT); bf16* KET = (bf16*)(ws + WS_KET); float* DEC = (float*)(ws + WS_DEC); bf16* ON = (bf16*)(ws + WS_OA);
    bf16* OA = (bf16*)(ws + WS_OA); bf16* YC = (bf16*)(ws + WS_YC);
    float* TMP = (float*)(ws + WS_ZC);
    bf16* MERGED = (bf16*)(ws + WS_OA);
    float* Y = (float*)(ws + WS_Y); float* X1 = (float*)(ws + WS_X1); bf16* X1B = (bf16*)(ws + WS_X1B);
    bf16* QP = (bf16*)(ws + WS_QP); bf16* PP = (bf16*)(ws + WS_OA);
    int* IDS = (int*)(ws + WS_IDS); float* GW = (float*)(ws + WS_GW);
    bf16* X2B = (bf16*)(ws + WS_X2B);

    const int gtid = F.vcu * (NWAVES * 64) + F.tid, NT = F.G * NWAVES * 64;
    const int gw = F.vcu * NWAVES + F.wave, NGW = F.G * NWAVES;

    if (IN(0)) {
        LAS float* scr = (LAS float*)(F.lds + F.wave * 16384);
        constexpr int I_IN = (D / 64) * (PROJ_W / 32), I_SQ = (D / 64) * (D / 32), I_Q = (D / 64) * (2048 / 32), I_PP = (PLE / 64) * (D / 32);
        constexpr int NITEMS = I_IN + 4 * I_SQ + I_Q + I_PP;
        for (int it = gw; it < NITEMS; it += NGW) {
            int r = it;
            if (r < I_IN) { p0_transpose_item(w_in, D, PROJ_W, WinT, scr, r, F.lane); continue; } r -= I_IN;
            if (r < I_SQ) { p0_transpose_item(w_a, D, D, WaT, scr, r, F.lane); continue; } r -= I_SQ;
            if (r < I_SQ) { p0_transpose_item(w_b, D, D, WbT, scr, r, F.lane); continue; } r -= I_SQ;
            if (r < I_SQ) { p0_transpose_item(w_out, D, D, WoT, scr, r, F.lane); continue; } r -= I_SQ;
            if (r < I_SQ) { p0_transpose_item(w_pg, D, D, WpgT, scr, r, F.lane); continue; } r -= I_SQ;
            if (r < I_Q) { p0_transpose_item(pk_wq, D, 2048, WqT, scr, r, F.lane); continue; } r -= I_Q;
            p0_transpose_item(w_pp, PLE, D, WppT, scr, r, F.lane);
        }
        convert_rows(x, XB, (size_t)T * D, gtid, NT);
        convert_rows(p, PB, (size_t)T * PLE, gtid, NT);
        convert_rows(pk_sk, SKB, (size_t)PKH * 2 * NKEYS * 128, gtid, NT);
    }
    SEAM(0);
    if (IN(1)) { EpiStore E{Zhg, 3072}; run_gemm(F, XB, WinT, T, 3072, D, E); }
    SEAM(1);
    if (IN(2)) {
        LAS float* tot = (LAS float*)F.lds;
        for (int unit = F.vcu; unit < 2048; unit += F.G) {
            const int n = unit >> 3, h = unit & 7, row0 = n * 64;
            const int c = F.tid & 127, sgm = F.tid >> 7, ch = h * 128 + c;
            const float lb = 1.0f / (1.0f + expf(lb_param[1024 + ch] - lb_param[ch]));
            float lf[16], kk[16];
            float run = 0.f;
#pragma unroll
            for (int i = 0; i < 16; ++i) { const size_t tok = (size_t)row0 + sgm * 16 + i;
                const float fz = bf2f(Zhg[tok * 3072 + 1024 + ch]); const float sg = 1.0f / (1.0f + expf(-fz));
                const float f = lb + (1.0f - lb) * sg; kk[i] = (1.0f - lb) * (1.0f - sg); run += logf(f); lf[i] = run; }
            tot[sgm * 128 + c] = run;
            __syncthreads();
            float off = 0.f, total = 0.f;
#pragma unroll
            for (int s2 = 0; s2 < 4; ++s2) { const float tv = tot[s2 * 128 + c]; total += tv; if (s2 < sgm) off += tv; }
            __syncthreads();
            float kev[16], vv[16];
#pragma unroll
            for (int i = 0; i < 16; ++i) { const size_t tok = (size_t)row0 + sgm * 16 + i; const float bc = lf[i] + off;
                const float q = bf2f(Zhg[tok * 3072 + ch]) * 0.08838834764831845f;
                const float qe = q * expf(bc), ke = kk[i] * expf(-bc);
                vv[i] = bf2f(Zhg[tok * 3072 + 2048 + ch]);
                Zhg[tok * 3072 + ch] = (bf16)f2bf(qe); Zhg[tok * 3072 + 1024 + ch] = (bf16)f2bf(ke); kev[i] = ke; }
            { float t0[8], t1[8];
#pragma unroll
              for (int i = 0; i < 8; ++i) { t0[i] = kev[i]; t1[i] = kev[8 + i]; }
              bf16* dst = KET + ((size_t)unit * 128 + c) * 64 + sgm * 16; *(v4u*)dst = pack8(t0); *(v4u*)(dst + 8) = pack8(t1);
#pragma unroll
              for (int i = 0; i < 8; ++i) { t0[i] = vv[i]; t1[i] = vv[8 + i]; }
              dst = VT + ((size_t)unit * 128 + c) * 64 + sgm * 16; *(v4u*)dst = pack8(t0); *(v4u*)(dst + 8) = pack8(t1); }
            if (sgm == 0) DEC[(size_t)n * 1024 + ch] = expf(total);
        }
    }
    SEAM(2);
    if (IN(3)) {
        const int q4 = F.lane >> 4, l15 = F.lane & 15;
        for (int unit = gw; unit < 2048; unit += NGW) {
            const int n = unit >> 3, h = unit & 7;
            const bf16* ket = KET + (size_t)unit * 128 * 64; const bf16* vt = VT + (size_t)unit * 128 * 64;
            bf16x8 a[8][2];
#pragma unroll
            for (int t = 0; t < 8; ++t)
#pragma unroll
                for (int s2 = 0; s2 < 2; ++s2) a[t][s2] = *(const bf16x8*)(ket + (16 * t + l15) * 64 + 32 * s2 + 8 * q4);
            f32x4 dc[8];
#pragma unroll
            for (int t = 0; t < 8; ++t) dc[t] = *(const f32x4*)(DEC + (size_t)n * 1024 + h * 128 + 16 * t + 4 * q4);
            for (int qd = 0; qd < 4; ++qd) {
                bf16x8 b[2][2];
#pragma unroll
                for (int cc = 0; cc < 2; ++cc)
#pragma unroll
                    for (int s2 = 0; s2 < 2; ++s2) b[cc][s2] = *(const bf16x8*)(vt + (32 * qd + 16 * cc + l15) * 64 + 32 * s2 + 8 * q4);
#pragma unroll
                for (int t = 0; t < 8; ++t)
#pragma unroll
                    for (int cc = 0; cc < 2; ++cc) {
                        f32x4 acc = (f32x4){0.f, 0.f, 0.f, 0.f};
                        acc = __builtin_amdgcn_mfma_f32_16x16x32_bf16(a[t][0], b[cc][0], acc, 0, 0, 0);
                        acc = __builtin_amdgcn_mfma_f32_16x16x32_bf16(a[t][1], b[cc][1], acc, 0, 0, 0);
                        acc = acc * dc[t];
                        const int dv = 32 * qd + 16 * cc + l15;
                        unsigned long long w = (unsigned long long)pk2(acc[0], acc[1]) | ((unsigned long long)pk2(acc[2], acc[3]) << 32);
                        *(unsigned long long*)(ST + ((size_t)unit * 128 + dv) * 128 + 16 * t + 4 * q4) = w;
                    }
            }
        }
    }
    SEAM(3);
    if (IN(4)) {
        for (int i = gtid; i < 65536; i += NT) {
            const int dk4 = i & 31, dv = (i >> 5) & 127, h = (i >> 12) & 7, b = i >> 15;
            f32x4 st = (f32x4){0.f, 0.f, 0.f, 0.f};
#pragma unroll 8
            for (int cn = 0; cn < 128; ++cn) {
                const int n = b * 128 + cn; const size_t unit = (size_t)n * 8 + h;
                unsigned long long* ptr = (unsigned long long*)(ST + (unit * 128 + dv) * 128 + dk4 * 4);
                const unsigned long long d = *ptr;
                const f32x4 dc = *(const f32x4*)(DEC + (size_t)n * 1024 + h * 128 + dk4 * 4);
                *ptr = (unsigned long long)pk2(st[0], st[1]) | ((unsigned long long)pk2(st[2], st[3]) << 32);
                const f32x4 dd = (f32x4){bflo((unsigned)d), bfhi((unsigned)d), bflo((unsigned)(d >> 32)), bfhi((unsigned)(d >> 32))};
                st = dc * st + dd;
            }
        }
    }
    SEAM(4);
    if (IN(5)) {
        const int q4 = F.lane >> 4, l15 = F.lane & 15;
        LAS bf16* Pl = (LAS bf16*)(F.lds + F.wave * 8192);
        for (int unit = gw; unit < 2048; unit += NGW) {
            const int n = unit >> 3, h = unit & 7, row0 = n * 64;
            const bf16* st = ST + (size_t)unit * 128 * 128; const bf16* vt = VT + (size_t)unit * 128 * 64;
            for (int half = 0; half < 2; ++half) {
                const int i0 = half * 32;
                bf16x8 qf[2][4];
#pragma unroll
                for (int it = 0; it < 2; ++it)
#pragma unroll
                    for (int ks = 0; ks < 4; ++ks) qf[it][ks] = *(const bf16x8*)(Zhg + (size_t)(row0 + i0 + 16 * it + l15) * 3072 + h * 128 + 32 * ks + 8 * q4);
                f32x4 acc[8][2];
#pragma unroll
                for (int dvt = 0; dvt < 8; ++dvt) { acc[dvt][0] = (f32x4){0.f, 0.f, 0.f, 0.f}; acc[dvt][1] = (f32x4){0.f, 0.f, 0.f, 0.f}; }
#pragma unroll
                for (int dvt = 0; dvt < 8; ++dvt)
#pragma unroll
                    for (int ks = 0; ks < 4; ++ks) { const bf16x8 a = *(const bf16x8*)(st + (16 * dvt + l15) * 128 + 32 * ks + 8 * q4);
                        acc[dvt][0] = __builtin_amdgcn_mfma_f32_16x16x32_bf16(a, qf[0][ks], acc[dvt][0], 0, 0, 0);
                        acc[dvt][1] = __builtin_amdgcn_mfma_f32_16x16x32_bf16(a, qf[1][ks], acc[dvt][1], 0, 0, 0); }
                const int njt = 2 * (half + 1);
                for (int jt = 0; jt < njt; ++jt) {
                    f32x4 p0 = (f32x4){0.f, 0.f, 0.f, 0.f}, p1 = (f32x4){0.f, 0.f, 0.f, 0.f};
#pragma unroll
                    for (int ks = 0; ks < 4; ++ks) { const bf16x8 a = *(const bf16x8*)(Zhg + (size_t)(row0 + 16 * jt + l15) * 3072 + 1024 + h * 128 + 32 * ks + 8 * q4);
                        p0 = __builtin_amdgcn_mfma_f32_16x16x32_bf16(a, qf[0][ks], p0, 0, 0, 0);
                        p1 = __builtin_amdgcn_mfma_f32_16x16x32_bf16(a, qf[1][ks], p1, 0, 0, 0); }
                    const int jb = 16 * jt + 4 * q4;
                    { const int ii = i0 + l15;
                      const float m0 = (jb + 0 <= ii) ? p0[0] : 0.f, m1 = (jb + 1 <= ii) ? p0[1] : 0.f, m2 = (jb + 2 <= ii) ? p0[2] : 0.f, m3 = (jb + 3 <= ii) ? p0[3] : 0.f;
                      *(LAS unsigned long long*)(Pl + l15 * 72 + jb) = (unsigned long long)pk2(m0, m1) | ((unsigned long long)pk2(m2, m3) << 32); }
                    { const int ii = i0 + 16 + l15;
                      const float m0 = (jb + 0 <= ii) ? p1[0] : 0.f, m1 = (jb + 1 <= ii) ? p1[1] : 0.f, m2 = (jb + 2 <= ii) ? p1[2] : 0.f, m3 = (jb + 3 <= ii) ? p1[3] : 0.f;
                      *(LAS unsigned long long*)(Pl + (16 + l15) * 72 + jb) = (unsigned long long)pk2(m0, m1) | ((unsigned long long)pk2(m2, m3) << 32); }
                }
                LDS_WAIT(); asm volatile("" ::: "memory");
                const int nks = half + 1;
                for (int kj = 0; kj < nks; ++kj) {
                    const bf16x8 b0 = *(const LAS bf16x8*)(Pl + l15 * 72 + 32 * kj + 8 * q4), b1 = *(const LAS bf16x8*)(Pl + (16 + l15) * 72 + 32 * kj + 8 * q4);
#pragma unroll
                    for (int dvt = 0; dvt < 8; ++dvt) { const bf16x8 a = *(const bf16x8*)(vt + (16 * dvt + l15) * 64 + 32 * kj + 8 * q4);
                        acc[dvt][0] = __builtin_amdgcn_mfma_f32_16x16x32_bf16(a, b0, acc[dvt][0], 0, 0, 0);
                        acc[dvt][1] = __builtin_amdgcn_mfma_f32_16x16x32_bf16(a, b1, acc[dvt][1], 0, 0, 0); }
                }
#pragma unroll
                for (int it = 0; it < 2; ++it) {
                    float ss = 0.f;
#pragma unroll
                    for (int dvt = 0; dvt < 8; ++dvt) { const f32x4 v = acc[dvt][it]; ss += (v[0] * v[0] + v[1] * v[1]) + (v[2] * v[2] + v[3] * v[3]); }
                    ss += __shfl_xor(ss, 16); ss += __shfl_xor(ss, 32);
                    const float rinv = 1.0f / sqrtf(ss * (1.0f / 128.0f) + RMS_EPS);
                    const size_t tok = (size_t)row0 + i0 + 16 * it + l15;
#pragma unroll
                    for (int dvt = 0; dvt < 8; ++dvt) { const f32x4 g4 = *(const f32x4*)(hg_norm_g + h * 128 + 16 * dvt + 4 * q4); const f32x4 o = acc[dvt][it] * rinv * g4;
                        *(unsigned long long*)(ON + tok * D + h * 128 + 16 * dvt + 4 * q4) = (unsigned long long)pk2(o[0], o[1]) | ((unsigned long long)pk2(o[2], o[3]) << 32); }
                }
                LDS_WAIT(); asm volatile("" ::: "memory");
            }
        }
    }
    SEAM(5);
    if (IN(6)) { EpiZ2 E{ON, Zc, Zg}; run_gemm(F, XB, WinT + (size_t)3072 * D, T, 6144, D, E); }
    SEAM(6);
    if (IN(7)) {
        for (int i = gtid; i < T * (D / 8); i += NT) {
            const int row = i / (D / 8), c0 = (i % (D / 8)) * 8, t = row % SEQ;
            float cb[8], u0[8], u1[8], u2[8], a[8], b[8];
            unpack8(*(const v4u*)(Zc + (size_t)row * 3072 + c0), cb);
            unpack8(*(const v4u*)(Zc + (size_t)row * 3072 + 1024 + c0), a); unpack8(*(const v4u*)(Zc + (size_t)row * 3072 + 2048 + c0), b);
#pragma unroll
            for (int j = 0; j < 8; ++j) u2[j] = a[j] * b[j];
            if (t >= 1) { unpack8(*(const v4u*)(Zc + (size_t)(row - 1) * 3072 + 1024 + c0), a); unpack8(*(const v4u*)(Zc + (size_t)(row - 1) * 3072 + 2048 + c0), b);
#pragma unroll
                for (int j = 0; j < 8; ++j) u1[j] = a[j] * b[j]; }
            else {
#pragma unroll
                for (int j = 0; j < 8; ++j) u1[j] = 0.f; }
            if (t >= 2) { unpack8(*(const v4u*)(Zc + (size_t)(row - 2) * 3072 + 1024 + c0), a); unpack8(*(const v4u*)(Zc + (size_t)(row - 2) * 3072 + 2048 + c0), b);
#pragma unroll
                for (int j = 0; j < 8; ++j) u0[j] = a[j] * b[j]; }
            else {
#pragma unroll
                for (int j = 0; j < 8; ++j) u0[j] = 0.f; }
            float y[8];
#pragma unroll
            for (int j = 0; j < 8; ++j) { const int c = c0 + j; y[j] = cb[j] * (conv_b[c] + conv_w[c] * u0[j] + conv_w[1024 + c] * u1[j] + conv_w[2048 + c] * u2[j]); }
            *(v4u*)(YC + (size_t)row * D + c0) = pack8(y);
        }
        convert_rows(pk_u, UB, (size_t)16384 * D, gtid, NT);
        convert_rows(pk_v, VB, (size_t)16384 * D, gtid, NT);
    }
    SEAM(7);
    if (IN(8)) { EpiGateA E{TMP, Zg}; run_gemm(F, OA, WaT, T, D, D, E); }
    SEAM(8);
    if (IN(9)) { EpiGateB E{TMP, Zg, MERGED}; run_gemm(F, YC, WbT, T, D, D, E); }
    SEAM(9);
    if (IN(10)) { EpiResid E{x, Y}; run_gemm(F, MERGED, WoT, T, D, D, E); }
    SEAM(10);
    if (IN(11)) {
        for (int row = gw; row < T; row += NGW) {
            f32x4 v[4];
#pragma unroll
            for (int j = 0; j < 4; ++j) v[j] = *(const f32x4*)(Y + (size_t)row * D + 4 * F.lane + 256 * j);
            ln_row_store(v, ln1_g, ln1_b, X1 + (size_t)row * D, X1B + (size_t)row * D, F.lane);
        }
    }
    SEAM(11);
    if (IN(12)) {
        { EpiStore E{QP, 2048}; run_gemm(F, X1B, WqT, T, 2048, D, E); }
        { EpiStore E{PP, D}; run_gemm(F, PB, WppT, T, D, PLE, E); }
    }
    SEAM(12);
    if (IN(13)) {
        const int lane = F.lane, r31 = lane & 31, hh = lane >> 5;
        LAS unsigned* ib = (LAS unsigned*)(F.lds + F.wave * 4096) + lane * 8;
        const float NEGV = -3.0e38f;
#define TK_INS(L, xx) do { const float x_ = (xx); _Pragma("unroll") for (int i_ = 15; i_ >= 1; --i_) L[i_] = __builtin_amdgcn_fmed3f(L[i_ - 1], L[i_], x_); L[0] = fmaxf(L[0], x_); } while (0)
        for (int task = gw; task < (T / 32) * PKH; task += NGW) {
            const int tg = task >> 3, h = task & 7; const size_t t = (size_t)tg * 32 + r31;
            float L1[16], L2[16];
#pragma unroll
            for (int p2 = 0; p2 < 2; ++p2) {
                float L[16];
#pragma unroll
                for (int i = 0; i < 16; ++i) L[i] = NEGV;
                bf16x8 bq[8];
#pragma unroll
                for (int ks = 0; ks < 8; ++ks) bq[ks] = *(const bf16x8*)(QP + t * 2048 + h * 256 + p2 * 128 + 16 * ks + 8 * hh);
#pragma unroll
                for (int kt = 0; kt < 4; ++kt) {
                    f32x16 acc;
#pragma unroll
                    for (int i = 0; i < 16; ++i) acc[i] = 0.f;
                    const bf16* krow = SKB + ((size_t)((h * 2 + p2) * 128 + 32 * kt + r31)) * 128 + 8 * hh;
#pragma unroll
                    for (int ks = 0; ks < 8; ++ks) { const bf16x8 a = *(const bf16x8*)(krow + 16 * ks); acc = __builtin_amdgcn_mfma_f32_32x32x16_bf16(a, bq[ks], acc, 0, 0, 0); }
#pragma unroll
                    for (int rg = 0; rg < 16; ++rg) { const float xv = acc[rg]; const int idxc = 32 * kt + (rg & 3) + 8 * (rg >> 2);
                        const float xp = __int_as_float((__float_as_int(xv) & ~0x7F) | idxc); TK_INS(L, xp); }
                }
                float P[16];
#pragma unroll
                for (int i = 0; i < 16; ++i) { L[i] = __int_as_float(__float_as_int(L[i]) | (4 * hh)); P[i] = __shfl_xor(L[i], 32); }
#pragma unroll
                for (int i = 0; i < 16; ++i) TK_INS(L, P[i]);
#pragma unroll
                for (int i = 0; i < 16; ++i) { if (p2 == 0) L1[i] = L[i]; else L2[i] = L[i]; }
            }
            unsigned ix1[16], ix2[16];
#pragma unroll
            for (int i = 0; i < 16; ++i) { ix1[i] = (unsigned)__float_as_int(L1[i]) & 0x7Fu; ix2[i] = (unsigned)__float_as_int(L2[i]) & 0x7Fu;
                L1[i] = __int_as_float(__float_as_int(L1[i]) & ~0x7F); L2[i] = __int_as_float(__float_as_int(L2[i]) & ~0x7F); }
#pragma unroll
            for (int i = 0; i < 4; ++i) { ib[i] = ix1[4 * i] | (ix1[4 * i + 1] << 8) | (ix1[4 * i + 2] << 16) | (ix1[4 * i + 3] << 24);
                                          ib[4 + i] = ix2[4 * i] | (ix2[4 * i + 1] << 8) | (ix2[4 * i + 2] << 16) | (ix2[4 * i + 3] << 24); }
            float W[16];
#pragma unroll
            for (int i = 0; i < 16; ++i) W[i] = NEGV;
#pragma unroll
            for (int a = 0; a < 16; ++a)
#pragma unroll
                for (int b = 0; b < 16; ++b)
                    if ((a + 1) * (b + 1) <= 16) { const float c = L1[a] + L2[b]; const float cp = __int_as_float((__float_as_int(c) & ~0xFF) | (a * 16 + b)); TK_INS(W, cp); }
            LDS_WAIT(); asm volatile("" ::: "memory");
            const LAS unsigned char* ibb = (const LAS unsigned char*)ib;
            int eid[16]; float ev[16];
#pragma unroll
            for (int k = 0; k < 16; ++k) { const int bits = __float_as_int(W[k]); const int a = (bits >> 4) & 15, b = bits & 15;
                eid[k] = (int)ibb[a] * 128 + (int)ibb[16 + b]; ev[k] = __int_as_float(bits & ~0xFF); }
            float sum = 0.f; const float mx = ev[0];
#pragma unroll
            for (int k = 0; k < 16; ++k) { ev[k] = expf(ev[k] - mx); sum += ev[k]; }
            const float inv = 1.0f / sum;
            if (hh == 0) {
#pragma unroll
                for (int k4 = 0; k4 < 4; ++k4) {
                    *(v4u*)(IDS + t * 128 + h * 16 + 4 * k4) = (v4u){(unsigned)eid[4 * k4], (unsigned)eid[4 * k4 + 1], (unsigned)eid[4 * k4 + 2], (unsigned)eid[4 * k4 + 3]};
                    *(f32x4*)(GW + t * 128 + h * 16 + 4 * k4) = (f32x4){ev[4 * k4] * inv, ev[4 * k4 + 1] * inv, ev[4 * k4 + 2] * inv, ev[4 * k4 + 3] * inv}; }
            }
            LDS_WAIT(); asm volatile("" ::: "memory");
        }
#undef TK_INS
    }
    SEAM(13);
    if (IN(14)) {
        const int lane = F.lane, q4 = lane >> 4, l15 = lane & 15;
        LAS bf16* xs = (LAS bf16*)(F.lds + F.wave * 4096);
        for (int t = gw; t < T; t += NGW) {
            { const v4u a = *(const v4u*)(X1B + (size_t)t * D + lane * 16), b = *(const v4u*)(X1B + (size_t)t * D + lane * 16 + 8);
              *(LAS v4u*)(xs + lane * 16) = a; *(LAS v4u*)(xs + lane * 16 + 8) = b; }
            const int id0 = IDS[(size_t)t * 128 + lane], id1 = IDS[(size_t)t * 128 + 64 + lane];
            const bf16* urow[8];
#pragma unroll
            for (int bb = 0; bb < 8; ++bb) { const int e = __shfl(bb < 4 ? id0 : id1, (bb & 3) * 16 + l15); urow[bb] = UB + (size_t)e * D + 8 * q4; }
            f32x4 hacc[8];
#pragma unroll
            for (int bb = 0; bb < 8; ++bb) hacc[bb] = (f32x4){0.f, 0.f, 0.f, 0.f};
            LDS_WAIT(); asm volatile("" ::: "memory");
            for (int sp = 0; sp < 16; ++sp) {
                const bf16x8 b0 = *(const LAS bf16x8*)(xs + 64 * sp + 8 * q4), b1 = *(const LAS bf16x8*)(xs + 64 * sp + 32 + 8 * q4);
                bf16x8 a0[8], a1[8];
#pragma unroll
                for (int bb = 0; bb < 8; ++bb) { a0[bb] = *(const bf16x8*)(urow[bb] + 64 * sp); a1[bb] = *(const bf16x8*)(urow[bb] + 64 * sp + 32); }
#pragma unroll
                for (int bb = 0; bb < 8; ++bb) { hacc[bb] = __builtin_amdgcn_mfma_f32_16x16x32_bf16(a0[bb], b0, hacc[bb], 0, 0, 0);
                                                  hacc[bb] = __builtin_amdgcn_mfma_f32_16x16x32_bf16(a1[bb], b1, hacc[bb], 0, 0, 0); }
            }
#pragma unroll
            for (int bb = 0; bb < 8; ++bb) { const f32x4 g4 = *(const f32x4*)(GW + (size_t)t * 128 + bb * 16 + 4 * q4);
#pragma unroll
                for (int r = 0; r < 4; ++r) hacc[bb][r] = g4[r] * gelu_erf(hacc[bb][r]); }
            float o[16];
#pragma unroll
            for (int j = 0; j < 16; ++j) o[j] = 0.f;
#pragma unroll
            for (int bb = 0; bb < 8; ++bb) {
#pragma unroll
                for (int qq = 0; qq < 4; ++qq)
#pragma unroll
                    for (int r = 0; r < 4; ++r) {
                        const int i = bb * 16 + qq * 4 + r;
                        const float hv = hacc[bb][r];
                        const float w = __builtin_bit_cast(float, __builtin_amdgcn_readlane(__builtin_bit_cast(int, hv), qq * 16));
                        const int e = __builtin_amdgcn_readlane(i < 64 ? id0 : id1, i & 63);
                        const bf16* vr = VB + (size_t)e * D + lane * 16;
                        const v4u v0 = *(const v4u*)vr, v1 = *(const v4u*)(vr + 8);
                        o[0] += w * bflo(v0.x); o[1] += w * bfhi(v0.x); o[2] += w * bflo(v0.y); o[3] += w * bfhi(v0.y);
                        o[4] += w * bflo(v0.z); o[5] += w * bfhi(v0.z); o[6] += w * bflo(v0.w); o[7] += w * bfhi(v0.w);
                        o[8] += w * bflo(v1.x); o[9] += w * bfhi(v1.x); o[10] += w * bflo(v1.y); o[11] += w * bfhi(v1.y);
                        o[12] += w * bflo(v1.z); o[13] += w * bfhi(v1.z); o[14] += w * bflo(v1.w); o[15] += w * bfhi(v1.w);
                    }
            }
            float* xrow = X1 + (size_t)t * D + lane * 16;
            float sm = 0.f;
#pragma unroll
            for (int j = 0; j < 4; ++j) { const f32x4 xv = *(const f32x4*)(xrow + 4 * j);
                o[4 * j] += ALPHA * xv.x; o[4 * j + 1] += ALPHA * xv.y; o[4 * j + 2] += ALPHA * xv.z; o[4 * j + 3] += ALPHA * xv.w; }
#pragma unroll
            for (int j = 0; j < 16; ++j) sm += o[j];
            const float mean = wave_sum(sm) * (1.f / D); float s2 = 0.f;
#pragma unroll
            for (int j = 0; j < 16; ++j) { o[j] -= mean; s2 += o[j] * o[j]; }
            const float rstd = 1.f / sqrtf(wave_sum(s2) * (1.f / D) + LN_EPS);
            float res[16];
#pragma unroll
            for (int j = 0; j < 4; ++j) { const f32x4 gg = *(const f32x4*)(ln2_g + lane * 16 + 4 * j), bb4 = *(const f32x4*)(ln2_b + lane * 16 + 4 * j);
                f32x4 r4; r4.x = o[4 * j] * rstd * gg.x + bb4.x; r4.y = o[4 * j + 1] * rstd * gg.y + bb4.y; r4.z = o[4 * j + 2] * rstd * gg.z + bb4.z; r4.w = o[4 * j + 3] * rstd * gg.w + bb4.w;
                *(f32x4*)(xrow + 4 * j) = r4; res[4 * j] = r4.x; res[4 * j + 1] = r4.y; res[4 * j + 2] = r4.z; res[4 * j + 3] = r4.w; }
            { float r0[8], r1[8];
#pragma unroll
              for (int j = 0; j < 8; ++j) { r0[j] = res[j]; r1[j] = res[8 + j]; }
              *(v4u*)(X2B + (size_t)t * D + lane * 16) = pack8(r0); *(v4u*)(X2B + (size_t)t * D + lane * 16 + 8) = pack8(r1); }
            LDS_WAIT(); asm volatile("" ::: "memory");
        }
    }
    SEAM(14);
    if (IN(15)) { EpiFinal E{X1, PP, out}; run_gemm(F, X2B, WpgT, T, D, D, E); }
#undef IN
#undef SEAM
}

extern "C" void kernel_launch(void* const* d_in, const int* in_sizes, int n_in, void* d_out, int out_size, void* d_ws, size_t ws_size, hipStream_t stream) {
    static int grid = 0;
    if (grid == 0) {
        if (n_in != 20 || out_size != T * D || ws_size < WS_END) { fprintf(stderr, "kernel_launch: unexpected shapes (n_in %d out %d ws %zu)\n", n_in, out_size, ws_size); grid = -1; return; }
        int dev = 0, cus = 0;
        if (hipGetDevice(&dev) != hipSuccess || hipDeviceGetAttribute(&cus, hipDeviceAttributeMultiprocessorCount, dev) != hipSuccess) { grid = -1; return; }
        if (hipFuncSetAttribute((const void*)skel_fwd, hipFuncAttributeMaxDynamicSharedMemorySize, LDS_BYTES) != hipSuccess) { fprintf(stderr, "kernel_launch: hipFuncSetAttribute failed\n"); grid = -1; return; }
        (void)hipGetLastError();
        grid = cus;
    }
    if (grid < 0) return;
    if (hipMemsetAsync((char*)d_ws + WS_CTL, 0, CTL_ZERO_BYTES, stream) != hipSuccess) return;
    Args a{};
    for (int i = 0; i < 20; ++i) a.in[i] = (const float*)d_in[i];
    a.out = (float*)d_out; a.ws = (unsigned char*)d_ws;
    if (N_LAUNCHES == 1) {
        a.ph_lo = 0; a.ph_hi = NPHASES; a.li = 0;
        hipLaunchKernelGGL(skel_fwd, dim3(grid), dim3(NWAVES * 64), LDS_BYTES, stream, a);
    } else {
        for (int li = 0; li < NPHASES; ++li) {
            a.ph_lo = li; a.ph_hi = li + 1; a.li = li;
            hipLaunchKernelGGL(skel_fwd, dim3(grid), dim3(NWAVES * 64), LDS_BYTES, stream, a);
        }
    }
}
```

```cpp
#include <hip/hip_runtime.h>
#include <cstdio>
#include <cstdint>
#include <cmath>

#ifndef MK_N_LAUNCHES
#define MK_N_LAUNCHES 1
#endif

constexpr int BATCH = 2, SEQ = 8192, D = 1024, T = BATCH * SEQ;
constexpr int PROJ_W = 9216;
constexpr int NHEAD = 8, DK = 128;
constexpr int PKH = 8, PKD = 256, NKEYS = 128, TOPK = 16;
constexpr int PLE = 256;
constexpr float LN_EPS = 1e-5f, RMS_EPS = 1e-6f;
constexpr float ALPHA = 1.189207115002721f;
constexpr int NWAVES = 8;
constexpr int NPHASES = 16;
constexpr int N_LAUNCHES = MK_N_LAUNCHES;

constexpr size_t MiB = 1u << 20;
constexpr size_t WS_CTL = 0, CTL_ZERO_BYTES = 1 * MiB;
constexpr size_t WS_WIN = 1 * MiB;
constexpr size_t WS_WA = 19 * MiB, WS_WB = 21 * MiB, WS_WO = 23 * MiB, WS_WPG = 25 * MiB;
constexpr size_t WS_WQ = 27 * MiB;
constexpr size_t WS_SK = 31 * MiB;
constexpr size_t WS_WPP = 31 * MiB + 512 * 1024;
constexpr size_t WS_XB = 32 * MiB;
constexpr size_t WS_BIG = 64 * MiB;
constexpr size_t WS_ZC = 64 * MiB;
constexpr size_t WS_ZG = 160 * MiB;
constexpr size_t WS_VT = 160 * MiB;
constexpr size_t WS_KET = 192 * MiB;
constexpr size_t WS_X1 = 128 * MiB;
constexpr size_t WS_X1B = 192 * MiB;
constexpr size_t WS_OA = 224 * MiB;
constexpr size_t WS_PB = 256 * MiB;
constexpr size_t WS_DEC = 264 * MiB;
constexpr size_t WS_END = 265 * MiB;
constexpr size_t WS_YC = WS_XB;
constexpr size_t WS_IDS = WS_XB;
constexpr size_t WS_GW = WS_XB + 8 * MiB;
constexpr size_t WS_Y = WS_BIG;
constexpr size_t WS_QP = WS_BIG;
constexpr size_t WS_X2B = WS_BIG;
constexpr int CW_BAR = 4096;

constexpr int LDS_BYTES = 147456;
constexpr int RING_BYTES = 131072, LDSCTL_OFF = RING_BYTES, MISC_OFF = LDSCTL_OFF + 320;

#define GAS __attribute__((address_space(1)))
#define LAS __attribute__((address_space(3)))
typedef unsigned short bf16;
typedef unsigned v4u __attribute__((ext_vector_type(4)));
typedef float f32x4 __attribute__((ext_vector_type(4)));
typedef float f32x2 __attribute__((ext_vector_type(2)));
typedef short bf16x8 __attribute__((ext_vector_type(8)));
typedef float f32x16 __attribute__((ext_vector_type(16)));
typedef GAS unsigned gu32;
#define RLX_AGENT __ATOMIC_RELAXED, __HIP_MEMORY_SCOPE_AGENT
#define LDS_WAIT() asm volatile("s_waitcnt lgkmcnt(0)" ::: "memory")

__device__ __forceinline__ unsigned f2bf(float f) { unsigned u = __builtin_bit_cast(unsigned, f); return (u + 0x7fffu + ((u >> 16) & 1u)) >> 16; }
__device__ __forceinline__ unsigned pk2(float lo, float hi) { return f2bf(lo) | (f2bf(hi) << 16); }
__device__ __forceinline__ float bf2f(unsigned short h) { return __builtin_bit_cast(float, (unsigned)h << 16); }
__device__ __forceinline__ float bflo(unsigned w) { return __builtin_bit_cast(float, w << 16); }
__device__ __forceinline__ float bfhi(unsigned w) { return __builtin_bit_cast(float, w & 0xffff0000u); }
__device__ __forceinline__ void unpack8(const v4u w, float (&o)[8]) { o[0] = bflo(w.x); o[1] = bfhi(w.x); o[2] = bflo(w.y); o[3] = bfhi(w.y); o[4] = bflo(w.z); o[5] = bfhi(w.z); o[6] = bflo(w.w); o[7] = bfhi(w.w); }
__device__ __forceinline__ v4u pack8(const float (&v)[8]) { v4u w; w.x = pk2(v[0], v[1]); w.y = pk2(v[2], v[3]); w.z = pk2(v[4], v[5]); w.w = pk2(v[6], v[7]); return w; }
__device__ __forceinline__ float sigmoidf_(float x) { return 1.0f / (1.0f + __expf(-x)); }
__device__ __forceinline__ float wave_sum(float v) {
#pragma unroll
    for (int o = 1; o < 64; o <<= 1) v += __shfl_xor(v, o);
    return v;
}

#define XB_TMO      128
#define XB_XCNT(j)  (256  + 64 * (j))
#define XB_XSUB(j)  (1280 + 64 * (j))
#define XB_XGEN(j)  (2304 + 64 * (j))
#define XB_TOP      3328
#define XB_TOPGEN   3392
#define XCD_BAR_WORDS 3456
#define XB_SPIN_CAP (1u << 26)

__device__ __forceinline__ unsigned xb_ld(unsigned* p)              { return __hip_atomic_load(p, __ATOMIC_RELAXED, __HIP_MEMORY_SCOPE_AGENT); }
__device__ __forceinline__ unsigned xb_add(unsigned* p, unsigned v) { return __hip_atomic_fetch_add(p, v, __ATOMIC_RELAXED, __HIP_MEMORY_SCOPE_AGENT); }
__device__ __forceinline__ unsigned xb_xcc_id() { return (unsigned)__builtin_amdgcn_s_getreg((3 << 11) | 20) & 0xFu; }
#define XB_SPIN(cond, bar) do { unsigned _sp = 0; while (cond) { __builtin_amdgcn_s_sleep(1); \
    if ((++_sp & 255u) == 0u) { if (xb_ld(&(bar)[XB_TMO])) break; if (_sp > XB_SPIN_CAP) { atomicAdd(&(bar)[XB_TMO], 1u); break; } } } } while (0)

struct XcdBarrier { unsigned* bar; unsigned x; volatile LAS unsigned* st; };

__device__ __forceinline__ XcdBarrier xcd_barrier_post(unsigned* bar, volatile LAS unsigned* st) {
    XcdBarrier b; b.bar = bar; b.x = xb_xcc_id(); b.st = st;
    if (threadIdx.x == 0) (void)xb_add(&bar[XB_XCNT(b.x)], 1u);
    return b;
}
__device__ __forceinline__ void xcd_barrier_complete(unsigned* bar, unsigned x, unsigned& nloc, unsigned& nx) {
    const unsigned G = gridDim.x * gridDim.y * gridDim.z;
    unsigned sum, cnt, mine, sp = 0u;
    for (;;) {
        sum = 0u; cnt = 0u; mine = 0u;
#pragma unroll
        for (unsigned j = 0; j < 16; ++j) { const unsigned c = xb_ld(&bar[XB_XCNT(j)]); sum += c; cnt += (c > 0u) ? 1u : 0u; mine = (j == x) ? c : mine; }
        if (sum == G) break;
        __builtin_amdgcn_s_sleep(1);
        if ((++sp & 255u) == 0u) { if (xb_ld(&bar[XB_TMO])) break; if (sp > XB_SPIN_CAP) { atomicAdd(&bar[XB_TMO], 1u); break; } }
    }
    nloc = mine > 0u ? mine : 1u; nx = cnt > 0u ? cnt : 1u;
}
__device__ __forceinline__ void xcd_barrier(const XcdBarrier& b) {
    asm volatile("s_waitcnt vmcnt(0)" ::: "memory");
    __syncthreads();
    if (threadIdx.x == 0) {
        unsigned* bar = b.bar;
        __builtin_amdgcn_s_waitcnt(0);
        unsigned nloc = b.st[0], nx = b.st[1];
        if (nloc == 0u) { xcd_barrier_complete(bar, b.x, nloc, nx); b.st[0] = nloc; b.st[1] = nx; }
        const unsigned old = xb_add(&bar[XB_XSUB(b.x)], 1u);
        const unsigned gen = old / nloc;
        if (old + 1u == (gen + 1u) * nloc) {
            __builtin_amdgcn_fence(__ATOMIC_RELEASE, "agent");
            asm volatile("s_waitcnt vmcnt(0)" ::: "memory");
            const unsigned og = xb_add(&bar[XB_TOP], 1u);
            const unsigned tg = og / nx;
            if (og + 1u == (tg + 1u) * nx) xb_add(&bar[XB_TOPGEN], 1u);
            else XB_SPIN(xb_ld(&bar[XB_TOPGEN]) == tg, bar);
            __builtin_amdgcn_fence(__ATOMIC_ACQUIRE, "agent");
            xb_add(&bar[XB_XGEN(b.x)], 1u);
            asm volatile("s_waitcnt vmcnt(0)" ::: "memory");
        } else {
            XB_SPIN(xb_ld(&bar[XB_XGEN(b.x)]) == gen, bar);
            __builtin_amdgcn_fence(__ATOMIC_ACQUIRE, "agent");
            asm volatile("s_waitcnt vmcnt(0)" ::: "memory");
        }
    }
    __syncthreads();
}

struct Frame {
    LAS unsigned char* lds;
    int tid, lane, wave, vcu, G;
};

struct Args {
    const float* in[20]; float* out; unsigned char* ws; int ph_lo, ph_hi, li, pad;
};

__device__ __forceinline__ void p0_transpose_item(const float* W, int K, int N, bf16* WT, LAS float* scr, int item, int lane) {
    const int nblk = N / 32, kb = item / nblk, nb = item % nblk, k0 = 64 * kb, n0 = 32 * nb;
#pragma unroll 8
    for (int i = 0; i < 32; ++i) { const int kk = 2 * i + (lane >> 5); scr[kk * 33 + (lane & 31)] = W[(size_t)(k0 + kk) * N + n0 + (lane & 31)]; }
    LDS_WAIT(); asm volatile("" ::: "memory");
    const int c = lane & 7;
#pragma unroll
    for (int j = 0; j < 4; ++j) { const int n = (lane >> 3) + 8 * j; const LAS float* s = scr + (8 * c) * 33 + n;
        v4u o; o.x = pk2(s[0 * 33], s[1 * 33]); o.y = pk2(s[2 * 33], s[3 * 33]); o.z = pk2(s[4 * 33], s[5 * 33]); o.w = pk2(s[6 * 33], s[7 * 33]);
        *(v4u*)(WT + (size_t)(n0 + n) * K + k0 + 8 * c) = o; }
    LDS_WAIT(); asm volatile("" ::: "memory");
}
__device__ __forceinline__ void convert_rows(const float* src, bf16* dst, size_t n, int gtid, int nthreads) {
    for (size_t i = (size_t)gtid * 8; i < n; i += (size_t)nthreads * 8) {
        const f32x4 a = *(const f32x4*)(src + i), b = *(const f32x4*)(src + i + 4);
        v4u o; o.x = pk2(a.x, a.y); o.y = pk2(a.z, a.w); o.z = pk2(b.x, b.y); o.w = pk2(b.z, b.w);
        *(v4u*)(dst + i) = o;
    }
}

namespace pg8 {
#define PG8_LAS __attribute__((address_space(3)))
typedef unsigned short bf16_t;
typedef short bf16x8 __attribute__((ext_vector_type(8)));
typedef float f32x4 __attribute__((ext_vector_type(4)));
typedef unsigned u32x4 __attribute__((ext_vector_type(4)));
constexpr int BM = 256, BK = 64, HALF = 128, HTB = HALF * BK * 2  , STAGE_BYTES = 8 * HTB, NXCD = 8, WGM = 8;

__host__ __device__ __forceinline__ int lds_byte(int r, int c) { const int st = (r >> 4) * 2 + (c >> 5), rr = r & 15, cc = c & 31, ob = rr * 64 + cc * 2; return st * 1024 + (ob ^ (((ob >> 9) & 1) << 5)); }
__host__ __device__ __forceinline__ void stage_rc(int b, int& R, int& C) { const int st = b / 1024, sb = b % 1024, swz = sb ^ (((sb >> 9) & 1) << 5); R = (st >> 1) * 16 + swz / 64; C = (st & 1) * 32 + (swz % 64) / 2; }
__host__ __device__ __forceinline__ int perm32(int rho) { const int n = rho >> 4, i = rho & 15; return 8 * (i >> 2) + 4 * n + (i & 3); }

struct Unit { int pm, pn; };
struct Gemm { const bf16_t* A; const bf16_t* Bt; int M, N, K; };

struct StaticOrder {
    int nM, nN, nwg, G, c;
    __host__ __device__ void init(int M, int N, int G_, int c_) { nM = M / BM; nN = N / BM; nwg = nM * nN; G = G_; c = c_; }
    __host__ __device__ bool next(int i, Unit& u) const {
        const long L = (long)i * G + c; if (L >= nwg) return false;
        int wgid = (int)L; { const int q = nwg / NXCD, r = nwg % NXCD, xcd = wgid % NXCD, off = wgid / NXCD; wgid = (xcd < r ? xcd * (q + 1) : r * (q + 1) + (xcd - r) * q) + off; }
        const int nig = WGM * nN, gid = wgid / nig, fm = gid * WGM, gsz = (nM - fm) < WGM ? (nM - fm) : WGM;
        u.pm = fm + ((wgid % nig) % gsz); u.pn = (wgid % nig) / gsz; return true;
    }
    __device__ __forceinline__ void a_ready(const Unit&) const {}
    __device__ __forceinline__ void done(const Unit&) const {}
};

__device__ __forceinline__ unsigned cvt_pk_bf16(float lo, float hi) { unsigned r; asm volatile("v_cvt_pk_bf16_f32 %0, %1, %2" : "=v"(r) : "v"(lo), "v"(hi)); return r; }
typedef float f32x2 __attribute__((ext_vector_type(2)));
template <class Epi, class Sched, bool ALIGN_EPI = false, bool SP2 = false>
__device__ __forceinline__ void gemm_phase(PG8_LAS unsigned char* lds, const Gemm g, const Sched& S, const Epi& E) {
    const int tid = threadIdx.x, wid = __builtin_amdgcn_readfirstlane(tid >> 6), lane = tid & 63, wr = wid >> 2, wc = wid & 3, fr = lane & 15, fq = lane >> 4;
    const int K = g.K, nt = K / BK;
    unsigned voffA[2], voffB[2];
#pragma unroll
    for (int i = 0; i < 2; ++i) { int R, C; stage_rc(tid * 16 + i * 8192, R, C); const int Rb = Epi::PERM ? ((R & ~31) + perm32(R & 31)) : R;
        voffA[i] = (unsigned)(R * K + C) * 2u; voffB[i] = (unsigned)(Rb * K + C) * 2u; }
    const size_t kstep = (size_t)(BK * 2);
    const size_t hstep = (size_t)HALF * K * 2;
    const size_t tstep = 2 * hstep;
    const unsigned ldsw = (unsigned)wid * 1024u;
    const int aoff = lds_byte(wr * 64 + fr, fq * 8), boff = lds_byte(wc * 32 + fr, fq * 8);
#define PG8_SA(b, h) (((b) * 2 + (h)) * HTB)
#define PG8_SB(b, h) ((4 + (b) * 2 + (h)) * HTB)
#define PG8_STAGE(bufoff, gbase, voff) do { _Pragma("unroll") for (int _i = 0; _i < 2; ++_i) \
        __builtin_amdgcn_global_load_lds((const unsigned*)((const char*)(gbase) + (voff)[_i]), (PG8_LAS unsigned*)(lds + (bufoff) + ldsw + _i * 8192), 16, 0, 0); } while (0)
#define PG8_LDA(dst, b, h) do { _Pragma("unroll") for (int m = 0; m < 4; ++m) _Pragma("unroll") for (int k = 0; k < 2; ++k) dst[m][k] = *(const PG8_LAS bf16x8*)(lds + PG8_SA(b, h) + aoff + m * 2048 + k * 1024); } while (0)
#define PG8_LDB(dst, b, h) do { _Pragma("unroll") for (int n = 0; n < 2; ++n) _Pragma("unroll") for (int k = 0; k < 2; ++k) dst[n][k] = *(const PG8_LAS bf16x8*)(lds + PG8_SB(b, h) + boff + n * 2048 + k * 1024); } while (0)
#define PG8_MMA(ai, bj, At, Bt) do { __builtin_amdgcn_s_setprio(1); _Pragma("unroll") for (int m = 0; m < 4; ++m) _Pragma("unroll") for (int n = 0; n < 2; ++n) _Pragma("unroll") for (int k = 0; k < 2; ++k) \
        acc[ai][bj][m][n] = __builtin_amdgcn_mfma_f32_16x16x32_bf16(Bt[n][k], At[m][k], acc[ai][bj][m][n], 0, 0, 0); __builtin_amdgcn_s_setprio(0); } while (0)
#define PG8_WAIT_V(n) asm volatile("s_waitcnt vmcnt(" #n ")" ::: "memory")
#define PG8_WAIT_L(n) asm volatile("s_waitcnt lgkmcnt(" #n ")" ::: "memory")
#define PG8_BAR __builtin_amdgcn_s_barrier()
#define PG8_SCHED __builtin_amdgcn_sched_barrier(0)
    Unit cur, nxt; int ui = 0;
    if (!S.next(0, cur)) return;
    f32x4 acc[2][2][4][2];
#pragma unroll
    for (int a = 0; a < 2; ++a)
#pragma unroll
        for (int b = 0; b < 2; ++b)
#pragma unroll
            for (int m = 0; m < 4; ++m)
#pragma unroll
                for (int n = 0; n < 2; ++n) acc[a][b][m][n] = (f32x4){0.f, 0.f, 0.f, 0.f};
    bf16x8 At[4][2], B0[2][2], B1[2][2];
    const char* cA = (const char*)g.A + (size_t)cur.pm * tstep; const char* cB = (const char*)g.Bt + (size_t)cur.pn * tstep;
    S.a_ready(cur);
    if constexpr (SP2) {
        PG8_STAGE(PG8_SB(0, 0), cB, voffB); PG8_STAGE(PG8_SB(0, 1), cB + hstep, voffB); PG8_STAGE(PG8_SA(0, 0), cA, voffA); PG8_STAGE(PG8_SA(0, 1), cA + hstep, voffA);
        if (wr == 1) PG8_BAR;
        PG8_WAIT_V(2); PG8_BAR;
        PG8_STAGE(PG8_SB(1, 0), cB + kstep, voffB); PG8_STAGE(PG8_SA(1, 0), cA + kstep, voffA); PG8_STAGE(PG8_SB(1, 1), cB + hstep + kstep, voffB);
        PG8_WAIT_V(6); PG8_BAR;
    } else {
        PG8_STAGE(PG8_SB(0, 0), cB, voffB); PG8_STAGE(PG8_SA(0, 0), cA, voffA); PG8_STAGE(PG8_SB(0, 1), cB + hstep, voffB); PG8_STAGE(PG8_SA(0, 1), cA + hstep, voffA);
        if (wr == 1) PG8_BAR;
        PG8_WAIT_V(4); PG8_BAR;
        PG8_STAGE(PG8_SB(1, 0), cB + kstep, voffB); PG8_STAGE(PG8_SA(1, 0), cA + kstep, voffA); PG8_STAGE(PG8_SB(1, 1), cB + hstep + kstep, voffB);
        PG8_WAIT_V(6); PG8_BAR;
    }
    for (;;) {
        const bool has_next = S.next(ui + 1, nxt);
        const char* nA = has_next ? (const char*)g.A + (size_t)nxt.pm * tstep : cA; const char* nB = has_next ? (const char*)g.Bt + (size_t)nxt.pn * tstep : cB;
        for (int t = 0; t < nt; t += 2) {
            const bool last = (t == nt - 2);
            const char* a1 = cA + (size_t)(t + 1) * kstep;
            const char* a2 = last ? nA : cA + (size_t)(t + 2) * kstep; const char* b2 = last ? nB : cB + (size_t)(t + 2) * kstep;
            const char* a3 = a2 + kstep; const char* b3 = b2 + kstep;
            if (last && has_next) S.a_ready(nxt);
            if constexpr (SP2) {
            PG8_LDB(B0, 0, 0); PG8_LDB(B1, 0, 1); PG8_SCHED; PG8_LDA(At, 0, 0); PG8_STAGE(PG8_SA(1, 1), a1 + hstep, voffA);
            PG8_WAIT_V(8); PG8_WAIT_L(0); PG8_BAR; PG8_MMA(0, 0, At, B0); PG8_MMA(0, 1, At, B1); PG8_BAR; PG8_SCHED;
            PG8_LDA(At, 0, 1); PG8_STAGE(PG8_SB(0, 0), b2, voffB); PG8_STAGE(PG8_SB(0, 1), b2 + hstep, voffB); PG8_STAGE(PG8_SA(0, 0), a2, voffA);
            PG8_WAIT_V(8); PG8_WAIT_L(0); PG8_BAR; PG8_MMA(1, 0, At, B0); PG8_MMA(1, 1, At, B1); PG8_BAR; PG8_SCHED;
            PG8_LDB(B0, 1, 0); PG8_LDB(B1, 1, 1); PG8_SCHED; PG8_LDA(At, 1, 0); PG8_STAGE(PG8_SA(0, 1), a2 + hstep, voffA);
            PG8_WAIT_V(8); PG8_WAIT_L(0); PG8_BAR; PG8_MMA(0, 0, At, B0); PG8_MMA(0, 1, At, B1); PG8_BAR; PG8_SCHED;
            PG8_LDA(At, 1, 1); PG8_STAGE(PG8_SB(1, 0), b3, voffB); PG8_STAGE(PG8_SB(1, 1), b3 + hstep, voffB); PG8_STAGE(PG8_SA(1, 0), a3, voffA);
            PG8_WAIT_V(8); PG8_WAIT_L(0); PG8_BAR; PG8_MMA(1, 0, At, B0); PG8_MMA(1, 1, At, B1); PG8_BAR; PG8_SCHED;
            } else {
            PG8_LDB(B0, 0, 0); PG8_SCHED; PG8_LDA(At, 0, 0); PG8_STAGE(PG8_SA(1, 1), a1 + hstep, voffA);
            PG8_WAIT_L(8); PG8_BAR; PG8_WAIT_L(0); PG8_MMA(0, 0, At, B0); PG8_BAR; PG8_SCHED;
            PG8_LDB(B1, 0, 1); PG8_STAGE(PG8_SB(0, 0), b2, voffB);
            PG8_BAR; PG8_WAIT_L(0); PG8_MMA(0, 1, At, B1); PG8_BAR;
            PG8_LDA(At, 0, 1); PG8_STAGE(PG8_SA(0, 0), a2, voffA);
            PG8_BAR; PG8_WAIT_L(0); PG8_MMA(1, 0, At, B0); PG8_BAR; PG8_SCHED;
            PG8_STAGE(PG8_SB(0, 1), b2 + hstep, voffB);
            PG8_WAIT_V(6); PG8_BAR; PG8_MMA(1, 1, At, B1); PG8_BAR;
            PG8_LDB(B0, 1, 0); PG8_SCHED; PG8_LDA(At, 1, 0); PG8_STAGE(PG8_SA(0, 1), a2 + hstep, voffA);
            PG8_WAIT_L(8); PG8_BAR; PG8_WAIT_L(0); PG8_MMA(0, 0, At, B0); PG8_BAR; PG8_SCHED;
            PG8_LDB(B1, 1, 1); PG8_STAGE(PG8_SB(1, 0), b3, voffB);
            PG8_BAR; PG8_WAIT_L(0); PG8_MMA(0, 1, At, B1); PG8_BAR;
            PG8_LDA(At, 1, 1); PG8_STAGE(PG8_SA(1, 0), a3, voffA);
            PG8_BAR; PG8_WAIT_L(0); PG8_MMA(1, 0, At, B0); PG8_BAR; PG8_SCHED;
            PG8_STAGE(PG8_SB(1, 1), b3 + hstep, voffB);
            PG8_WAIT_V(6); PG8_BAR; PG8_MMA(1, 1, At, B1); PG8_BAR;
            }
        }
        if constexpr (ALIGN_EPI) { if (wr == 0) PG8_BAR; }
        if constexpr (!Epi::AFTER_DRAIN) { E(acc, cur, wr, wc, fr, fq); S.done(cur); }
        if (!has_next) break;
#pragma unroll
        for (int a = 0; a < 2; ++a)
#pragma unroll
            for (int b = 0; b < 2; ++b)
#pragma unroll
                for (int m = 0; m < 4; ++m)
#pragma unroll
                    for (int n = 0; n < 2; ++n) acc[a][b][m][n] = (f32x4){0.f, 0.f, 0.f, 0.f};
        cur = nxt; cA = nA; cB = nB; ++ui;
        if constexpr (ALIGN_EPI) { if (wr == 1) PG8_BAR; }
    }
    PG8_WAIT_V(0);
    if constexpr (!ALIGN_EPI) { if (wr == 0) PG8_BAR; }
    PG8_BAR;
    if constexpr (Epi::AFTER_DRAIN) { E.fused(acc, cur, wr, wc, fr, fq, lds, wid, lane); S.done(cur); }
#undef PG8_SA
#undef PG8_SB
#undef PG8_STAGE
#undef PG8_LDA
#undef PG8_LDB
#undef PG8_MMA
#undef PG8_WAIT_V
#undef PG8_WAIT_L
#undef PG8_BAR
#undef PG8_SCHED
}

template <class Fn> struct EpiRow8 {
    static constexpr bool PERM = true, AFTER_DRAIN = false; Fn f;
    __device__ __forceinline__ void operator()(const f32x4 (&acc)[2][2][4][2], const Unit& u, int wr, int wc, int fr, int fq) const {
#pragma unroll
        for (int ai = 0; ai < 2; ++ai)
#pragma unroll
            for (int m = 0; m < 4; ++m) { const int r = u.pm * BM + ai * HALF + wr * 64 + m * 16 + fr;
#pragma unroll
                for (int bj = 0; bj < 2; ++bj) { const int c0 = u.pn * BM + bj * HALF + wc * 32 + 8 * fq;
                    const f32x4 v0 = acc[ai][bj][m][0], v1 = acc[ai][bj][m][1];
                    const float v[8] = {v0[0], v0[1], v0[2], v0[3], v1[0], v1[1], v1[2], v1[3]};
                    f.row8(r, c0, v); } }
    }
};
}

__device__ __forceinline__ void convert_fp8(const float* src, unsigned char* dst, size_t n, float scale, int gtid, int nthreads) {
    for (size_t i = (size_t)gtid * 16; i < n; i += (size_t)nthreads * 16) {
        v4u o;
#pragma unroll
        for (int j = 0; j < 4; ++j) { const f32x4 a = *(const f32x4*)(src + i + 4 * j); int w = 0;
            w = __builtin_amdgcn_cvt_pk_fp8_f32(a.x * scale, a.y * scale, w, false); w = __builtin_amdgcn_cvt_pk_fp8_f32(a.z * scale, a.w * scale, w, true);
            o[j] = (unsigned)w; }
        *(v4u*)(dst + i) = o;
    }
}

template <class Epi>
__device__ __forceinline__ void naive_gemm(const Frame& F, const bf16* A, const bf16* Bt, int M, int N, int K, const Epi& E) {
    LAS float* As = (LAS float*)F.lds;
    LAS float* Bs = As + 32 * 132;
    const int tid = F.tid, tr = tid >> 4, tc = tid & 15;
    const int ntn = N / 128, nt = (M / 128) * ntn;
    for (int tile = F.vcu; tile < nt; tile += F.G) {
        const int tm = tile / ntn, tn = tile % ntn;
        float acc[4][8];
#pragma unroll
        for (int i = 0; i < 4; ++i)
#pragma unroll
            for (int j = 0; j < 8; ++j) acc[i][j] = 0.f;
        for (int k0 = 0; k0 < K; k0 += 32) {
            { const int r = tid >> 2, kc = (tid & 3) * 8;
              const v4u a = *(const v4u*)(A + (size_t)(tm * 128 + r) * K + k0 + kc);
              const v4u b = *(const v4u*)(Bt + (size_t)(tn * 128 + r) * K + k0 + kc);
              float fa[8], fb[8]; unpack8(a, fa); unpack8(b, fb);
#pragma unroll
              for (int j = 0; j < 8; ++j) { As[(kc + j) * 132 + r] = fa[j]; Bs[(kc + j) * 132 + r] = fb[j]; } }
            __syncthreads();
#pragma unroll 8
            for (int k = 0; k < 32; ++k) {
                const f32x4 a = *(const LAS f32x4*)(As + k * 132 + tr * 4);
                const f32x4 b0 = *(const LAS f32x4*)(Bs + k * 132 + tc * 8), b1 = *(const LAS f32x4*)(Bs + k * 132 + tc * 8 + 4);
#pragma unroll
                for (int i = 0; i < 4; ++i) {
                    acc[i][0] += a[i] * b0.x; acc[i][1] += a[i] * b0.y; acc[i][2] += a[i] * b0.z; acc[i][3] += a[i] * b0.w;
                    acc[i][4] += a[i] * b1.x; acc[i][5] += a[i] * b1.y; acc[i][6] += a[i] * b1.z; acc[i][7] += a[i] * b1.w; }
            }
            __syncthreads();
        }
#pragma unroll
        for (int i = 0; i < 4; ++i) E.row8(tm * 128 + tr * 4 + i, tn * 128 + tc * 8, acc[i]);
    }
}

struct EpiStore { bf16* O; int ldc;
    __device__ __forceinline__ void row8(int r, int c0, const float (&v)[8]) const { *(v4u*)(O + (size_t)r * ldc + c0) = pack8(v); } };
struct EpiZ2 { bf16* ONOA; bf16* Zc; bf16* Zg;
    __device__ __forceinline__ void row8(int r, int c0, const float (&v)[8]) const {
        if (c0 < 1024) { float on[8], o[8]; unpack8(*(const v4u*)(ONOA + (size_t)r * D + c0), on);
#pragma unroll
            for (int j = 0; j < 8; ++j) o[j] = on[j] * (v[j] / (1.0f + __expf(-v[j])));
            *(v4u*)(ONOA + (size_t)r * D + c0) = pack8(o); }
        else if (c0 < 4096) *(v4u*)(Zc + (size_t)r * 3072 + (c0 - 1024)) = pack8(v);
        else *(v4u*)(Zg + (size_t)r * 2048 + (c0 - 4096)) = pack8(v); } };
struct EpiGateA { float* TMP; const bf16* Zg;
    __device__ __forceinline__ void row8(int r, int c0, const float (&v)[8]) const {
        float g[8]; unpack8(*(const v4u*)(Zg + (size_t)r * 2048 + c0), g);
        f32x4 o0, o1; o0.x = sigmoidf_(g[0]) * v[0]; o0.y = sigmoidf_(g[1]) * v[1]; o0.z = sigmoidf_(g[2]) * v[2]; o0.w = sigmoidf_(g[3]) * v[3];
        o1.x = sigmoidf_(g[4]) * v[4]; o1.y = sigmoidf_(g[5]) * v[5]; o1.z = sigmoidf_(g[6]) * v[6]; o1.w = sigmoidf_(g[7]) * v[7];
        *(f32x4*)(TMP + (size_t)r * D + c0) = o0; *(f32x4*)(TMP + (size_t)r * D + c0 + 4) = o1; } };
struct EpiGateB { const float* TMP; const bf16* Zg; bf16* MERGED;
    __device__ __forceinline__ void row8(int r, int c0, const float (&v)[8]) const {
        float g[8]; unpack8(*(const v4u*)(Zg + (size_t)r * 2048 + 1024 + c0), g);
        const f32x4 t0 = *(const f32x4*)(TMP + (size_t)r * D + c0), t1 = *(const f32x4*)(TMP + (size_t)r * D + c0 + 4);
        float o[8]; o[0] = t0.x + sigmoidf_(g[0]) * v[0]; o[1] = t0.y + sigmoidf_(g[1]) * v[1]; o[2] = t0.z + sigmoidf_(g[2]) * v[2]; o[3] = t0.w + sigmoidf_(g[3]) * v[3];
        o[4] = t1.x + sigmoidf_(g[4]) * v[4]; o[5] = t1.y + sigmoidf_(g[5]) * v[5]; o[6] = t1.z + sigmoidf_(g[6]) * v[6]; o[7] = t1.w + sigmoidf_(g[7]) * v[7];
        *(v4u*)(MERGED + (size_t)r * D + c0) = pack8(o); } };
struct EpiResid { const float* X; float* Y;
    __device__ __forceinline__ void row8(int r, int c0, const float (&v)[8]) const {
        const f32x4 x0 = *(const f32x4*)(X + (size_t)r * D + c0), x1 = *(const f32x4*)(X + (size_t)r * D + c0 + 4);
        f32x4 o0, o1; o0.x = ALPHA * x0.x + v[0]; o0.y = ALPHA * x0.y + v[1]; o0.z = ALPHA * x0.z + v[2]; o0.w = ALPHA * x0.w + v[3];
        o1.x = ALPHA * x1.x + v[4]; o1.y = ALPHA * x1.y + v[5]; o1.z = ALPHA * x1.z + v[6]; o1.w = ALPHA * x1.w + v[7];
        *(f32x4*)(Y + (size_t)r * D + c0) = o0; *(f32x4*)(Y + (size_t)r * D + c0 + 4) = o1; } };
struct EpiFinal { const float* X2; const bf16* PP; float* OUT;
    __device__ __forceinline__ void row8(int r, int c0, const float (&v)[8]) const {
        float p[8]; unpack8(*(const v4u*)(PP + (size_t)r * D + c0), p);
        const f32x4 x0 = *(const f32x4*)(X2 + (size_t)r * D + c0), x1 = *(const f32x4*)(X2 + (size_t)r * D + c0 + 4);
        f32x4 o0, o1; o0.x = x0.x + sigmoidf_(v[0]) * p[0]; o0.y = x0.y + sigmoidf_(v[1]) * p[1]; o0.z = x0.z + sigmoidf_(v[2]) * p[2]; o0.w = x0.w + sigmoidf_(v[3]) * p[3];
        o1.x = x1.x + sigmoidf_(v[4]) * p[4]; o1.y = x1.y + sigmoidf_(v[5]) * p[5]; o1.z = x1.z + sigmoidf_(v[6]) * p[6]; o1.w = x1.w + sigmoidf_(v[7]) * p[7];
        *(f32x4*)(OUT + (size_t)r * D + c0) = o0; *(f32x4*)(OUT + (size_t)r * D + c0 + 4) = o1; } };


template <class Fn>
__device__ __forceinline__ void run_gemm(const Frame& F, const bf16* A, const bf16* Bt, int M, int N, int K, const Fn& fn) {
    pg8::Gemm g{A, Bt, M, N, K}; pg8::StaticOrder S; S.init(M, N, F.G, (int)blockIdx.x);
    pg8::EpiRow8<Fn> E{fn};
    pg8::gemm_phase<pg8::EpiRow8<Fn>, pg8::StaticOrder, true, true>(F.lds, g, S, E);
}

__device__ __forceinline__ void ln_row_store(f32x4 (&v)[4], const float* g, const float* b, float* orow, bf16* obrow, int lane) {
    float s = 0.f;
#pragma unroll
    for (int j = 0; j < 4; ++j) s += (v[j].x + v[j].y) + (v[j].z + v[j].w);
    const float mean = wave_sum(s) * (1.f / D); float s2 = 0.f;
#pragma unroll
    for (int j = 0; j < 4; ++j) { v[j] = v[j] - mean; s2 += (v[j].x * v[j].x + v[j].y * v[j].y) + (v[j].z * v[j].z + v[j].w * v[j].w); }
    const float rstd = 1.f / sqrtf(wave_sum(s2) * (1.f / D) + LN_EPS);
#pragma unroll
    for (int j = 0; j < 4; ++j) {
        const f32x4 gg = *(const f32x4*)(g + 4 * lane + 256 * j), bb = *(const f32x4*)(b + 4 * lane + 256 * j);
        const f32x4 o = v[j] * rstd * gg + bb;
        *(f32x4*)(orow + 4 * lane + 256 * j) = o;
        unsigned long long w = (unsigned long long)pk2(o.x, o.y) | ((unsigned long long)pk2(o.z, o.w) << 32);
        *(unsigned long long*)(obrow + 4 * lane + 256 * j) = w;
    }
}
__device__ __forceinline__ float gelu_erf(float x) { return 0.5f * x * (1.0f + erff(x * 0.70710678118654752f)); }

__global__ void __launch_bounds__(NWAVES * 64, 2) skel_fwd(Args args) {
    extern __shared__ __attribute__((aligned(16))) unsigned char lds[];
    Frame F;
    F.lds = (LAS unsigned char*)lds;
    F.tid = threadIdx.x; F.lane = F.tid & 63; F.wave = __builtin_amdgcn_readfirstlane(F.tid >> 6);
    F.G = gridDim.x; { const int bx = blockIdx.x; F.vcu = (F.G % 8 == 0) ? (bx % 8) * (F.G / 8) + bx / 8 : bx; }
    unsigned char* ws = args.ws;
    volatile LAS unsigned* MISC = (volatile LAS unsigned*)(F.lds + MISC_OFF);
    for (int u = F.tid; u < (LDS_BYTES - LDSCTL_OFF) / 4; u += NWAVES * 64) ((LAS unsigned*)(F.lds + LDSCTL_OFF))[u] = 0u;
    __syncthreads();
    XcdBarrier bar; bar.bar = (unsigned*)(ws + WS_CTL) + CW_BAR; bar.x = 0; bar.st = nullptr;
    if (N_LAUNCHES == 1) bar = xcd_barrier_post((unsigned*)(ws + WS_CTL) + CW_BAR, MISC + 8);
    const int lo = args.ph_lo, hi = args.ph_hi;
#define IN(k) (lo <= (k) && (k) < hi)
#define SEAM(k) do { if (IN(k) && IN((k) + 1)) xcd_barrier(bar); } while (0)

    const float* x = args.in[0]; const float* p = args.in[1]; const float* w_in = args.in[2]; const float* lb_param = args.in[3];
    const float* hg_norm_g = args.in[4]; const float* conv_w = args.in[5]; const float* conv_b = args.in[6];
    const float* w_a = args.in[7]; const float* w_b = args.in[8]; const float* w_out = args.in[9];
    const float* ln1_g = args.in[10]; const float* ln1_b = args.in[11]; const float* pk_wq = args.in[12]; const float* pk_sk = args.in[13];
    const float* pk_u = args.in[14]; const float* pk_v = args.in[15]; const float* ln2_g = args.in[16]; const float* ln2_b = args.in[17];
    const float* w_pg = args.in[18]; const float* w_pp = args.in[19];
    float* out = args.out;
    bf16* WinT = (bf16*)(ws + WS_WIN); bf16* WaT = (bf16*)(ws + WS_WA); bf16* WbT = (bf16*)(ws + WS_WB); bf16* WoT = (bf16*)(ws + WS_WO);
    bf16* WpgT = (bf16*)(ws + WS_WPG); bf16* WqT = (bf16*)(ws + WS_WQ); bf16* SKB = (bf16*)(ws + WS_SK); bf16* WppT = (bf16*)(ws + WS_WPP);
    bf16* XB = (bf16*)(ws + WS_XB); bf16* PB = (bf16*)(ws + WS_PB);
    bf16* Zhg = (bf16*)(ws + WS_BIG); bf16* Zc = (bf16*)(ws + WS_ZC); bf16* Zg = (bf16*)(ws + WS_ZG);
    unsigned char* UF8 = (unsigned char*)out; unsigned char* VF8 = (unsigned char*)out + (size_t)16384 * D;
    bf16* ST = (bf16*)out;
    bf16* VT = (bf16*)(ws + WS_VT); bf16* KET = (bf16*)(ws + WS_KET); float* DEC = (float*)(ws + WS_DEC); bf16* ON = (bf16*)(ws + WS_OA);
    bf16* OA = (bf16*)(ws + WS_OA); bf16* YC = (bf16*)(ws + WS_YC);
    float* TMP = (float*)(ws + WS_ZC);
    bf16* MERGED = (bf16*)(ws + WS_OA);
    float* Y = (float*)(ws + WS_Y); float* X1 = (float*)(ws + WS_X1); bf16* X1B = (bf16*)(ws + WS_X1B);
    bf16* QP = (bf16*)(ws + WS_QP); bf16* PP = (bf16*)(ws + WS_OA);
    int* IDS = (int*)(ws + WS_IDS); float* GW = (float*)(ws + WS_GW);
    bf16* X2B = (bf16*)(ws + WS_X2B);

    const int gtid = F.vcu * (NWAVES * 64) + F.tid, NT = F.G * NWAVES * 64;
    const int gw = F.vcu * NWAVES + F.wave, NGW = F.G * NWAVES;

    if (IN(0)) {
        LAS float* scr = (LAS float*)(F.lds + F.wave * 16384);
        constexpr int I_IN = (D / 64) * (PROJ_W / 32), I_SQ = (D / 64) * (D / 32), I_Q = (D / 64) * (2048 / 32), I_PP = (PLE / 64) * (D / 32);
        constexpr int NITEMS = I_IN + 4 * I_SQ + I_Q + I_PP;
        for (int it = gw; it < NITEMS; it += NGW) {
            int r = it;
            if (r < I_IN) { p0_transpose_item(w_in, D, PROJ_W, WinT, scr, r, F.lane); continue; } r -= I_IN;
            if (r < I_SQ) { p0_transpose_item(w_a, D, D, WaT, scr, r, F.lane); continue; } r -= I_SQ;
            if (r < I_SQ) { p0_transpose_item(w_b, D, D, WbT, scr, r, F.lane); continue; } r -= I_SQ;
            if (r < I_SQ) { p0_transpose_item(w_out, D, D, WoT, scr, r, F.lane); continue; } r -= I_SQ;
            if (r < I_SQ) { p0_transpose_item(w_pg, D, D, WpgT, scr, r, F.lane); continue; } r -= I_SQ;
            if (r < I_Q) { p0_transpose_item(pk_wq, D, 2048, WqT, scr, r, F.lane); continue; } r -= I_Q;
            p0_transpose_item(w_pp, PLE, D, WppT, scr, r, F.lane);
        }
        convert_rows(x, XB, (size_t)T * D, gtid, NT);
        convert_rows(p, PB, (size_t)T * PLE, gtid, NT);
        convert_rows(pk_sk, SKB, (size_t)PKH * 2 * NKEYS * 128, gtid, NT);
    }
    SEAM(0);
    if (IN(1)) { EpiStore E{Zhg, 3072}; run_gemm(F, XB, WinT, T, 3072, D, E); }
    SEAM(1);
    if (IN(2)) {
        LAS float* tot = (LAS float*)F.lds;
        for (int unit = F.vcu; unit < 2048; unit += F.G) {
            const int n = unit >> 3, h = unit & 7, row0 = n * 64;
            const int c = F.tid & 127, sgm = F.tid >> 7, ch = h * 128 + c;
            const float lb = 1.0f / (1.0f + expf(lb_param[1024 + ch] - lb_param[ch]));
            float lf[16], kk[16];
            float run = 0.f;
#pragma unroll
            for (int i = 0; i < 16; ++i) { const size_t tok = (size_t)row0 + sgm * 16 + i;
                const float fz = bf2f(Zhg[tok * 3072 + 1024 + ch]); const float sg = 1.0f / (1.0f + expf(-fz));
                const float f = lb + (1.0f - lb) * sg; kk[i] = (1.0f - lb) * (1.0f - sg); run += logf(f); lf[i] = run; }
            tot[sgm * 128 + c] = run;
            __syncthreads();
            float off = 0.f, total = 0.f;
#pragma unroll
            for (int s2 = 0; s2 < 4; ++s2) { const float tv = tot[s2 * 128 + c]; total += tv; if (s2 < sgm) off += tv; }
            __syncthreads();
            float kev[16], vv[16];
#pragma unroll
            for (int i = 0; i < 16; ++i) { const size_t tok = (size_t)row0 + sgm * 16 + i; const float bc = lf[i] + off;
                const float q = bf2f(Zhg[tok * 3072 + ch]) * 0.08838834764831845f;
                const float qe = q * expf(bc), ke = kk[i] * expf(-bc);
                vv[i] = bf2f(Zhg[tok * 3072 + 2048 + ch]);
                Zhg[tok * 3072 + ch] = (bf16)f2bf(qe); Zhg[tok * 3072 + 1024 + ch] = (bf16)f2bf(ke); kev[i] = ke; }
            { float t0[8], t1[8];
#pragma unroll
              for (int i = 0; i < 8; ++i) { t0[i] = kev[i]; t1[i] = kev[8 + i]; }
              bf16* dst = KET + ((size_t)unit * 128 + c) * 64 + sgm * 16; *(v4u*)dst = pack8(t0); *(v4u*)(dst + 8) = pack8(t1);
#pragma unroll
              for (int i = 0; i < 8; ++i) { t0[i] = vv[i]; t1[i] = vv[8 + i]; }
              dst = VT + ((size_t)unit * 128 + c) * 64 + sgm * 16; *(v4u*)dst = pack8(t0); *(v4u*)(dst + 8) = pack8(t1); }
            if (sgm == 0) DEC[(size_t)n * 1024 + ch] = expf(total);
        }
    }
    SEAM(2);
    if (IN(3)) {
        const int q4 = F.lane >> 4, l15 = F.lane & 15;
        for (int unit = gw; unit < 2048; unit += NGW) {
            const int n = unit >> 3, h = unit & 7;
            const bf16* ket = KET + (size_t)unit * 128 * 64; const bf16* vt = VT + (size_t)unit * 128 * 64;
            bf16x8 a[8][2];
#pragma unroll
            for (int t = 0; t < 8; ++t)
#pragma unroll
                for (int s2 = 0; s2 < 2; ++s2) a[t][s2] = *(const bf16x8*)(ket + (16 * t + l15) * 64 + 32 * s2 + 8 * q4);
            f32x4 dc[8];
#pragma unroll
            for (int t = 0; t < 8; ++t) dc[t] = *(const f32x4*)(DEC + (size_t)n * 1024 + h * 128 + 16 * t + 4 * q4);
            for (int qd = 0; qd < 4; ++qd) {
                bf16x8 b[2][2];
#pragma unroll
                for (int cc = 0; cc < 2; ++cc)
#pragma unroll
                    for (int s2 = 0; s2 < 2; ++s2) b[cc][s2] = *(const bf16x8*)(vt + (32 * qd + 16 * cc + l15) * 64 + 32 * s2 + 8 * q4);
#pragma unroll
                for (int t = 0; t < 8; ++t)
#pragma unroll
                    for (int cc = 0; cc < 2; ++cc) {
                        f32x4 acc = (f32x4){0.f, 0.f, 0.f, 0.f};
                        acc = __builtin_amdgcn_mfma_f32_16x16x32_bf16(a[t][0], b[cc][0], acc, 0, 0, 0);
                        acc = __builtin_amdgcn_mfma_f32_16x16x32_bf16(a[t][1], b[cc][1], acc, 0, 0, 0);
                        acc = acc * dc[t];
                        const int dv = 32 * qd + 16 * cc + l15;
                        unsigned long long w = (unsigned long long)pk2(acc[0], acc[1]) | ((unsigned long long)pk2(acc[2], acc[3]) << 32);
                        *(unsigned long long*)(ST + ((size_t)unit * 128 + dv) * 128 + 16 * t + 4 * q4) = w;
                    }
            }
        }
    }
    SEAM(3);
    if (IN(4)) {
        for (int i = gtid; i < 65536; i += NT) {
            const int dk4 = i & 31, dv = (i >> 5) & 127, h = (i >> 12) & 7, b = i >> 15;
            f32x4 st = (f32x4){0.f, 0.f, 0.f, 0.f};
#pragma unroll 8
            for (int cn = 0; cn < 128; ++cn) {
                const int n = b * 128 + cn; const size_t unit = (size_t)n * 8 + h;
                unsigned long long* ptr = (unsigned long long*)(ST + (unit * 128 + dv) * 128 + dk4 * 4);
                const unsigned long long d = *ptr;
                const f32x4 dc = *(const f32x4*)(DEC + (size_t)n * 1024 + h * 128 + dk4 * 4);
                *ptr = (unsigned long long)pk2(st[0], st[1]) | ((unsigned long long)pk2(st[2], st[3]) << 32);
                const f32x4 dd = (f32x4){bflo((unsigned)d), bfhi((unsigned)d), bflo((unsigned)(d >> 32)), bfhi((unsigned)(d >> 32))};
                st = dc * st + dd;
            }
        }
    }
    SEAM(4);
    if (IN(5)) {
        const int q4 = F.lane >> 4, l15 = F.lane & 15;
        LAS bf16* Pl = (LAS bf16*)(F.lds + F.wave * 8192);
        for (int unit = gw; unit < 2048; unit += NGW) {
            const int n = unit >> 3, h = unit & 7, row0 = n * 64;
            const bf16* st = ST + (size_t)unit * 128 * 128; const bf16* vt = VT + (size_t)unit * 128 * 64;
            for (int half = 0; half < 2; ++half) {
                const int i0 = half * 32;
                bf16x8 qf[2][4];
#pragma unroll
                for (int it = 0; it < 2; ++it)
#pragma unroll
                    for (int ks = 0; ks < 4; ++ks) qf[it][ks] = *(const bf16x8*)(Zhg + (size_t)(row0 + i0 + 16 * it + l15) * 3072 + h * 128 + 32 * ks + 8 * q4);
                f32x4 acc[8][2];
#pragma unroll
                for (int dvt = 0; dvt < 8; ++dvt) { acc[dvt][0] = (f32x4){0.f, 0.f, 0.f, 0.f}; acc[dvt][1] = (f32x4){0.f, 0.f, 0.f, 0.f}; }
#pragma unroll
                for (int dvt = 0; dvt < 8; ++dvt)
#pragma unroll
                    for (int ks = 0; ks < 4; ++ks) { const bf16x8 a = *(const bf16x8*)(st + (16 * dvt + l15) * 128 + 32 * ks + 8 * q4);
                        acc[dvt][0] = __builtin_amdgcn_mfma_f32_16x16x32_bf16(a, qf[0][ks], acc[dvt][0], 0, 0, 0);
                        acc[dvt][1] = __builtin_amdgcn_mfma_f32_16x16x32_bf16(a, qf[1][ks], acc[dvt][1], 0, 0, 0); }
                const int njt = 2 * (half + 1);
                for (int jt = 0; jt < njt; ++jt) {
                    f32x4 p0 = (f32x4){0.f, 0.f, 0.f, 0.f}, p1 = (f32x4){0.f, 0.f, 0.f, 0.f};
#pragma unroll
                    for (int ks = 0; ks < 4; ++ks) { const bf16x8 a = *(const bf16x8*)(Zhg + (size_t)(row0 + 16 * jt + l15) * 3072 + 1024 + h * 128 + 32 * ks + 8 * q4);
                        p0 = __builtin_amdgcn_mfma_f32_16x16x32_bf16(a, qf[0][ks], p0, 0, 0, 0);
                        p1 = __builtin_amdgcn_mfma_f32_16x16x32_bf16(a, qf[1][ks], p1, 0, 0, 0); }
                    const int jb = 16 * jt + 4 * q4;
                    { const int ii = i0 + l15;
                      const float m0 = (jb + 0 <= ii) ? p0[0] : 0.f, m1 = (jb + 1 <= ii) ? p0[1] : 0.f, m2 = (jb + 2 <= ii) ? p0[2] : 0.f, m3 = (jb + 3 <= ii) ? p0[3] : 0.f;
                      *(LAS unsigned long long*)(Pl + l15 * 72 + jb) = (unsigned long long)pk2(m0, m1) | ((unsigned long long)pk2(m2, m3) << 32); }
                    { const int ii = i0 + 16 + l15;
                      const float m0 = (jb + 0 <= ii) ? p1[0] : 0.f, m1 = (jb + 1 <= ii) ? p1[1] : 0.f, m2 = (jb + 2 <= ii) ? p1[2] : 0.f, m3 = (jb + 3 <= ii) ? p1[3] : 0.f;
                      *(LAS unsigned long long*)(Pl + (16 + l15) * 72 + jb) = (unsigned long long)pk2(m0, m1) | ((unsigned long long)pk2(m2, m3) << 32); }
                }
                LDS_WAIT(); asm volatile("" ::: "memory");
                const int nks = half + 1;
                for (int kj = 0; kj < nks; ++kj) {
                    const bf16x8 b0 = *(const LAS bf16x8*)(Pl + l15 * 72 + 32 * kj + 8 * q4), b1 = *(const LAS bf16x8*)(Pl + (16 + l15) * 72 + 32 * kj + 8 * q4);
#pragma unroll
                    for (int dvt = 0; dvt < 8; ++dvt) { const bf16x8 a = *(const bf16x8*)(vt + (16 * dvt + l15) * 64 + 32 * kj + 8 * q4);
                        acc[dvt][0] = __builtin_amdgcn_mfma_f32_16x16x32_bf16(a, b0, acc[dvt][0], 0, 0, 0);
                        acc[dvt][1] = __builtin_amdgcn_mfma_f32_16x16x32_bf16(a, b1, acc[dvt][1], 0, 0, 0); }
                }
#pragma unroll
                for (int it = 0; it < 2; ++it) {
                    float ss = 0.f;
#pragma unroll
                    for (int dvt = 0; dvt < 8; ++dvt) { const f32x4 v = acc[dvt][it]; ss += (v[0] * v[0] + v[1] * v[1]) + (v[2] * v[2] + v[3] * v[3]); }
                    ss += __shfl_xor(ss, 16); ss += __shfl_xor(ss, 32);
                    const float rinv = 1.0f / sqrtf(ss * (1.0f / 128.0f) + RMS_EPS);
                    const size_t tok = (size_t)row0 + i0 + 16 * it + l15;
#pragma unroll
                    for (int dvt = 0; dvt < 8; ++dvt) { const f32x4 g4 = *(const f32x4*)(hg_norm_g + h * 128 + 16 * dvt + 4 * q4); const f32x4 o = acc[dvt][it] * rinv * g4;
                        *(unsigned long long*)(ON + tok * D + h * 128 + 16 * dvt + 4 * q4) = (unsigned long long)pk2(o[0], o[1]) | ((unsigned long long)pk2(o[2], o[3]) << 32); }
                }
                LDS_WAIT(); asm volatile("" ::: "memory");
            }
        }
    }
    SEAM(5);
    if (IN(6)) { EpiZ2 E{ON, Zc, Zg}; run_gemm(F, XB, WinT + (size_t)3072 * D, T, 6144, D, E); }
    SEAM(6);
    if (IN(7)) {
        for (int i = gtid; i < T * (D / 8); i += NT) {
            const int row = i / (D / 8), c0 = (i % (D / 8)) * 8, t = row % SEQ;
            float cb[8], u0[8], u1[8], u2[8], a[8], b[8];
            unpack8(*(const v4u*)(Zc + (size_t)row * 3072 + c0), cb);
            unpack8(*(const v4u*)(Zc + (size_t)row * 3072 + 1024 + c0), a); unpack8(*(const v4u*)(Zc + (size_t)row * 3072 + 2048 + c0), b);
#pragma unroll
            for (int j = 0; j < 8; ++j) u2[j] = a[j] * b[j];
            if (t >= 1) { unpack8(*(const v4u*)(Zc + (size_t)(row - 1) * 3072 + 1024 + c0), a); unpack8(*(const v4u*)(Zc + (size_t)(row - 1) * 3072 + 2048 + c0), b);
#pragma unroll
                for (int j = 0; j < 8; ++j) u1[j] = a[j] * b[j]; }
            else {
#pragma unroll
                for (int j = 0; j < 8; ++j) u1[j] = 0.f; }
            if (t >= 2) { unpack8(*(const v4u*)(Zc + (size_t)(row - 2) * 3072 + 1024 + c0), a); unpack8(*(const v4u*)(Zc + (size_t)(row - 2) * 3072 + 2048 + c0), b);
#pragma unroll
                for (int j = 0; j < 8; ++j) u0[j] = a[j] * b[j]; }
            else {
#pragma unroll
                for (int j = 0; j < 8; ++j) u0[j] = 0.f; }
            float y[8];
#pragma unroll
            for (int j = 0; j < 8; ++j) { const int c = c0 + j; y[j] = cb[j] * (conv_b[c] + conv_w[c] * u0[j] + conv_w[1024 + c] * u1[j] + conv_w[2048 + c] * u2[j]); }
            *(v4u*)(YC + (size_t)row * D + c0) = pack8(y);
        }
        convert_fp8(pk_u, UF8, (size_t)16384 * D, 32.0f, gtid, NT);
        convert_fp8(pk_v, VF8, (size_t)16384 * D, 1.0f, gtid, NT);
    }
    SEAM(7);
    if (IN(8)) { EpiGateA E{TMP, Zg}; run_gemm(F, OA, WaT, T, D, D, E); }
    SEAM(8);
    if (IN(9)) { EpiGateB E{TMP, Zg, MERGED}; run_gemm(F, YC, WbT, T, D, D, E); }
    SEAM(9);
    if (IN(10)) { EpiResid E{x, Y}; run_gemm(F, MERGED, WoT, T, D, D, E); }
    SEAM(10);
    if (IN(11)) {
        for (int row = gw; row < T; row += NGW) {
            f32x4 v[4];
#pragma unroll
            for (int j = 0; j < 4; ++j) v[j] = *(const f32x4*)(Y + (size_t)row * D + 4 * F.lane + 256 * j);
            ln_row_store(v, ln1_g, ln1_b, X1 + (size_t)row * D, X1B + (size_t)row * D, F.lane);
        }
    }
    SEAM(11);
    if (IN(12)) {
        { EpiStore E{QP, 2048}; run_gemm(F, X1B, WqT, T, 2048, D, E); }
        { EpiStore E{PP, D}; run_gemm(F, PB, WppT, T, D, PLE, E); }
    }
    SEAM(12);
    if (IN(13)) {
        const int lane = F.lane, r31 = lane & 31, hh = lane >> 5;
        LAS unsigned* ib = (LAS unsigned*)(F.lds + F.wave * 4096) + lane * 8;
        const float NEGV = -3.0e38f;
#define TK_INS(L, xx) do { const float x_ = (xx); _Pragma("unroll") for (int i_ = 15; i_ >= 1; --i_) L[i_] = __builtin_amdgcn_fmed3f(L[i_ - 1], L[i_], x_); L[0] = fmaxf(L[0], x_); } while (0)
        for (int task = gw; task < (T / 32) * PKH; task += NGW) {
            const int tg = task >> 3, h = task & 7; const size_t t = (size_t)tg * 32 + r31;
            float L1[16], L2[16];
#pragma unroll
            for (int p2 = 0; p2 < 2; ++p2) {
                float L[16];
#pragma unroll
                for (int i = 0; i < 16; ++i) L[i] = NEGV;
                bf16x8 bq[8];
#pragma unroll
                for (int ks = 0; ks < 8; ++ks) bq[ks] = *(const bf16x8*)(QP + t * 2048 + h * 256 + p2 * 128 + 16 * ks + 8 * hh);
#pragma unroll
                for (int kt = 0; kt < 4; ++kt) {
                    f32x16 acc;
#pragma unroll
                    for (int i = 0; i < 16; ++i) acc[i] = 0.f;
                    const bf16* krow = SKB + ((size_t)((h * 2 + p2) * 128 + 32 * kt + r31)) * 128 + 8 * hh;
#pragma unroll
                    for (int ks = 0; ks < 8; ++ks) { const bf16x8 a = *(const bf16x8*)(krow + 16 * ks); acc = __builtin_amdgcn_mfma_f32_32x32x16_bf16(a, bq[ks], acc, 0, 0, 0); }
#pragma unroll
                    for (int rg = 0; rg < 16; ++rg) { const float xv = acc[rg]; const int idxc = 32 * kt + (rg & 3) + 8 * (rg >> 2);
                        const float xp = __int_as_float((__float_as_int(xv) & ~0x7F) | idxc); TK_INS(L, xp); }
                }
                float P[16];
#pragma unroll
                for (int i = 0; i < 16; ++i) { L[i] = __int_as_float(__float_as_int(L[i]) | (4 * hh)); P[i] = __shfl_xor(L[i], 32); }
#pragma unroll
                for (int i = 0; i < 16; ++i) TK_INS(L, P[i]);
#pragma unroll
                for (int i = 0; i < 16; ++i) { if (p2 == 0) L1[i] = L[i]; else L2[i] = L[i]; }
            }
            unsigned ix1[16], ix2[16];
#pragma unroll
            for (int i = 0; i < 16; ++i) { ix1[i] = (unsigned)__float_as_int(L1[i]) & 0x7Fu; ix2[i] = (unsigned)__float_as_int(L2[i]) & 0x7Fu;
                L1[i] = __int_as_float(__float_as_int(L1[i]) & ~0x7F); L2[i] = __int_as_float(__float_as_int(L2[i]) & ~0x7F); }
#pragma unroll
            for (int i = 0; i < 4; ++i) { ib[i] = ix1[4 * i] | (ix1[4 * i + 1] << 8) | (ix1[4 * i + 2] << 16) | (ix1[4 * i + 3] << 24);
                                          ib[4 + i] = ix2[4 * i] | (ix2[4 * i + 1] << 8) | (ix2[4 * i + 2] << 16) | (ix2[4 * i + 3] << 24); }
            float W[16];
#pragma unroll
            for (int i = 0; i < 16; ++i) W[i] = NEGV;
#pragma unroll
            for (int a = 0; a < 16; ++a)
#pragma unroll
                for (int b = 0; b < 16; ++b)
                    if ((a + 1) * (b + 1) <= 16) { const float c = L1[a] + L2[b]; const float cp = __int_as_float((__float_as_int(c) & ~0xFF) | (a * 16 + b)); TK_INS(W, cp); }
            LDS_WAIT(); asm volatile("" ::: "memory");
            const LAS unsigned char* ibb = (const LAS unsigned char*)ib;
            int eid[16]; float ev[16];
#pragma unroll
            for (int k = 0; k < 16; ++k) { const int bits = __float_as_int(W[k]); const int a = (bits >> 4) & 15, b = bits & 15;
                eid[k] = (int)ibb[a] * 128 + (int)ibb[16 + b]; ev[k] = __int_as_float(bits & ~0xFF); }
            float sum = 0.f; const float mx = ev[0];
#pragma unroll
            for (int k = 0; k < 16; ++k) { ev[k] = expf(ev[k] - mx); sum += ev[k]; }
            const float inv = 1.0f / sum;
            if (hh == 0) {
#pragma unroll
                for (int k4 = 0; k4 < 4; ++k4) {
                    *(v4u*)(IDS + t * 128 + h * 16 + 4 * k4) = (v4u){(unsigned)eid[4 * k4], (unsigned)eid[4 * k4 + 1], (unsigned)eid[4 * k4 + 2], (unsigned)eid[4 * k4 + 3]};
                    *(f32x4*)(GW + t * 128 + h * 16 + 4 * k4) = (f32x4){ev[4 * k4] * inv, ev[4 * k4 + 1] * inv, ev[4 * k4 + 2] * inv, ev[4 * k4 + 3] * inv}; }
            }
            LDS_WAIT(); asm volatile("" ::: "memory");
        }
#undef TK_INS
    }
    SEAM(13);
    if (IN(14)) {
        const int lane = F.lane, q4 = lane >> 4, l15 = lane & 15;
        LAS unsigned char* xs8 = F.lds + F.wave * 4096;
        for (int t = gw; t < T; t += NGW) {
            { float xa[8], xb[8]; unpack8(*(const v4u*)(X1B + (size_t)t * D + lane * 16), xa); unpack8(*(const v4u*)(X1B + (size_t)t * D + lane * 16 + 8), xb);
              v4u o; int w = 0;
              w = __builtin_amdgcn_cvt_pk_fp8_f32(xa[0], xa[1], w, false); w = __builtin_amdgcn_cvt_pk_fp8_f32(xa[2], xa[3], w, true); o.x = (unsigned)w;
              w = __builtin_amdgcn_cvt_pk_fp8_f32(xa[4], xa[5], w, false); w = __builtin_amdgcn_cvt_pk_fp8_f32(xa[6], xa[7], w, true); o.y = (unsigned)w;
              w = __builtin_amdgcn_cvt_pk_fp8_f32(xb[0], xb[1], w, false); w = __builtin_amdgcn_cvt_pk_fp8_f32(xb[2], xb[3], w, true); o.z = (unsigned)w;
              w = __builtin_amdgcn_cvt_pk_fp8_f32(xb[4], xb[5], w, false); w = __builtin_amdgcn_cvt_pk_fp8_f32(xb[6], xb[7], w, true); o.w = (unsigned)w;
              *(LAS v4u*)(xs8 + lane * 16) = o; }
            const int id0 = IDS[(size_t)t * 128 + lane], id1 = IDS[(size_t)t * 128 + 64 + lane];
            const unsigned char* urow[8];
#pragma unroll
            for (int bb = 0; bb < 8; ++bb) { const int e = __shfl(bb < 4 ? id0 : id1, (bb & 3) * 16 + l15); urow[bb] = UF8 + (size_t)e * D + 16 * q4; }
            f32x4 hacc[8];
#pragma unroll
            for (int bb = 0; bb < 8; ++bb) hacc[bb] = (f32x4){0.f, 0.f, 0.f, 0.f};
            LDS_WAIT(); asm volatile("" ::: "memory");
            for (int sp = 0; sp < 16; ++sp) {
                const v4u bv = *(const LAS v4u*)(xs8 + 64 * sp + 16 * q4);
                const long b0 = (long)(((unsigned long long)bv.y << 32) | bv.x), b1 = (long)(((unsigned long long)bv.w << 32) | bv.z);
                v4u av[8];
#pragma unroll
                for (int bb = 0; bb < 8; ++bb) av[bb] = *(const v4u*)(urow[bb] + 64 * sp);
#pragma unroll
                for (int bb = 0; bb < 8; ++bb) { const long a0 = (long)(((unsigned long long)av[bb].y << 32) | av[bb].x), a1 = (long)(((unsigned long long)av[bb].w << 32) | av[bb].z);
                    hacc[bb] = __builtin_amdgcn_mfma_f32_16x16x32_fp8_fp8(a0, b0, hacc[bb], 0, 0, 0);
                    hacc[bb] = __builtin_amdgcn_mfma_f32_16x16x32_fp8_fp8(a1, b1, hacc[bb], 0, 0, 0); }
            }
#pragma unroll
            for (int bb = 0; bb < 8; ++bb) { const f32x4 g4 = *(const f32x4*)(GW + (size_t)t * 128 + bb * 16 + 4 * q4);
#pragma unroll
                for (int r = 0; r < 4; ++r) { const float dv = hacc[bb][r] * 0.03125f; hacc[bb][r] = g4[r] * gelu_erf(dv); } }
            float o[16];
#pragma unroll
            for (int j = 0; j < 16; ++j) o[j] = 0.f;
#pragma unroll
            for (int bb = 0; bb < 8; ++bb) {
#pragma unroll
                for (int qq = 0; qq < 4; ++qq)
#pragma unroll
                    for (int r = 0; r < 4; ++r) {
                        const int i = bb * 16 + qq * 4 + r;
                        const float hv = hacc[bb][r];
                        const float w = __builtin_bit_cast(float, __builtin_amdgcn_readlane(__builtin_bit_cast(int, hv), qq * 16));
                        const int e = __builtin_amdgcn_readlane(i < 64 ? id0 : id1, i & 63);
                        const v4u vv = *(const v4u*)(VF8 + (size_t)e * D + lane * 16);
#pragma unroll
                        for (int j = 0; j < 4; ++j) { const int wd = (int)vv[j]; const f32x2 lo = __builtin_amdgcn_cvt_pk_f32_fp8(wd, false), hi = __builtin_amdgcn_cvt_pk_f32_fp8(wd, true);
                            o[4 * j] += w * lo.x; o[4 * j + 1] += w * lo.y; o[4 * j + 2] += w * hi.x; o[4 * j + 3] += w * hi.y; }
                    }
            }
            float* xrow = X1 + (size_t)t * D + lane * 16;
            float sm = 0.f;
#pragma unroll
            for (int j = 0; j < 4; ++j) { const f32x4 xv = *(const f32x4*)(xrow + 4 * j);
                o[4 * j] += ALPHA * xv.x; o[4 * j + 1] += ALPHA * xv.y; o[4 * j + 2] += ALPHA * xv.z; o[4 * j + 3] += ALPHA * xv.w; }
#pragma unroll
            for (int j = 0; j < 16; ++j) sm += o[j];
            const float mean = wave_sum(sm) * (1.f / D); float s2 = 0.f;
#pragma unroll
            for (int j = 0; j < 16; ++j) { o[j] -= mean; s2 += o[j] * o[j]; }
            const float rstd = 1.f / sqrtf(wave_sum(s2) * (1.f / D) + LN_EPS);
            float res[16];
#pragma unroll
            for (int j = 0; j < 4; ++j) { const f32x4 gg = *(const f32x4*)(ln2_g + lane * 16 + 4 * j), bb4 = *(const f32x4*)(ln2_b + lane * 16 + 4 * j);
                f32x4 r4; r4.x = o[4 * j] * rstd * gg.x + bb4.x; r4.y = o[4 * j + 1] * rstd * gg.y + bb4.y; r4.z = o[4 * j + 2] * rstd * gg.z + bb4.z; r4.w = o[4 * j + 3] * rstd * gg.w + bb4.w;
                *(f32x4*)(xrow + 4 * j) = r4; res[4 * j] = r4.x; res[4 * j + 1] = r4.y; res[4 * j + 2] = r4.z; res[4 * j + 3] = r4.w; }
            { float r0[8], r1[8];
#pragma unroll
              for (int j = 0; j < 8; ++j) { r0[j] = res[j]; r1[j] = res[8 + j]; }
              *(v4u*)(X2B + (size_t)t * D + lane * 16) = pack8(r0); *(v4u*)(X2B + (size_t)t * D + lane * 16 + 8) = pack8(r1); }
            LDS_WAIT(); asm volatile("" ::: "memory");
        }
    }
    SEAM(14);
    if (IN(15)) { EpiFinal E{X1, PP, out}; run_gemm(F, X2B, WpgT, T, D, D, E); }
#undef IN
#undef SEAM
}

extern "C" void kernel_launch(void* const* d_in, const int* in_sizes, int n_in, void* d_out, int out_size, void* d_ws, size_t ws_size, hipStream_t stream) {
    static int grid = 0;
    if (grid == 0) {
        if (n_in != 20 || out_size != T * D || ws_size < WS_END) { fprintf(stderr, "kernel_launch: unexpected shapes (n_in %d out %d ws %zu)\n", n_in, out_size, ws_size); grid = -1; return; }
        int dev = 0, cus = 0;
        if (hipGetDevice(&dev) != hipSuccess || hipDeviceGetAttribute(&cus, hipDeviceAttributeMultiprocessorCount, dev) != hipSuccess) { grid = -1; return; }
        if (hipFuncSetAttribute((const void*)skel_fwd, hipFuncAttributeMaxDynamicSharedMemorySize, LDS_BYTES) != hipSuccess) { fprintf(stderr, "kernel_launch: hipFuncSetAttribute failed\n"); grid = -1; return; }
        (void)hipGetLastError();
        grid = cus;
    }
    if (grid < 0) return;
    if (hipMemsetAsync((char*)d_ws + WS_CTL, 0, CTL_ZERO_BYTES, stream) != hipSuccess) return;
    Args a{};
    for (int i = 0; i < 20; ++i) a.in[i] = (const float*)d_in[i];
    a.out = (float*)d_out; a.ws = (unsigned char*)d_ws;
    if (N_LAUNCHES == 1) {
        a.ph_lo = 0; a.ph_hi = NPHASES; a.li = 0;
        hipLaunchKernelGGL(skel_fwd, dim3(grid), dim3(NWAVES * 64), LDS_BYTES, stream, a);
    } else {
        for (int li = 0; li < NPHASES; ++li) {
            a.ph_lo = li; a.ph_hi = li + 1; a.li = li;
            hipLaunchKernelGGL(skel_fwd, dim3(grid), dim3(NWAVES * 64), LDS_BYTES, stream, a);
        }
    }
}
```

```cpp
#include <hip/hip_runtime.h>
#include <cstdio>
#include <cstdint>
#include <cmath>

#ifndef MK_N_LAUNCHES
#define MK_N_LAUNCHES 1
#endif

constexpr int BATCH = 2, SEQ = 8192, D = 1024, T = BATCH * SEQ;
constexpr int PROJ_W = 9216;
constexpr int NHEAD = 8, DK = 128;
constexpr int PKH = 8, PKD = 256, NKEYS = 128, TOPK = 16;
constexpr int PLE = 256;
constexpr float LN_EPS = 1e-5f, RMS_EPS = 1e-6f;
constexpr float ALPHA = 1.189207115002721f;
constexpr int NWAVES = 8;
constexpr int NPHASES = 18;
constexpr int N_LAUNCHES = MK_N_LAUNCHES;

constexpr size_t MiB = 1u << 20;
constexpr size_t WS_CTL = 0, CTL_ZERO_BYTES = 1 * MiB;
constexpr size_t WS_WIN = 1 * MiB;
constexpr size_t WS_WA = 19 * MiB, WS_WB = 21 * MiB, WS_WO = 23 * MiB, WS_WPG = 25 * MiB;
constexpr size_t WS_WQ = 27 * MiB;
constexpr size_t WS_SK = 31 * MiB;
constexpr size_t WS_WPP = 31 * MiB + 512 * 1024;
constexpr size_t WS_XB = 32 * MiB;
constexpr size_t WS_BIG = 64 * MiB;
constexpr size_t WS_ZC = 64 * MiB;
constexpr size_t WS_ZG = 160 * MiB;
constexpr size_t WS_VT = 160 * MiB;
constexpr size_t WS_KET = 192 * MiB;
constexpr size_t WS_X1 = 128 * MiB;
constexpr size_t WS_X1B = 192 * MiB;
constexpr size_t WS_OA = 224 * MiB;
constexpr size_t WS_PB = 256 * MiB;
constexpr size_t WS_DEC = 264 * MiB;
constexpr size_t WS_END = 265 * MiB;
constexpr size_t WS_YC = WS_XB;
constexpr size_t WS_IDS = WS_XB;
constexpr size_t WS_GW = WS_XB + 8 * MiB;
constexpr size_t WS_Y = WS_BIG;
constexpr size_t WS_QP = WS_BIG;
constexpr size_t WS_WGT = WS_XB + 16 * MiB;
constexpr size_t WS_STATS = WS_XB + 24 * MiB;
constexpr size_t WS_YB = WS_BIG;
constexpr size_t WS_X2B = WS_BIG + 32 * MiB;
constexpr int CW_BAR = 4096;
constexpr int CW_XRANK = 8192;

constexpr int LDS_BYTES = 147456;
constexpr int RING_BYTES = 131072, LDSCTL_OFF = LDS_BYTES - 512, MISC_OFF = LDSCTL_OFF + 320;

#define GAS __attribute__((address_space(1)))
#define LAS __attribute__((address_space(3)))
typedef unsigned short bf16;
typedef unsigned v4u __attribute__((ext_vector_type(4)));
typedef float f32x4 __attribute__((ext_vector_type(4)));
typedef float f32x2 __attribute__((ext_vector_type(2)));
typedef short bf16x8 __attribute__((ext_vector_type(8)));
typedef float f32x16 __attribute__((ext_vector_type(16)));
typedef GAS unsigned gu32;
#define RLX_AGENT __ATOMIC_RELAXED, __HIP_MEMORY_SCOPE_AGENT
#define LDS_WAIT() asm volatile("s_waitcnt lgkmcnt(0)" ::: "memory")

__device__ __forceinline__ unsigned f2bf(float f) { unsigned u = __builtin_bit_cast(unsigned, f); return (u + 0x7fffu + ((u >> 16) & 1u)) >> 16; }
__device__ __forceinline__ unsigned pk2(float lo, float hi) { return f2bf(lo) | (f2bf(hi) << 16); }
__device__ __forceinline__ float bf2f(unsigned short h) { return __builtin_bit_cast(float, (unsigned)h << 16); }
__device__ __forceinline__ float bflo(unsigned w) { return __builtin_bit_cast(float, w << 16); }
__device__ __forceinline__ float bfhi(unsigned w) { return __builtin_bit_cast(float, w & 0xffff0000u); }
__device__ __forceinline__ void unpack8(const v4u w, float (&o)[8]) { o[0] = bflo(w.x); o[1] = bfhi(w.x); o[2] = bflo(w.y); o[3] = bfhi(w.y); o[4] = bflo(w.z); o[5] = bfhi(w.z); o[6] = bflo(w.w); o[7] = bfhi(w.w); }
__device__ __forceinline__ v4u pack8(const float (&v)[8]) { v4u w; w.x = pk2(v[0], v[1]); w.y = pk2(v[2], v[3]); w.z = pk2(v[4], v[5]); w.w = pk2(v[6], v[7]); return w; }
__device__ __forceinline__ float sigmoidf_(float x) { return 1.0f / (1.0f + __expf(-x)); }
__device__ __forceinline__ float wave_sum(float v) {
#pragma unroll
    for (int o = 1; o < 64; o <<= 1) v += __shfl_xor(v, o);
    return v;
}

#define XB_TMO      128
#define XB_XCNT(j)  (256  + 64 * (j))
#define XB_XSUB(j)  (1280 + 64 * (j))
#define XB_XGEN(j)  (2304 + 64 * (j))
#define XB_TOP      3328
#define XB_TOPGEN   3392
#define XCD_BAR_WORDS 3456
#define XB_SPIN_CAP (1u << 26)

__device__ __forceinline__ unsigned xb_ld(unsigned* p)              { return __hip_atomic_load(p, __ATOMIC_RELAXED, __HIP_MEMORY_SCOPE_AGENT); }
__device__ __forceinline__ unsigned xb_add(unsigned* p, unsigned v) { return __hip_atomic_fetch_add(p, v, __ATOMIC_RELAXED, __HIP_MEMORY_SCOPE_AGENT); }
__device__ __forceinline__ unsigned xb_xcc_id() { return (unsigned)__builtin_amdgcn_s_getreg((3 << 11) | 20) & 0xFu; }
#define XB_SPIN(cond, bar) do { unsigned _sp = 0; while (cond) { __builtin_amdgcn_s_sleep(1); \
    if ((++_sp & 255u) == 0u) { if (xb_ld(&(bar)[XB_TMO])) break; if (_sp > XB_SPIN_CAP) { atomicAdd(&(bar)[XB_TMO], 1u); break; } } } } while (0)

struct XcdBarrier { unsigned* bar; unsigned x; volatile LAS unsigned* st; };

__device__ __forceinline__ XcdBarrier xcd_barrier_post(unsigned* bar, volatile LAS unsigned* st) {
    XcdBarrier b; b.bar = bar; b.x = xb_xcc_id(); b.st = st;
    if (threadIdx.x == 0) (void)xb_add(&bar[XB_XCNT(b.x)], 1u);
    return b;
}
__device__ __forceinline__ void xcd_barrier_complete(unsigned* bar, unsigned x, unsigned& nloc, unsigned& nx) {
    const unsigned G = gridDim.x * gridDim.y * gridDim.z;
    unsigned sum, cnt, mine, sp = 0u;
    for (;;) {
        sum = 0u; cnt = 0u; mine = 0u;
#pragma unroll
        for (unsigned j = 0; j < 16; ++j) { const unsigned c = xb_ld(&bar[XB_XCNT(j)]); sum += c; cnt += (c > 0u) ? 1u : 0u; mine = (j == x) ? c : mine; }
        if (sum == G) break;
        __builtin_amdgcn_s_sleep(1);
        if ((++sp & 255u) == 0u) { if (xb_ld(&bar[XB_TMO])) break; if (sp > XB_SPIN_CAP) { atomicAdd(&bar[XB_TMO], 1u); break; } }
    }
    nloc = mine > 0u ? mine : 1u; nx = cnt > 0u ? cnt : 1u;
}
__device__ __forceinline__ void xcd_barrier(const XcdBarrier& b) {
    asm volatile("s_waitcnt vmcnt(0)" ::: "memory");
    __syncthreads();
    if (threadIdx.x == 0) {
        unsigned* bar = b.bar;
        __builtin_amdgcn_s_waitcnt(0);
        unsigned nloc = b.st[0], nx = b.st[1];
        if (nloc == 0u) { xcd_barrier_complete(bar, b.x, nloc, nx); b.st[0] = nloc; b.st[1] = nx; }
        const unsigned old = xb_add(&bar[XB_XSUB(b.x)], 1u);
        const unsigned gen = old / nloc;
        if (old + 1u == (gen + 1u) * nloc) {
            __builtin_amdgcn_fence(__ATOMIC_RELEASE, "agent");
            asm volatile("s_waitcnt vmcnt(0)" ::: "memory");
            const unsigned og = xb_add(&bar[XB_TOP], 1u);
            const unsigned tg = og / nx;
            if (og + 1u == (tg + 1u) * nx) xb_add(&bar[XB_TOPGEN], 1u);
            else XB_SPIN(xb_ld(&bar[XB_TOPGEN]) == tg, bar);
            __builtin_amdgcn_fence(__ATOMIC_ACQUIRE, "agent");
            xb_add(&bar[XB_XGEN(b.x)], 1u);
            asm volatile("s_waitcnt vmcnt(0)" ::: "memory");
        } else {
            XB_SPIN(xb_ld(&bar[XB_XGEN(b.x)]) == gen, bar);
            __builtin_amdgcn_fence(__ATOMIC_ACQUIRE, "agent");
            asm volatile("s_waitcnt vmcnt(0)" ::: "memory");
        }
    }
    __syncthreads();
}

struct Frame {
    LAS unsigned char* lds;
    int tid, lane, wave, vcu, G;
};

struct Args {
    const float* in[20]; float* out; unsigned char* ws; int ph_lo, ph_hi, li, pad;
};

__device__ __forceinline__ void p0_transpose_item(const float* W, int K, int N, bf16* WT, LAS float* scr, int item, int lane) {
    const int nblk = N / 32, kb = item / nblk, nb = item % nblk, k0 = 64 * kb, n0 = 32 * nb;
#pragma unroll 8
    for (int i = 0; i < 32; ++i) { const int kk = 2 * i + (lane >> 5); scr[kk * 33 + (lane & 31)] = W[(size_t)(k0 + kk) * N + n0 + (lane & 31)]; }
    LDS_WAIT(); asm volatile("" ::: "memory");
    const int c = lane & 7;
#pragma unroll
    for (int j = 0; j < 4; ++j) { const int n = (lane >> 3) + 8 * j; const LAS float* s = scr + (8 * c) * 33 + n;
        v4u o; o.x = pk2(s[0 * 33], s[1 * 33]); o.y = pk2(s[2 * 33], s[3 * 33]); o.z = pk2(s[4 * 33], s[5 * 33]); o.w = pk2(s[6 * 33], s[7 * 33]);
        *(v4u*)(WT + (size_t)(n0 + n) * K + k0 + 8 * c) = o; }
    LDS_WAIT(); asm volatile("" ::: "memory");
}
__device__ __forceinline__ void convert_rows(const float* src, bf16* dst, size_t n, int gtid, int nthreads) {
    for (size_t i = (size_t)gtid * 8; i < n; i += (size_t)nthreads * 8) {
        const f32x4 a = *(const f32x4*)(src + i), b = *(const f32x4*)(src + i + 4);
        v4u o; o.x = pk2(a.x, a.y); o.y = pk2(a.z, a.w); o.z = pk2(b.x, b.y); o.w = pk2(b.z, b.w);
        *(v4u*)(dst + i) = o;
    }
}

namespace pg8 {
#define PG8_LAS __attribute__((address_space(3)))
typedef unsigned short bf16_t;
typedef short bf16x8 __attribute__((ext_vector_type(8)));
typedef float f32x4 __attribute__((ext_vector_type(4)));
typedef unsigned u32x4 __attribute__((ext_vector_type(4)));
constexpr int BM = 256, BK = 64, HALF = 128, HTB = HALF * BK * 2  , STAGE_BYTES = 8 * HTB, NXCD = 8, WGM = 8;

__host__ __device__ __forceinline__ int lds_byte(int r, int c) { const int st = (r >> 4) * 2 + (c >> 5), rr = r & 15, cc = c & 31, ob = rr * 64 + cc * 2; return st * 1024 + (ob ^ (((ob >> 9) & 1) << 5)); }
__host__ __device__ __forceinline__ void stage_rc(int b, int& R, int& C) { const int st = b / 1024, sb = b % 1024, swz = sb ^ (((sb >> 9) & 1) << 5); R = (st >> 1) * 16 + swz / 64; C = (st & 1) * 32 + (swz % 64) / 2; }
__host__ __device__ __forceinline__ int perm32(int rho) { const int n = rho >> 4, i = rho & 15; return 8 * (i >> 2) + 4 * n + (i & 3); }

struct Unit { int pm, pn; };
struct Gemm { const bf16_t* A; const bf16_t* Bt; int M, N, K; };

struct StaticOrder {
    int nM, nN, nwg, G, c;
    __host__ __device__ void init(int M, int N, int G_, int c_) { nM = M / BM; nN = N / BM; nwg = nM * nN; G = G_; c = c_; }
    __host__ __device__ bool next(int i, Unit& u) const {
        const long L = (long)i * G + c; if (L >= nwg) return false;
        int wgid = (int)L; { const int q = nwg / NXCD, r = nwg % NXCD, xcd = wgid % NXCD, off = wgid / NXCD; wgid = (xcd < r ? xcd * (q + 1) : r * (q + 1) + (xcd - r) * q) + off; }
        const int nig = WGM * nN, gid = wgid / nig, fm = gid * WGM, gsz = (nM - fm) < WGM ? (nM - fm) : WGM;
        u.pm = fm + ((wgid % nig) % gsz); u.pn = (wgid % nig) / gsz; return true;
    }
    __device__ __forceinline__ void a_ready(const Unit&) const {}
    __device__ __forceinline__ void done(const Unit&) const {}
};

__device__ __forceinline__ unsigned cvt_pk_bf16(float lo, float hi) { unsigned r; asm volatile("v_cvt_pk_bf16_f32 %0, %1, %2" : "=v"(r) : "v"(lo), "v"(hi)); return r; }
typedef float f32x2 __attribute__((ext_vector_type(2)));
template <class Epi, class Sched, bool ALIGN_EPI = false, bool SP2 = false>
__device__ __forceinline__ void gemm_phase(PG8_LAS unsigned char* lds, const Gemm g, const Sched& S, const Epi& E) {
    const int tid = threadIdx.x, wid = __builtin_amdgcn_readfirstlane(tid >> 6), lane = tid & 63, wr = wid >> 2, wc = wid & 3, fr = lane & 15, fq = lane >> 4;
    const int K = g.K, nt = K / BK;
    unsigned voffA[2], voffB[2];
#pragma unroll
    for (int i = 0; i < 2; ++i) { int R, C; stage_rc(tid * 16 + i * 8192, R, C); const int Rb = Epi::PERM ? ((R & ~31) + perm32(R & 31)) : R;
        voffA[i] = (unsigned)(R * K + C) * 2u; voffB[i] = (unsigned)(Rb * K + C) * 2u; }
    const size_t kstep = (size_t)(BK * 2);
    const size_t hstep = (size_t)HALF * K * 2;
    const size_t tstep = 2 * hstep;
    const unsigned ldsw = (unsigned)wid * 1024u;
    const int aoff = lds_byte(wr * 64 + fr, fq * 8), boff = lds_byte(wc * 32 + fr, fq * 8);
#define PG8_SA(b, h) (((b) * 2 + (h)) * HTB)
#define PG8_SB(b, h) ((4 + (b) * 2 + (h)) * HTB)
#define PG8_STAGE(bufoff, gbase, voff) do { _Pragma("unroll") for (int _i = 0; _i < 2; ++_i) \
        __builtin_amdgcn_global_load_lds((const unsigned*)((const char*)(gbase) + (voff)[_i]), (PG8_LAS unsigned*)(lds + (bufoff) + ldsw + _i * 8192), 16, 0, 0); } while (0)
#define PG8_LDA(dst, b, h) do { _Pragma("unroll") for (int m = 0; m < 4; ++m) _Pragma("unroll") for (int k = 0; k < 2; ++k) dst[m][k] = *(const PG8_LAS bf16x8*)(lds + PG8_SA(b, h) + aoff + m * 2048 + k * 1024); } while (0)
#define PG8_LDB(dst, b, h) do { _Pragma("unroll") for (int n = 0; n < 2; ++n) _Pragma("unroll") for (int k = 0; k < 2; ++k) dst[n][k] = *(const PG8_LAS bf16x8*)(lds + PG8_SB(b, h) + boff + n * 2048 + k * 1024); } while (0)
#define PG8_MMA(ai, bj, At, Bt) do { __builtin_amdgcn_s_setprio(1); _Pragma("unroll") for (int m = 0; m < 4; ++m) _Pragma("unroll") for (int n = 0; n < 2; ++n) _Pragma("unroll") for (int k = 0; k < 2; ++k) \
        acc[ai][bj][m][n] = __builtin_amdgcn_mfma_f32_16x16x32_bf16(Bt[n][k], At[m][k], acc[ai][bj][m][n], 0, 0, 0); __builtin_amdgcn_s_setprio(0); } while (0)
#define PG8_WAIT_V(n) asm volatile("s_waitcnt vmcnt(" #n ")" ::: "memory")
#define PG8_WAIT_L(n) asm volatile("s_waitcnt lgkmcnt(" #n ")" ::: "memory")
#define PG8_BAR __builtin_amdgcn_s_barrier()
#define PG8_SCHED __builtin_amdgcn_sched_barrier(0)
    Unit cur, nxt; int ui = 0;
    if (!S.next(0, cur)) return;
    f32x4 acc[2][2][4][2];
#pragma unroll
    for (int a = 0; a < 2; ++a)
#pragma unroll
        for (int b = 0; b < 2; ++b)
#pragma unroll
            for (int m = 0; m < 4; ++m)
#pragma unroll
                for (int n = 0; n < 2; ++n) acc[a][b][m][n] = (f32x4){0.f, 0.f, 0.f, 0.f};
    bf16x8 At[4][2], B0[2][2], B1[2][2];
    const char* cA = (const char*)g.A + (size_t)cur.pm * tstep; const char* cB = (const char*)g.Bt + (size_t)cur.pn * tstep;
    S.a_ready(cur);
    if constexpr (SP2) {
        PG8_STAGE(PG8_SB(0, 0), cB, voffB); PG8_STAGE(PG8_SB(0, 1), cB + hstep, voffB); PG8_STAGE(PG8_SA(0, 0), cA, voffA); PG8_STAGE(PG8_SA(0, 1), cA + hstep, voffA);
        if (wr == 1) PG8_BAR;
        PG8_WAIT_V(2); PG8_BAR;
        PG8_STAGE(PG8_SB(1, 0), cB + kstep, voffB); PG8_STAGE(PG8_SA(1, 0), cA + kstep, voffA); PG8_STAGE(PG8_SB(1, 1), cB + hstep + kstep, voffB);
        PG8_WAIT_V(6); PG8_BAR;
    } else {
        PG8_STAGE(PG8_SB(0, 0), cB, voffB); PG8_STAGE(PG8_SA(0, 0), cA, voffA); PG8_STAGE(PG8_SB(0, 1), cB + hstep, voffB); PG8_STAGE(PG8_SA(0, 1), cA + hstep, voffA);
        if (wr == 1) PG8_BAR;
        PG8_WAIT_V(4); PG8_BAR;
        PG8_STAGE(PG8_SB(1, 0), cB + kstep, voffB); PG8_STAGE(PG8_SA(1, 0), cA + kstep, voffA); PG8_STAGE(PG8_SB(1, 1), cB + hstep + kstep, voffB);
        PG8_WAIT_V(6); PG8_BAR;
    }
    for (;;) {
        const bool has_next = S.next(ui + 1, nxt);
        const char* nA = has_next ? (const char*)g.A + (size_t)nxt.pm * tstep : cA; const char* nB = has_next ? (const char*)g.Bt + (size_t)nxt.pn * tstep : cB;
        for (int t = 0; t < nt; t += 2) {
            const bool last = (t == nt - 2);
            const char* a1 = cA + (size_t)(t + 1) * kstep;
            const char* a2 = last ? nA : cA + (size_t)(t + 2) * kstep; const char* b2 = last ? nB : cB + (size_t)(t + 2) * kstep;
            const char* a3 = a2 + kstep; const char* b3 = b2 + kstep;
            if (last && has_next) S.a_ready(nxt);
            if constexpr (SP2) {
            PG8_LDB(B0, 0, 0); PG8_LDB(B1, 0, 1); PG8_SCHED; PG8_LDA(At, 0, 0); PG8_STAGE(PG8_SA(1, 1), a1 + hstep, voffA);
            PG8_WAIT_V(8); PG8_WAIT_L(0); PG8_BAR; PG8_MMA(0, 0, At, B0); PG8_MMA(0, 1, At, B1); PG8_BAR; PG8_SCHED;
            PG8_LDA(At, 0, 1); PG8_STAGE(PG8_SB(0, 0), b2, voffB); PG8_STAGE(PG8_SB(0, 1), b2 + hstep, voffB); PG8_STAGE(PG8_SA(0, 0), a2, voffA);
            PG8_WAIT_V(8); PG8_WAIT_L(0); PG8_BAR; PG8_MMA(1, 0, At, B0); PG8_MMA(1, 1, At, B1); PG8_BAR; PG8_SCHED;
            PG8_LDB(B0, 1, 0); PG8_LDB(B1, 1, 1); PG8_SCHED; PG8_LDA(At, 1, 0); PG8_STAGE(PG8_SA(0, 1), a2 + hstep, voffA);
            PG8_WAIT_V(8); PG8_WAIT_L(0); PG8_BAR; PG8_MMA(0, 0, At, B0); PG8_MMA(0, 1, At, B1); PG8_BAR; PG8_SCHED;
            PG8_LDA(At, 1, 1); PG8_STAGE(PG8_SB(1, 0), b3, voffB); PG8_STAGE(PG8_SB(1, 1), b3 + hstep, voffB); PG8_STAGE(PG8_SA(1, 0), a3, voffA);
            PG8_WAIT_V(8); PG8_WAIT_L(0); PG8_BAR; PG8_MMA(1, 0, At, B0); PG8_MMA(1, 1, At, B1); PG8_BAR; PG8_SCHED;
            } else {
            PG8_LDB(B0, 0, 0); PG8_SCHED; PG8_LDA(At, 0, 0); PG8_STAGE(PG8_SA(1, 1), a1 + hstep, voffA);
            PG8_WAIT_L(8); PG8_BAR; PG8_WAIT_L(0); PG8_MMA(0, 0, At, B0); PG8_BAR; PG8_SCHED;
            PG8_LDB(B1, 0, 1); PG8_STAGE(PG8_SB(0, 0), b2, voffB);
            PG8_BAR; PG8_WAIT_L(0); PG8_MMA(0, 1, At, B1); PG8_BAR;
            PG8_LDA(At, 0, 1); PG8_STAGE(PG8_SA(0, 0), a2, voffA);
            PG8_BAR; PG8_WAIT_L(0); PG8_MMA(1, 0, At, B0); PG8_BAR; PG8_SCHED;
            PG8_STAGE(PG8_SB(0, 1), b2 + hstep, voffB);
            PG8_WAIT_V(6); PG8_BAR; PG8_MMA(1, 1, At, B1); PG8_BAR;
            PG8_LDB(B0, 1, 0); PG8_SCHED; PG8_LDA(At, 1, 0); PG8_STAGE(PG8_SA(0, 1), a2 + hstep, voffA);
            PG8_WAIT_L(8); PG8_BAR; PG8_WAIT_L(0); PG8_MMA(0, 0, At, B0); PG8_BAR; PG8_SCHED;
            PG8_LDB(B1, 1, 1); PG8_STAGE(PG8_SB(1, 0), b3, voffB);
            PG8_BAR; PG8_WAIT_L(0); PG8_MMA(0, 1, At, B1); PG8_BAR;
            PG8_LDA(At, 1, 1); PG8_STAGE(PG8_SA(1, 0), a3, voffA);
            PG8_BAR; PG8_WAIT_L(0); PG8_MMA(1, 0, At, B0); PG8_BAR; PG8_SCHED;
            PG8_STAGE(PG8_SB(1, 1), b3 + hstep, voffB);
            PG8_WAIT_V(6); PG8_BAR; PG8_MMA(1, 1, At, B1); PG8_BAR;
            }
        }
        if constexpr (ALIGN_EPI) { if (wr == 0) PG8_BAR; }
        if constexpr (!Epi::AFTER_DRAIN) { E(acc, cur, wr, wc, fr, fq); S.done(cur); }
        if (!has_next) break;
#pragma unroll
        for (int a = 0; a < 2; ++a)
#pragma unroll
            for (int b = 0; b < 2; ++b)
#pragma unroll
                for (int m = 0; m < 4; ++m)
#pragma unroll
                    for (int n = 0; n < 2; ++n) acc[a][b][m][n] = (f32x4){0.f, 0.f, 0.f, 0.f};
        cur = nxt; cA = nA; cB = nB; ++ui;
        if constexpr (ALIGN_EPI) { if (wr == 1) PG8_BAR; }
    }
    PG8_WAIT_V(0);
    if constexpr (!ALIGN_EPI) { if (wr == 0) PG8_BAR; }
    PG8_BAR;
    if constexpr (Epi::AFTER_DRAIN) { E.fused(acc, cur, wr, wc, fr, fq, lds, wid, lane); S.done(cur); }
#undef PG8_SA
#undef PG8_SB
#undef PG8_STAGE
#undef PG8_LDA
#undef PG8_LDB
#undef PG8_MMA
#undef PG8_WAIT_V
#undef PG8_WAIT_L
#undef PG8_BAR
#undef PG8_SCHED
}

template <class Fn> struct EpiRow8 {
    static constexpr bool PERM = true, AFTER_DRAIN = false; Fn f;
    __device__ __forceinline__ void operator()(const f32x4 (&acc)[2][2][4][2], const Unit& u, int wr, int wc, int fr, int fq) const {
#pragma unroll
        for (int ai = 0; ai < 2; ++ai)
#pragma unroll
            for (int m = 0; m < 4; ++m) { const int r = u.pm * BM + ai * HALF + wr * 64 + m * 16 + fr;
#pragma unroll
                for (int bj = 0; bj < 2; ++bj) { const int c0 = u.pn * BM + bj * HALF + wc * 32 + 8 * fq;
                    const f32x4 v0 = acc[ai][bj][m][0], v1 = acc[ai][bj][m][1];
                    const float v[8] = {v0[0], v0[1], v0[2], v0[3], v1[0], v1[1], v1[2], v1[3]};
                    f.row8(r, c0, v); } }
    }
};
}

__device__ __forceinline__ void convert_fp8(const float* src, unsigned char* dst, size_t n, float scale, int gtid, int nthreads) {
    for (size_t i = (size_t)gtid * 16; i < n; i += (size_t)nthreads * 16) {
        v4u o;
#pragma unroll
        for (int j = 0; j < 4; ++j) { const f32x4 a = *(const f32x4*)(src + i + 4 * j); int w = 0;
            w = __builtin_amdgcn_cvt_pk_fp8_f32(a.x * scale, a.y * scale, w, false); w = __builtin_amdgcn_cvt_pk_fp8_f32(a.z * scale, a.w * scale, w, true);
            o[j] = (unsigned)w; }
        *(v4u*)(dst + i) = o;
    }
}

template <class Epi>
__device__ __forceinline__ void naive_gemm(const Frame& F, const bf16* A, const bf16* Bt, int M, int N, int K, const Epi& E) {
    LAS float* As = (LAS float*)F.lds;
    LAS float* Bs = As + 32 * 132;
    const int tid = F.tid, tr = tid >> 4, tc = tid & 15;
    const int ntn = N / 128, nt = (M / 128) * ntn;
    for (int tile = F.vcu; tile < nt; tile += F.G) {
        const int tm = tile / ntn, tn = tile % ntn;
        float acc[4][8];
#pragma unroll
        for (int i = 0; i < 4; ++i)
#pragma unroll
            for (int j = 0; j < 8; ++j) acc[i][j] = 0.f;
        for (int k0 = 0; k0 < K; k0 += 32) {
            { const int r = tid >> 2, kc = (tid & 3) * 8;
              const v4u a = *(const v4u*)(A + (size_t)(tm * 128 + r) * K + k0 + kc);
              const v4u b = *(const v4u*)(Bt + (size_t)(tn * 128 + r) * K + k0 + kc);
              float fa[8], fb[8]; unpack8(a, fa); unpack8(b, fb);
#pragma unroll
              for (int j = 0; j < 8; ++j) { As[(kc + j) * 132 + r] = fa[j]; Bs[(kc + j) * 132 + r] = fb[j]; } }
            __syncthreads();
#pragma unroll 8
            for (int k = 0; k < 32; ++k) {
                const f32x4 a = *(const LAS f32x4*)(As + k * 132 + tr * 4);
                const f32x4 b0 = *(const LAS f32x4*)(Bs + k * 132 + tc * 8), b1 = *(const LAS f32x4*)(Bs + k * 132 + tc * 8 + 4);
#pragma unroll
                for (int i = 0; i < 4; ++i) {
                    acc[i][0] += a[i] * b0.x; acc[i][1] += a[i] * b0.y; acc[i][2] += a[i] * b0.z; acc[i][3] += a[i] * b0.w;
                    acc[i][4] += a[i] * b1.x; acc[i][5] += a[i] * b1.y; acc[i][6] += a[i] * b1.z; acc[i][7] += a[i] * b1.w; }
            }
            __syncthreads();
        }
#pragma unroll
        for (int i = 0; i < 4; ++i) E.row8(tm * 128 + tr * 4 + i, tn * 128 + tc * 8, acc[i]);
    }
}

struct EpiStore { bf16* O; int ldc;
    __device__ __forceinline__ void row8(int r, int c0, const float (&v)[8]) const { *(v4u*)(O + (size_t)r * ldc + c0) = pack8(v); } };
struct EpiZ2 { bf16* ONOA; bf16* Zc; bf16* Zg;
    __device__ __forceinline__ void row8(int r, int c0, const float (&v)[8]) const {
        if (c0 < 1024) { float on[8], o[8]; unpack8(*(const v4u*)(ONOA + (size_t)r * D + c0), on);
#pragma unroll
            for (int j = 0; j < 8; ++j) o[j] = on[j] * (v[j] / (1.0f + __expf(-v[j])));
            *(v4u*)(ONOA + (size_t)r * D + c0) = pack8(o); }
        else if (c0 < 4096) *(v4u*)(Zc + (size_t)r * 3072 + (c0 - 1024)) = pack8(v);
        else *(v4u*)(Zg + (size_t)r * 2048 + (c0 - 4096)) = pack8(v); } };
struct EpiGateA { float* TMP; const bf16* Zg;
    __device__ __forceinline__ void row8(int r, int c0, const float (&v)[8]) const {
        float g[8]; unpack8(*(const v4u*)(Zg + (size_t)r * 2048 + c0), g);
        f32x4 o0, o1; o0.x = sigmoidf_(g[0]) * v[0]; o0.y = sigmoidf_(g[1]) * v[1]; o0.z = sigmoidf_(g[2]) * v[2]; o0.w = sigmoidf_(g[3]) * v[3];
        o1.x = sigmoidf_(g[4]) * v[4]; o1.y = sigmoidf_(g[5]) * v[5]; o1.z = sigmoidf_(g[6]) * v[6]; o1.w = sigmoidf_(g[7]) * v[7];
        *(f32x4*)(TMP + (size_t)r * D + c0) = o0; *(f32x4*)(TMP + (size_t)r * D + c0 + 4) = o1; } };
struct EpiGateB { const float* TMP; const bf16* Zg; bf16* MERGED;
    __device__ __forceinline__ void row8(int r, int c0, const float (&v)[8]) const {
        float g[8]; unpack8(*(const v4u*)(Zg + (size_t)r * 2048 + 1024 + c0), g);
        const f32x4 t0 = *(const f32x4*)(TMP + (size_t)r * D + c0), t1 = *(const f32x4*)(TMP + (size_t)r * D + c0 + 4);
        float o[8]; o[0] = t0.x + sigmoidf_(g[0]) * v[0]; o[1] = t0.y + sigmoidf_(g[1]) * v[1]; o[2] = t0.z + sigmoidf_(g[2]) * v[2]; o[3] = t0.w + sigmoidf_(g[3]) * v[3];
        o[4] = t1.x + sigmoidf_(g[4]) * v[4]; o[5] = t1.y + sigmoidf_(g[5]) * v[5]; o[6] = t1.z + sigmoidf_(g[6]) * v[6]; o[7] = t1.w + sigmoidf_(g[7]) * v[7];
        *(v4u*)(MERGED + (size_t)r * D + c0) = pack8(o); } };
struct EpiResid { const float* X; float* Y;
    __device__ __forceinline__ void row8(int r, int c0, const float (&v)[8]) const {
        const f32x4 x0 = *(const f32x4*)(X + (size_t)r * D + c0), x1 = *(const f32x4*)(X + (size_t)r * D + c0 + 4);
        f32x4 o0, o1; o0.x = ALPHA * x0.x + v[0]; o0.y = ALPHA * x0.y + v[1]; o0.z = ALPHA * x0.z + v[2]; o0.w = ALPHA * x0.w + v[3];
        o1.x = ALPHA * x1.x + v[4]; o1.y = ALPHA * x1.y + v[5]; o1.z = ALPHA * x1.z + v[6]; o1.w = ALPHA * x1.w + v[7];
        *(f32x4*)(Y + (size_t)r * D + c0) = o0; *(f32x4*)(Y + (size_t)r * D + c0 + 4) = o1; } };
struct EpiFinal { const bf16* X2B; const bf16* PP; float* OUT;
    __device__ __forceinline__ void row8(int r, int c0, const float (&v)[8]) const {
        float p[8], x2[8]; unpack8(*(const v4u*)(PP + (size_t)r * D + c0), p); unpack8(*(const v4u*)(X2B + (size_t)r * D + c0), x2);
        f32x4 o0, o1; o0.x = x2[0] + sigmoidf_(v[0]) * p[0]; o0.y = x2[1] + sigmoidf_(v[1]) * p[1]; o0.z = x2[2] + sigmoidf_(v[2]) * p[2]; o0.w = x2[3] + sigmoidf_(v[3]) * p[3];
        o1.x = x2[4] + sigmoidf_(v[4]) * p[4]; o1.y = x2[5] + sigmoidf_(v[5]) * p[5]; o1.z = x2[6] + sigmoidf_(v[6]) * p[6]; o1.w = x2[7] + sigmoidf_(v[7]) * p[7];
        *(f32x4*)(OUT + (size_t)r * D + c0) = o0; *(f32x4*)(OUT + (size_t)r * D + c0 + 4) = o1; } };

template <class Fn>
__device__ __forceinline__ void run_gemm(const Frame& F, const bf16* A, const bf16* Bt, int M, int N, int K, const Fn& fn) {
    pg8::Gemm g{A, Bt, M, N, K}; pg8::StaticOrder S; S.init(M, N, F.G, (int)blockIdx.x);
    pg8::EpiRow8<Fn> E{fn};
    pg8::gemm_phase<pg8::EpiRow8<Fn>, pg8::StaticOrder, true, true>(F.lds, g, S, E);
}

__device__ __forceinline__ void ln_row_store(f32x4 (&v)[4], const float* g, const float* b, float* orow, bf16* obrow, int lane) {
    float s = 0.f;
#pragma unroll
    for (int j = 0; j < 4; ++j) s += (v[j].x + v[j].y) + (v[j].z + v[j].w);
    const float mean = wave_sum(s) * (1.f / D); float s2 = 0.f;
#pragma unroll
    for (int j = 0; j < 4; ++j) { v[j] = v[j] - mean; s2 += (v[j].x * v[j].x + v[j].y * v[j].y) + (v[j].z * v[j].z + v[j].w * v[j].w); }
    const float rstd = 1.f / sqrtf(wave_sum(s2) * (1.f / D) + LN_EPS);
#pragma unroll
    for (int j = 0; j < 4; ++j) {
        const f32x4 gg = *(const f32x4*)(g + 4 * lane + 256 * j), bb = *(const f32x4*)(b + 4 * lane + 256 * j);
        const f32x4 o = v[j] * rstd * gg + bb;
        *(f32x4*)(orow + 4 * lane + 256 * j) = o;
        unsigned long long w = (unsigned long long)pk2(o.x, o.y) | ((unsigned long long)pk2(o.z, o.w) << 32);
        *(unsigned long long*)(obrow + 4 * lane + 256 * j) = w;
    }
}
__device__ __forceinline__ float gelu_erf(float x) { return 0.5f * x * (1.0f + erff(x * 0.70710678118654752f)); }

__device__ __forceinline__ float gelu_fast(float v) {
    const float av = fabsf(v), t = __builtin_amdgcn_rcpf(av * 0.2316418882f + 1.0f);
    float q = t * 0.5307027145f + (-0.7265760135f); q = q * t + 0.7107068705f; q = q * t + (-0.142248368f); q = q * t + 0.127414796f; q = q * t;
    const float e = __builtin_amdgcn_exp2f((v * v) * (-0.72134752044f));
    const float m = v * (q * e);
    return v < 0.f ? m : v - m;
}

__global__ void __launch_bounds__(NWAVES * 64, 2) skel_fwd(Args args) {
    extern __shared__ __attribute__((aligned(16))) unsigned char lds[];
    Frame F;
    F.lds = (LAS unsigned char*)lds;
    F.tid = threadIdx.x; F.lane = F.tid & 63; F.wave = __builtin_amdgcn_readfirstlane(F.tid >> 6);
    F.G = gridDim.x; { const int bx = blockIdx.x; F.vcu = (F.G % 8 == 0) ? (bx % 8) * (F.G / 8) + bx / 8 : bx; }
    unsigned char* ws = args.ws;
    volatile LAS unsigned* MISC = (volatile LAS unsigned*)(F.lds + MISC_OFF);
    for (int u = F.tid; u < (LDS_BYTES - LDSCTL_OFF) / 4; u += NWAVES * 64) ((LAS unsigned*)(F.lds + LDSCTL_OFF))[u] = 0u;
    __syncthreads();
    XcdBarrier bar; bar.bar = (unsigned*)(ws + WS_CTL) + CW_BAR; bar.x = 0; bar.st = nullptr;
    if (N_LAUNCHES == 1) bar = xcd_barrier_post((unsigned*)(ws + WS_CTL) + CW_BAR, MISC + 8);
    if (N_LAUNCHES == 1 && F.tid == 0) { MISC[10] = xb_add((unsigned*)(ws + WS_CTL) + CW_XRANK + 64 * bar.x, 1u); }
    const int lo = args.ph_lo, hi = args.ph_hi;
#define IN(k) (lo <= (k) && (k) < hi)
#define SEAM(k) do { if (IN(k) && IN((k) + 1)) xcd_barrier(bar); } while (0)

    const float* x = args.in[0]; const float* p = args.in[1]; const float* w_in = args.in[2]; const float* lb_param = args.in[3];
    const float* hg_norm_g = args.in[4]; const float* conv_w = args.in[5]; const float* conv_b = args.in[6];
    const float* w_a = args.in[7]; const float* w_b = args.in[8]; const float* w_out = args.in[9];
    const float* ln1_g = args.in[10]; const float* ln1_b = args.in[11]; const float* pk_wq = args.in[12]; const float* pk_sk = args.in[13];
    const float* pk_u = args.in[14]; const float* pk_v = args.in[15]; const float* ln2_g = args.in[16]; const float* ln2_b = args.in[17];
    const float* w_pg = args.in[18]; const float* w_pp = args.in[19];
    float* out = args.out;
    bf16* WinT = (bf16*)(ws + WS_WIN); bf16* WaT = (bf16*)(ws + WS_WA); bf16* WbT = (bf16*)(ws + WS_WB); bf16* WoT = (bf16*)(ws + WS_WO);
    bf16* WpgT = (bf16*)(ws + WS_WPG); bf16* WqT = (bf16*)(ws + WS_WQ); bf16* SKB = (bf16*)(ws + WS_SK); bf16* WppT = (bf16*)(ws + WS_WPP);
    bf16* XB = (bf16*)(ws + WS_XB); bf16* PB = (bf16*)(ws + WS_PB);
    bf16* Zhg = (bf16*)(ws + WS_BIG); bf16* Zc = (bf16*)(ws + WS_ZC); bf16* Zg = (bf16*)(ws + WS_ZG);
    unsigned char* UF8 = (unsigned char*)out; unsigned char* VF8 = (unsigned char*)out + (size_t)16384 * D;
    bf16* ST = (bf16*)out;
    bf16* VT = (bf16*)(ws + WS_VT); bf16* KET = (bf16*)(ws + WS_KET); float* DEC = (float*)(ws + WS_DEC); bf16* ON = (bf16*)(ws + WS_OA);
    bf16* OA = (bf16*)(ws + WS_OA); bf16* YC = (bf16*)(ws + WS_YC);
    float* TMP = (float*)(ws + WS_ZC);
    bf16* MERGED = (bf16*)(ws + WS_OA);
    float* Y = (float*)(ws + WS_Y); float* X1 = (float*)(ws + WS_X1); bf16* X1B = (bf16*)(ws + WS_X1B);
    bf16* QP = (bf16*)(ws + WS_QP); bf16* PP = (bf16*)(ws + WS_OA);
    int* IDS = (int*)(ws + WS_IDS); float* GW = (float*)(ws + WS_GW);
    bf16* X2B = (bf16*)(ws + WS_X2B); bf16* YB = (bf16*)(ws + WS_YB); float* WGT = (float*)(ws + WS_WGT); float* STATS = (float*)(ws + WS_STATS);

    const int gtid = F.vcu * (NWAVES * 64) + F.tid, NT = F.G * NWAVES * 64;
    const int gw = F.vcu * NWAVES + F.wave, NGW = F.G * NWAVES;

    if (IN(0)) {
        LAS float* scr = (LAS float*)(F.lds + F.wave * 16384);
        constexpr int I_IN = (D / 64) * (PROJ_W / 32), I_SQ = (D / 64) * (D / 32), I_Q = (D / 64) * (2048 / 32), I_PP = (PLE / 64) * (D / 32);
        constexpr int NITEMS = I_IN + 4 * I_SQ + I_Q + I_PP;
        for (int it = gw; it < NITEMS; it += NGW) {
            int r = it;
            if (r < I_IN) { p0_transpose_item(w_in, D, PROJ_W, WinT, scr, r, F.lane); continue; } r -= I_IN;
            if (r < I_SQ) { p0_transpose_item(w_a, D, D, WaT, scr, r, F.lane); continue; } r -= I_SQ;
            if (r < I_SQ) { p0_transpose_item(w_b, D, D, WbT, scr, r, F.lane); continue; } r -= I_SQ;
            if (r < I_SQ) { p0_transpose_item(w_out, D, D, WoT, scr, r, F.lane); continue; } r -= I_SQ;
            if (r < I_SQ) { p0_transpose_item(w_pg, D, D, WpgT, scr, r, F.lane); continue; } r -= I_SQ;
            if (r < I_Q) { p0_transpose_item(pk_wq, D, 2048, WqT, scr, r, F.lane); continue; } r -= I_Q;
            p0_transpose_item(w_pp, PLE, D, WppT, scr, r, F.lane);
        }
        convert_rows(x, XB, (size_t)T * D, gtid, NT);
        convert_rows(p, PB, (size_t)T * PLE, gtid, NT);
        convert_rows(pk_sk, SKB, (size_t)PKH * 2 * NKEYS * 128, gtid, NT);
    }
    SEAM(0);
    if (IN(1)) { EpiStore E{Zhg, 3072}; run_gemm(F, XB, WinT, T, 3072, D, E); }
    SEAM(1);
    if (IN(2)) {
        LAS float* tot = (LAS float*)F.lds;
        for (int unit = F.vcu; unit < 2048; unit += F.G) {
            const int n = unit >> 3, h = unit & 7, row0 = n * 64;
            const int c = F.tid & 127, sgm = F.tid >> 7, ch = h * 128 + c;
            const float lb = 1.0f / (1.0f + expf(lb_param[1024 + ch] - lb_param[ch]));
            float lf[16], kk[16];
            float run = 0.f;
#pragma unroll
            for (int i = 0; i < 16; ++i) { const size_t tok = (size_t)row0 + sgm * 16 + i;
                const float fz = bf2f(Zhg[tok * 3072 + 1024 + ch]); const float sg = 1.0f / (1.0f + expf(-fz));
                const float f = lb + (1.0f - lb) * sg; kk[i] = (1.0f - lb) * (1.0f - sg); run += logf(f); lf[i] = run; }
            tot[sgm * 128 + c] = run;
            __syncthreads();
            float off = 0.f, total = 0.f;
#pragma unroll
            for (int s2 = 0; s2 < 4; ++s2) { const float tv = tot[s2 * 128 + c]; total += tv; if (s2 < sgm) off += tv; }
            __syncthreads();
            float kev[16], vv[16];
#pragma unroll
            for (int i = 0; i < 16; ++i) { const size_t tok = (size_t)row0 + sgm * 16 + i; const float bc = lf[i] + off;
                const float q = bf2f(Zhg[tok * 3072 + ch]) * 0.08838834764831845f;
                const float qe = q * expf(bc), ke = kk[i] * expf(-bc);
                vv[i] = bf2f(Zhg[tok * 3072 + 2048 + ch]);
                Zhg[tok * 3072 + ch] = (bf16)f2bf(qe); Zhg[tok * 3072 + 1024 + ch] = (bf16)f2bf(ke); kev[i] = ke; }
            { float t0[8], t1[8];
#pragma unroll
              for (int i = 0; i < 8; ++i) { t0[i] = kev[i]; t1[i] = kev[8 + i]; }
              bf16* dst = KET + ((size_t)unit * 128 + c) * 64 + sgm * 16; *(v4u*)dst = pack8(t0); *(v4u*)(dst + 8) = pack8(t1);
#pragma unroll
              for (int i = 0; i < 8; ++i) { t0[i] = vv[i]; t1[i] = vv[8 + i]; }
              dst = VT + ((size_t)unit * 128 + c) * 64 + sgm * 16; *(v4u*)dst = pack8(t0); *(v4u*)(dst + 8) = pack8(t1); }
            if (sgm == 0) DEC[(size_t)n * 1024 + ch] = expf(total);
        }
    }
    SEAM(2);
    if (IN(3)) {
        const int q4 = F.lane >> 4, l15 = F.lane & 15;
        for (int unit = gw; unit < 2048; unit += NGW) {
            const int n = unit >> 3, h = unit & 7;
            const bf16* ket = KET + (size_t)unit * 128 * 64; const bf16* vt = VT + (size_t)unit * 128 * 64;
            bf16x8 a[8][2];
#pragma unroll
            for (int t = 0; t < 8; ++t)
#pragma unroll
                for (int s2 = 0; s2 < 2; ++s2) a[t][s2] = *(const bf16x8*)(ket + (16 * t + l15) * 64 + 32 * s2 + 8 * q4);
            f32x4 dc[8];
#pragma unroll
            for (int t = 0; t < 8; ++t) dc[t] = *(const f32x4*)(DEC + (size_t)n * 1024 + h * 128 + 16 * t + 4 * q4);
            for (int qd = 0; qd < 4; ++qd) {
                bf16x8 b[2][2];
#pragma unroll
                for (int cc = 0; cc < 2; ++cc)
#pragma unroll
                    for (int s2 = 0; s2 < 2; ++s2) b[cc][s2] = *(const bf16x8*)(vt + (32 * qd + 16 * cc + l15) * 64 + 32 * s2 + 8 * q4);
#pragma unroll
                for (int t = 0; t < 8; ++t)
#pragma unroll
                    for (int cc = 0; cc < 2; ++cc) {
                        f32x4 acc = (f32x4){0.f, 0.f, 0.f, 0.f};
                        acc = __builtin_amdgcn_mfma_f32_16x16x32_bf16(a[t][0], b[cc][0], acc, 0, 0, 0);
                        acc = __builtin_amdgcn_mfma_f32_16x16x32_bf16(a[t][1], b[cc][1], acc, 0, 0, 0);
                        acc = acc * dc[t];
                        const int dv = 32 * qd + 16 * cc + l15;
                        unsigned long long w = (unsigned long long)pk2(acc[0], acc[1]) | ((unsigned long long)pk2(acc[2], acc[3]) << 32);
                        *(unsigned long long*)(ST + ((size_t)unit * 128 + dv) * 128 + 16 * t + 4 * q4) = w;
                    }
            }
        }
    }
    SEAM(3);
    if (IN(4)) {
        for (int i = gtid; i < 65536; i += NT) {
            const int dk4 = i & 31, dv = (i >> 5) & 127, h = (i >> 12) & 7, b = i >> 15;
            f32x4 st = (f32x4){0.f, 0.f, 0.f, 0.f};
#pragma unroll 8
            for (int cn = 0; cn < 128; ++cn) {
                const int n = b * 128 + cn; const size_t unit = (size_t)n * 8 + h;
                unsigned long long* ptr = (unsigned long long*)(ST + (unit * 128 + dv) * 128 + dk4 * 4);
                const unsigned long long d = *ptr;
                const f32x4 dc = *(const f32x4*)(DEC + (size_t)n * 1024 + h * 128 + dk4 * 4);
                *ptr = (unsigned long long)pk2(st[0], st[1]) | ((unsigned long long)pk2(st[2], st[3]) << 32);
                const f32x4 dd = (f32x4){bflo((unsigned)d), bfhi((unsigned)d), bflo((unsigned)(d >> 32)), bfhi((unsigned)(d >> 32))};
                st = dc * st + dd;
            }
        }
    }
    SEAM(4);
    if (IN(5)) {
        const int q4 = F.lane >> 4, l15 = F.lane & 15;
        LAS bf16* Pl = (LAS bf16*)(F.lds + F.wave * 8192);
        for (int unit = gw; unit < 2048; unit += NGW) {
            const int n = unit >> 3, h = unit & 7, row0 = n * 64;
            const bf16* st = ST + (size_t)unit * 128 * 128; const bf16* vt = VT + (size_t)unit * 128 * 64;
            for (int half = 0; half < 2; ++half) {
                const int i0 = half * 32;
                bf16x8 qf[2][4];
#pragma unroll
                for (int it = 0; it < 2; ++it)
#pragma unroll
                    for (int ks = 0; ks < 4; ++ks) qf[it][ks] = *(const bf16x8*)(Zhg + (size_t)(row0 + i0 + 16 * it + l15) * 3072 + h * 128 + 32 * ks + 8 * q4);
                f32x4 acc[8][2];
#pragma unroll
                for (int dvt = 0; dvt < 8; ++dvt) { acc[dvt][0] = (f32x4){0.f, 0.f, 0.f, 0.f}; acc[dvt][1] = (f32x4){0.f, 0.f, 0.f, 0.f}; }
#pragma unroll
                for (int dvt = 0; dvt < 8; ++dvt)
#pragma unroll
                    for (int ks = 0; ks < 4; ++ks) { const bf16x8 a = *(const bf16x8*)(st + (16 * dvt + l15) * 128 + 32 * ks + 8 * q4);
                        acc[dvt][0] = __builtin_amdgcn_mfma_f32_16x16x32_bf16(a, qf[0][ks], acc[dvt][0], 0, 0, 0);
                        acc[dvt][1] = __builtin_amdgcn_mfma_f32_16x16x32_bf16(a, qf[1][ks], acc[dvt][1], 0, 0, 0); }
                const int njt = 2 * (half + 1);
                for (int jt = 0; jt < njt; ++jt) {
                    f32x4 p0 = (f32x4){0.f, 0.f, 0.f, 0.f}, p1 = (f32x4){0.f, 0.f, 0.f, 0.f};
#pragma unroll
                    for (int ks = 0; ks < 4; ++ks) { const bf16x8 a = *(const bf16x8*)(Zhg + (size_t)(row0 + 16 * jt + l15) * 3072 + 1024 + h * 128 + 32 * ks + 8 * q4);
                        p0 = __builtin_amdgcn_mfma_f32_16x16x32_bf16(a, qf[0][ks], p0, 0, 0, 0);
                        p1 = __builtin_amdgcn_mfma_f32_16x16x32_bf16(a, qf[1][ks], p1, 0, 0, 0); }
                    const int jb = 16 * jt + 4 * q4;
                    { const int ii = i0 + l15;
                      const float m0 = (jb + 0 <= ii) ? p0[0] : 0.f, m1 = (jb + 1 <= ii) ? p0[1] : 0.f, m2 = (jb + 2 <= ii) ? p0[2] : 0.f, m3 = (jb + 3 <= ii) ? p0[3] : 0.f;
                      *(LAS unsigned long long*)(Pl + l15 * 72 + jb) = (unsigned long long)pk2(m0, m1) | ((unsigned long long)pk2(m2, m3) << 32); }
                    { const int ii = i0 + 16 + l15;
                      const float m0 = (jb + 0 <= ii) ? p1[0] : 0.f, m1 = (jb + 1 <= ii) ? p1[1] : 0.f, m2 = (jb + 2 <= ii) ? p1[2] : 0.f, m3 = (jb + 3 <= ii) ? p1[3] : 0.f;
                      *(LAS unsigned long long*)(Pl + (16 + l15) * 72 + jb) = (unsigned long long)pk2(m0, m1) | ((unsigned long long)pk2(m2, m3) << 32); }
                }
                LDS_WAIT(); asm volatile("" ::: "memory");
                const int nks = half + 1;
                for (int kj = 0; kj < nks; ++kj) {
                    const bf16x8 b0 = *(const LAS bf16x8*)(Pl + l15 * 72 + 32 * kj + 8 * q4), b1 = *(const LAS bf16x8*)(Pl + (16 + l15) * 72 + 32 * kj + 8 * q4);
#pragma unroll
                    for (int dvt = 0; dvt < 8; ++dvt) { const bf16x8 a = *(const bf16x8*)(vt + (16 * dvt + l15) * 64 + 32 * kj + 8 * q4);
                        acc[dvt][0] = __builtin_amdgcn_mfma_f32_16x16x32_bf16(a, b0, acc[dvt][0], 0, 0, 0);
                        acc[dvt][1] = __builtin_amdgcn_mfma_f32_16x16x32_bf16(a, b1, acc[dvt][1], 0, 0, 0); }
                }
#pragma unroll
                for (int it = 0; it < 2; ++it) {
                    float ss = 0.f;
#pragma unroll
                    for (int dvt = 0; dvt < 8; ++dvt) { const f32x4 v = acc[dvt][it]; ss += (v[0] * v[0] + v[1] * v[1]) + (v[2] * v[2] + v[3] * v[3]); }
                    ss += __shfl_xor(ss, 16); ss += __shfl_xor(ss, 32);
                    const float rinv = 1.0f / sqrtf(ss * (1.0f / 128.0f) + RMS_EPS);
                    const size_t tok = (size_t)row0 + i0 + 16 * it + l15;
#pragma unroll
                    for (int dvt = 0; dvt < 8; ++dvt) { const f32x4 g4 = *(const f32x4*)(hg_norm_g + h * 128 + 16 * dvt + 4 * q4); const f32x4 o = acc[dvt][it] * rinv * g4;
                        *(unsigned long long*)(ON + tok * D + h * 128 + 16 * dvt + 4 * q4) = (unsigned long long)pk2(o[0], o[1]) | ((unsigned long long)pk2(o[2], o[3]) << 32); }
                }
                LDS_WAIT(); asm volatile("" ::: "memory");
            }
        }
    }
    SEAM(5);
    if (IN(6)) { EpiZ2 E{ON, Zc, Zg}; run_gemm(F, XB, WinT + (size_t)3072 * D, T, 6144, D, E); }
    SEAM(6);
    if (IN(7)) {
        for (int i = gtid; i < T * (D / 8); i += NT) {
            const int row = i / (D / 8), c0 = (i % (D / 8)) * 8, t = row % SEQ;
            float cb[8], u0[8], u1[8], u2[8], a[8], b[8];
            unpack8(*(const v4u*)(Zc + (size_t)row * 3072 + c0), cb);
            unpack8(*(const v4u*)(Zc + (size_t)row * 3072 + 1024 + c0), a); unpack8(*(const v4u*)(Zc + (size_t)row * 3072 + 2048 + c0), b);
#pragma unroll
            for (int j = 0; j < 8; ++j) u2[j] = a[j] * b[j];
            if (t >= 1) { unpack8(*(const v4u*)(Zc + (size_t)(row - 1) * 3072 + 1024 + c0), a); unpack8(*(const v4u*)(Zc + (size_t)(row - 1) * 3072 + 2048 + c0), b);
#pragma unroll
                for (int j = 0; j < 8; ++j) u1[j] = a[j] * b[j]; }
            else {
#pragma unroll
                for (int j = 0; j < 8; ++j) u1[j] = 0.f; }
            if (t >= 2) { unpack8(*(const v4u*)(Zc + (size_t)(row - 2) * 3072 + 1024 + c0), a); unpack8(*(const v4u*)(Zc + (size_t)(row - 2) * 3072 + 2048 + c0), b);
#pragma unroll
                for (int j = 0; j < 8; ++j) u0[j] = a[j] * b[j]; }
            else {
#pragma unroll
                for (int j = 0; j < 8; ++j) u0[j] = 0.f; }
            float y[8];
#pragma unroll
            for (int j = 0; j < 8; ++j) { const int c = c0 + j; y[j] = cb[j] * (conv_b[c] + conv_w[c] * u0[j] + conv_w[1024 + c] * u1[j] + conv_w[2048 + c] * u2[j]); }
            *(v4u*)(YC + (size_t)row * D + c0) = pack8(y);
        }
        convert_fp8(pk_u, UF8, (size_t)16384 * D, 32.0f, gtid, NT);
        convert_fp8(pk_v, VF8, (size_t)16384 * D, 1.0f, gtid, NT);
    }
    SEAM(7);
    if (IN(8)) { EpiGateA E{TMP, Zg}; run_gemm(F, OA, WaT, T, D, D, E); }
    SEAM(8);
    if (IN(9)) { EpiGateB E{TMP, Zg, MERGED}; run_gemm(F, YC, WbT, T, D, D, E); }
    SEAM(9);
    if (IN(10)) { EpiResid E{x, Y}; run_gemm(F, MERGED, WoT, T, D, D, E); }
    SEAM(10);
    if (IN(11)) {
        for (int row = gw; row < T; row += NGW) {
            f32x4 v[4];
#pragma unroll
            for (int j = 0; j < 4; ++j) v[j] = *(const f32x4*)(Y + (size_t)row * D + 4 * F.lane + 256 * j);
            ln_row_store(v, ln1_g, ln1_b, X1 + (size_t)row * D, X1B + (size_t)row * D, F.lane);
        }
    }
    SEAM(11);
    if (IN(12)) {
        { EpiStore E{QP, 2048}; run_gemm(F, X1B, WqT, T, 2048, D, E); }
        { EpiStore E{PP, D}; run_gemm(F, PB, WppT, T, D, PLE, E); }
    }
    SEAM(12);
    if (IN(13)) {
        const int lane = F.lane, r31 = lane & 31, hh = lane >> 5;
        LAS unsigned* ib = (LAS unsigned*)(F.lds + F.wave * 4096) + lane * 8;
        const float NEGV = -3.0e38f;
#define TK_INS(L, xx) do { const float x_ = (xx); _Pragma("unroll") for (int i_ = 15; i_ >= 1; --i_) L[i_] = __builtin_amdgcn_fmed3f(L[i_ - 1], L[i_], x_); L[0] = fmaxf(L[0], x_); } while (0)
        for (int task = gw; task < (T / 32) * PKH; task += NGW) {
            const int tg = task >> 3, h = task & 7; const size_t t = (size_t)tg * 32 + r31;
            float L1[16], L2[16];
#pragma unroll
            for (int p2 = 0; p2 < 2; ++p2) {
                float L[16];
#pragma unroll
                for (int i = 0; i < 16; ++i) L[i] = NEGV;
                bf16x8 bq[8];
#pragma unroll
                for (int ks = 0; ks < 8; ++ks) bq[ks] = *(const bf16x8*)(QP + t * 2048 + h * 256 + p2 * 128 + 16 * ks + 8 * hh);
#pragma unroll
                for (int kt = 0; kt < 4; ++kt) {
                    f32x16 acc;
#pragma unroll
                    for (int i = 0; i < 16; ++i) acc[i] = 0.f;
                    const bf16* krow = SKB + ((size_t)((h * 2 + p2) * 128 + 32 * kt + r31)) * 128 + 8 * hh;
#pragma unroll
                    for (int ks = 0; ks < 8; ++ks) { const bf16x8 a = *(const bf16x8*)(krow + 16 * ks); acc = __builtin_amdgcn_mfma_f32_32x32x16_bf16(a, bq[ks], acc, 0, 0, 0); }
#pragma unroll
                    for (int rg = 0; rg < 16; ++rg) { const float xv = acc[rg]; const int idxc = 32 * kt + (rg & 3) + 8 * (rg >> 2);
                        const float xp = __int_as_float((__float_as_int(xv) & ~0x7F) | idxc); TK_INS(L, xp); }
                }
                float P[16];
#pragma unroll
                for (int i = 0; i < 16; ++i) { L[i] = __int_as_float(__float_as_int(L[i]) | (4 * hh)); P[i] = __shfl_xor(L[i], 32); }
#pragma unroll
                for (int i = 0; i < 16; ++i) TK_INS(L, P[i]);
#pragma unroll
                for (int i = 0; i < 16; ++i) { if (p2 == 0) L1[i] = L[i]; else L2[i] = L[i]; }
            }
            unsigned ix1[16], ix2[16];
#pragma unroll
            for (int i = 0; i < 16; ++i) { ix1[i] = (unsigned)__float_as_int(L1[i]) & 0x7Fu; ix2[i] = (unsigned)__float_as_int(L2[i]) & 0x7Fu;
                L1[i] = __int_as_float(__float_as_int(L1[i]) & ~0x7F); L2[i] = __int_as_float(__float_as_int(L2[i]) & ~0x7F); }
#pragma unroll
            for (int i = 0; i < 4; ++i) { ib[i] = ix1[4 * i] | (ix1[4 * i + 1] << 8) | (ix1[4 * i + 2] << 16) | (ix1[4 * i + 3] << 24);
                                          ib[4 + i] = ix2[4 * i] | (ix2[4 * i + 1] << 8) | (ix2[4 * i + 2] << 16) | (ix2[4 * i + 3] << 24); }
            float W[16];
#pragma unroll
            for (int i = 0; i < 16; ++i) W[i] = NEGV;
#pragma unroll
            for (int a = 0; a < 16; ++a)
#pragma unroll
                for (int b = 0; b < 16; ++b)
                    if ((a + 1) * (b + 1) <= 16) { const float c = L1[a] + L2[b]; const float cp = __int_as_float((__float_as_int(c) & ~0xFF) | (a * 16 + b)); TK_INS(W, cp); }
            LDS_WAIT(); asm volatile("" ::: "memory");
            const LAS unsigned char* ibb = (const LAS unsigned char*)ib;
            int eid[16]; float ev[16];
#pragma unroll
            for (int k = 0; k < 16; ++k) { const int bits = __float_as_int(W[k]); const int a = (bits >> 4) & 15, b = bits & 15;
                eid[k] = (int)ibb[a] * 128 + (int)ibb[16 + b]; ev[k] = __int_as_float(bits & ~0xFF); }
            float sum = 0.f; const float mx = ev[0];
#pragma unroll
            for (int k = 0; k < 16; ++k) { ev[k] = expf(ev[k] - mx); sum += ev[k]; }
            const float inv = 1.0f / sum;
            if (hh == 0) {
#pragma unroll
                for (int k4 = 0; k4 < 4; ++k4) {
                    *(v4u*)(IDS + t * 128 + h * 16 + 4 * k4) = (v4u){(unsigned)eid[4 * k4], (unsigned)eid[4 * k4 + 1], (unsigned)eid[4 * k4 + 2], (unsigned)eid[4 * k4 + 3]};
                    *(f32x4*)(GW + t * 128 + h * 16 + 4 * k4) = (f32x4){ev[4 * k4] * inv, ev[4 * k4 + 1] * inv, ev[4 * k4 + 2] * inv, ev[4 * k4 + 3] * inv}; }
            }
            LDS_WAIT(); asm volatile("" ::: "memory");
        }
#undef TK_INS
    }
    SEAM(13);
    int gper = F.G, gfirst = 0, gstep = 1, grank = F.vcu;
    if (N_LAUNCHES == 1 && (IN(14) || IN(15))) {
        if (F.tid == 0) { unsigned* bw = (unsigned*)(ws + WS_CTL) + CW_BAR; unsigned nx = 0, gi = 0, mine = 1;
            for (unsigned j = 0; j < 16; ++j) { const unsigned c = xb_ld(&bw[XB_XCNT(j)]); if (c) { if (j < bar.x) ++gi; ++nx; } if (j == bar.x) mine = c ? c : 1u; }
            MISC[11] = mine; MISC[12] = gi; MISC[13] = nx ? nx : 1u; }
        __syncthreads();
        gper = (int)MISC[11]; gfirst = (int)MISC[12]; gstep = (int)MISC[13]; grank = (int)MISC[10];
    }
    if (IN(14)) {
        const int lane = F.lane;
        LAS unsigned char* wl = F.lds + F.wave * 17920;
        LAS unsigned char* xs8 = wl;
        LAS unsigned* ent = (LAS unsigned*)(wl + 8192);
        LAS float* entg = (LAS float*)(wl + 8192 + 4096);
        const bool isdiag = (lane >> 4) == ((lane >> 2) & 3);
        const float dm0 = (isdiag && (lane & 3) == 0) ? 1.f : 0.f, dm1 = (isdiag && (lane & 3) == 1) ? 1.f : 0.f, dm2 = (isdiag && (lane & 3) == 2) ? 1.f : 0.f, dm3 = (isdiag && (lane & 3) == 3) ? 1.f : 0.f;
        const bool h32 = (lane & 32) != 0, h16 = (lane & 16) != 0, h8 = (lane & 8) != 0, h4 = (lane & 4) != 0;
        for (int sl = gfirst; sl < 8; sl += gstep)
        for (int tg = grank * NWAVES + F.wave; tg < T / 8; tg += gper * NWAVES) {
            const size_t tb = (size_t)tg * 8;
            v4u idv[4]; f32x4 gv[4];
#pragma unroll
            for (int j = 0; j < 4; ++j) { idv[j] = *(const v4u*)(IDS + tb * 128 + lane * 4 + 256 * j); gv[j] = *(const f32x4*)(GW + tb * 128 + lane * 4 + 256 * j); }
#pragma unroll
            for (int ih = 0; ih < 2; ++ih) {
                v4u xr[4][2];
#pragma unroll
                for (int i = 0; i < 4; ++i) { xr[i][0] = *(const v4u*)(X1B + (tb + 4 * ih + i) * D + lane * 16); xr[i][1] = *(const v4u*)(X1B + (tb + 4 * ih + i) * D + lane * 16 + 8); }
#pragma unroll
                for (int i = 0; i < 4; ++i) { float xa[8], xb[8]; unpack8(xr[i][0], xa); unpack8(xr[i][1], xb);
                    v4u o; int w = 0;
                    w = __builtin_amdgcn_cvt_pk_fp8_f32(xa[0], xa[1], w, false); w = __builtin_amdgcn_cvt_pk_fp8_f32(xa[2], xa[3], w, true); o.x = (unsigned)w;
                    w = __builtin_amdgcn_cvt_pk_fp8_f32(xa[4], xa[5], w, false); w = __builtin_amdgcn_cvt_pk_fp8_f32(xa[6], xa[7], w, true); o.y = (unsigned)w;
                    w = __builtin_amdgcn_cvt_pk_fp8_f32(xb[0], xb[1], w, false); w = __builtin_amdgcn_cvt_pk_fp8_f32(xb[2], xb[3], w, true); o.z = (unsigned)w;
                    w = __builtin_amdgcn_cvt_pk_fp8_f32(xb[4], xb[5], w, false); w = __builtin_amdgcn_cvt_pk_fp8_f32(xb[6], xb[7], w, true); o.w = (unsigned)w;
                    *(LAS v4u*)(xs8 + (4 * ih + i) * 1024 + lane * 16) = o; }
                asm volatile("" ::: "memory");
            }
            int cnt = 0;
#pragma unroll
            for (int j = 0; j < 4; ++j)
#pragma unroll
                for (int c = 0; c < 4; ++c) { const unsigned id = idv[j][c]; const bool hit = (int)(id >> 11) == sl; const unsigned long long m = __ballot(hit);
                    const int r = cnt + (int)__builtin_amdgcn_mbcnt_hi((unsigned)(m >> 32), __builtin_amdgcn_mbcnt_lo((unsigned)m, 0u));
                    if (hit) { ent[r] = id | ((unsigned)((lane & 31) * 4 + c) << 14) | ((unsigned)(2 * j + (lane >> 5)) << 21); entg[r] = gv[j][c]; }
                    cnt += __popcll(m); }
            LDS_WAIT(); asm volatile("" ::: "memory");
            for (int base = 0; base < cnt; base += 16) {
                unsigned en[16]; v4u av[16];
#pragma unroll
                for (int i = 0; i < 16; ++i) { const int row = (base + i < cnt) ? base + i : cnt - 1; en[i] = (unsigned)__builtin_amdgcn_readfirstlane((int)ent[row]);
                    av[i] = *(const v4u*)(UF8 + (size_t)(en[i] & 0x3fffu) * D + lane * 16); }
                float dd[16];
#pragma unroll
                for (int i = 0; i < 16; ++i) {
                    const v4u bv = *(const LAS v4u*)(xs8 + (en[i] >> 21) * 1024 + lane * 16);
                    f32x4 acc = (f32x4){0.f, 0.f, 0.f, 0.f};
                    acc = __builtin_amdgcn_mfma_f32_16x16x32_fp8_fp8((long)(((unsigned long long)av[i].y << 32) | av[i].x), (long)(((unsigned long long)bv.y << 32) | bv.x), acc, 0, 0, 0);
                    acc = __builtin_amdgcn_mfma_f32_16x16x32_fp8_fp8((long)(((unsigned long long)av[i].w << 32) | av[i].z), (long)(((unsigned long long)bv.w << 32) | bv.z), acc, 0, 0, 0);
                    dd[i] = (dm0 * acc[0] + dm1 * acc[1]) + (dm2 * acc[2] + dm3 * acc[3]);
                }
                float v8[8], v4[4], v2[2];
#pragma unroll
                for (int i = 0; i < 8; ++i) v8[i] = (h32 ? dd[8 + i] : dd[i]) + __shfl_xor(h32 ? dd[i] : dd[8 + i], 32);
#pragma unroll
                for (int i = 0; i < 4; ++i) v4[i] = (h16 ? v8[4 + i] : v8[i]) + __shfl_xor(h16 ? v8[i] : v8[4 + i], 16);
#pragma unroll
                for (int i = 0; i < 2; ++i) v2[i] = (h8 ? v4[2 + i] : v4[i]) + __shfl_xor(h8 ? v4[i] : v4[2 + i], 8);
                float tot = (h4 ? v2[1] : v2[0]) + __shfl_xor(h4 ? v2[0] : v2[1], 4);
                tot += __shfl_xor(tot, 2); tot += __shfl_xor(tot, 1);
                const int row = base + ((lane >> 2) & 15);
                if ((lane & 3) == 0 && row < cnt) { const unsigned e2 = ent[row];
                    WGT[(tb + (e2 >> 21)) * 128 + ((e2 >> 14) & 127u)] = entg[row] * gelu_fast(tot * 0.03125f); }
            }
            LDS_WAIT(); asm volatile("" ::: "memory");
        }
    }
    SEAM(14);
    if (IN(15)) {
        const int lane = F.lane, rg = lane >> 3, c8 = lane & 7;
        LAS unsigned long long* pr = (LAS unsigned long long*)(F.lds + F.wave * 17920);
        for (int cs = gfirst; cs < 8; cs += gstep)
        for (int tg = grank * NWAVES + F.wave; tg < T / 8; tg += gper * NWAVES) {
            const size_t tb = (size_t)tg * 8;
#pragma unroll
            for (int j = 0; j < 4; ++j) { const v4u idv = *(const v4u*)(IDS + tb * 128 + lane * 4 + 256 * j); const f32x4 wv = *(const f32x4*)(WGT + tb * 128 + lane * 4 + 256 * j);
#pragma unroll
                for (int c = 0; c < 4; ++c) pr[lane * 4 + 256 * j + c] = ((unsigned long long)(unsigned)__float_as_int(wv[c]) << 32) | idv[c]; }
            const size_t t = tb + rg;
            const v4u xv0 = *(const v4u*)(X1B + t * D + cs * 128 + c8 * 16), xv1 = *(const v4u*)(X1B + t * D + cs * 128 + c8 * 16 + 8);
            LDS_WAIT(); asm volatile("" ::: "memory");
            float acc[16];
#pragma unroll
            for (int j = 0; j < 16; ++j) acc[j] = 0.f;
            const LAS unsigned* prt = (const LAS unsigned*)(pr + rg * 128);
            for (int it0 = 0; it0 < 128; it0 += 16) {
                v4u vv[16];
#pragma unroll
                for (int k = 0; k < 16; ++k) vv[k] = *(const v4u*)(VF8 + (size_t)prt[2 * (it0 + k)] * D + cs * 128 + c8 * 16);
#pragma unroll
                for (int k = 0; k < 16; ++k) { const float w = __int_as_float((int)prt[2 * (it0 + k) + 1]);
#pragma unroll
                    for (int j = 0; j < 4; ++j) { const int wd = (int)vv[k][j]; const f32x2 lo = __builtin_amdgcn_cvt_pk_f32_fp8(wd, false), hi = __builtin_amdgcn_cvt_pk_f32_fp8(wd, true);
                        acc[4 * j] += w * lo.x; acc[4 * j + 1] += w * lo.y; acc[4 * j + 2] += w * hi.x; acc[4 * j + 3] += w * hi.y; } }
            }
            { float x0[8], x1v[8]; unpack8(xv0, x0); unpack8(xv1, x1v);
#pragma unroll
              for (int j = 0; j < 8; ++j) { acc[j] += ALPHA * x0[j]; acc[8 + j] += ALPHA * x1v[j]; } }
            float s1 = 0.f, s2 = 0.f;
#pragma unroll
            for (int j = 0; j < 16; ++j) { s1 += acc[j]; s2 += acc[j] * acc[j]; }
            { float r0[8], r1[8];
#pragma unroll
              for (int j = 0; j < 8; ++j) { r0[j] = acc[j]; r1[j] = acc[8 + j]; }
              bf16* yr = YB + t * D + cs * 128 + c8 * 16;
              *(v4u*)yr = pack8(r0); *(v4u*)(yr + 8) = pack8(r1); }
            s1 += __shfl_xor(s1, 1); s1 += __shfl_xor(s1, 2); s1 += __shfl_xor(s1, 4);
            s2 += __shfl_xor(s2, 1); s2 += __shfl_xor(s2, 2); s2 += __shfl_xor(s2, 4);
            if (c8 == 0) { STATS[(t * 8 + cs) * 2] = s1; STATS[(t * 8 + cs) * 2 + 1] = s2; }
            LDS_WAIT(); asm volatile("" ::: "memory");
        }
    }
    SEAM(15);
    if (IN(16)) {
        for (int t = gw; t < T; t += NGW) {
            const int lane = F.lane;
            float y[16]; { float y0[8], y1[8]; unpack8(*(const v4u*)(YB + (size_t)t * D + lane * 16), y0); unpack8(*(const v4u*)(YB + (size_t)t * D + lane * 16 + 8), y1);
#pragma unroll
                for (int j = 0; j < 8; ++j) { y[j] = y0[j]; y[8 + j] = y1[j]; } }
            float s1 = (lane < 8) ? STATS[((size_t)t * 8 + lane) * 2] : 0.f, s2 = (lane < 8) ? STATS[((size_t)t * 8 + lane) * 2 + 1] : 0.f;
            s1 += __shfl_xor(s1, 1); s1 += __shfl_xor(s1, 2); s1 += __shfl_xor(s1, 4);
            s2 += __shfl_xor(s2, 1); s2 += __shfl_xor(s2, 2); s2 += __shfl_xor(s2, 4);
            s1 = __shfl(s1, 0); s2 = __shfl(s2, 0);
            const float mean = s1 * (1.f / D); const float var = fmaxf(s2 * (1.f / D) - mean * mean, 0.f); const float rstd = 1.f / sqrtf(var + LN_EPS);
            float res[16];
#pragma unroll
            for (int j = 0; j < 4; ++j) { const f32x4 gg = *(const f32x4*)(ln2_g + lane * 16 + 4 * j), bb4 = *(const f32x4*)(ln2_b + lane * 16 + 4 * j);
                res[4 * j] = (y[4 * j] - mean) * rstd * gg.x + bb4.x; res[4 * j + 1] = (y[4 * j + 1] - mean) * rstd * gg.y + bb4.y;
                res[4 * j + 2] = (y[4 * j + 2] - mean) * rstd * gg.z + bb4.z; res[4 * j + 3] = (y[4 * j + 3] - mean) * rstd * gg.w + bb4.w; }
            { float r0[8], r1[8];
#pragma unroll
              for (int j = 0; j < 8; ++j) { r0[j] = res[j]; r1[j] = res[8 + j]; }
              *(v4u*)(X2B + (size_t)t * D + lane * 16) = pack8(r0); *(v4u*)(X2B + (size_t)t * D + lane * 16 + 8) = pack8(r1); }
        }
    }
    SEAM(16);
    if (IN(17)) { EpiFinal E{X2B, PP, out}; run_gemm(F, X2B, WpgT, T, D, D, E); }
#undef IN
#undef SEAM
}

extern "C" void kernel_launch(void* const* d_in, const int* in_sizes, int n_in, void* d_out, int out_size, void* d_ws, size_t ws_size, hipStream_t stream) {
    static int grid = 0;
    if (grid == 0) {
        if (n_in != 20 || out_size != T * D || ws_size < WS_END) { fprintf(stderr, "kernel_launch: unexpected shapes (n_in %d out %d ws %zu)\n", n_in, out_size, ws_size); grid = -1; return; }
        int dev = 0, cus = 0;
        if (hipGetDevice(&dev) != hipSuccess || hipDeviceGetAttribute(&cus, hipDeviceAttributeMultiprocessorCount, dev) != hipSuccess) { grid = -1; return; }
        if (hipFuncSetAttribute((const void*)skel_fwd, hipFuncAttributeMaxDynamicSharedMemorySize, LDS_BYTES) != hipSuccess) { fprintf(stderr, "kernel_launch: hipFuncSetAttribute failed\n"); grid = -1; return; }
        (void)hipGetLastError();
        grid = cus;
    }
    if (grid < 0) return;
    if (hipMemsetAsync((char*)d_ws + WS_CTL, 0, CTL_ZERO_BYTES, stream) != hipSuccess) return;
    Args a{};
    for (int i = 0; i < 20; ++i) a.in[i] = (const float*)d_in[i];
    a.out = (float*)d_out; a.ws = (unsigned char*)d_ws;
    if (N_LAUNCHES == 1) {
        a.ph_lo = 0; a.ph_hi = NPHASES; a.li = 0;
        hipLaunchKernelGGL(skel_fwd, dim3(grid), dim3(NWAVES * 64), LDS_BYTES, stream, a);
    } else {
        for (int li = 0; li < NPHASES; ++li) {
            a.ph_lo = li; a.ph_hi = li + 1; a.li = li;
            hipLaunchKernelGGL(skel_fwd, dim3(grid), dim3(NWAVES * 64), LDS_BYTES, stream, a);
        }
    }
}
```

```cpp
#include <hip/hip_runtime.h>
#include <cstdio>
#include <cstdint>
#include <cmath>

#ifndef MK_N_LAUNCHES
#define MK_N_LAUNCHES 1
#endif

constexpr int BATCH = 2, SEQ = 8192, D = 1024, T = BATCH * SEQ;
constexpr int PROJ_W = 9216;
constexpr int NHEAD = 8, DK = 128;
constexpr int PKH = 8, PKD = 256, NKEYS = 128, TOPK = 16;
constexpr int PLE = 256;
constexpr float LN_EPS = 1e-5f, RMS_EPS = 1e-6f;
constexpr float ALPHA = 1.189207115002721f;
constexpr int NWAVES = 8;
constexpr int NPHASES = 18;
constexpr int N_LAUNCHES = MK_N_LAUNCHES;

constexpr size_t MiB = 1u << 20;
constexpr size_t WS_CTL = 0, CTL_ZERO_BYTES = 1 * MiB;
constexpr size_t WS_WIN = 1 * MiB;
constexpr size_t WS_WA = 19 * MiB, WS_WB = 21 * MiB, WS_WO = 23 * MiB, WS_WPG = 25 * MiB;
constexpr size_t WS_WQ = 27 * MiB;
constexpr size_t WS_SK = 31 * MiB;
constexpr size_t WS_WPP = 31 * MiB + 512 * 1024;
constexpr size_t WS_XB = 32 * MiB;
constexpr size_t WS_BIG = 64 * MiB;
constexpr size_t WS_ZC = 64 * MiB;
constexpr size_t WS_ZG = 160 * MiB;
constexpr size_t WS_VT = 160 * MiB;
constexpr size_t WS_KET = 192 * MiB;
constexpr size_t WS_X1 = 128 * MiB;
constexpr size_t WS_X1B = 192 * MiB;
constexpr size_t WS_OA = 224 * MiB;
constexpr size_t WS_PB = 256 * MiB;
constexpr size_t WS_DEC = 264 * MiB;
constexpr size_t WS_END = 265 * MiB;
constexpr size_t WS_YC = WS_XB;
constexpr size_t WS_IDS = WS_XB;
constexpr size_t WS_GW = WS_XB + 8 * MiB;
constexpr size_t WS_Y = WS_BIG;
constexpr size_t WS_QP = WS_BIG;
constexpr size_t WS_WGT = WS_XB + 16 * MiB;
constexpr size_t WS_STATS = WS_XB + 24 * MiB;
constexpr size_t WS_YB = WS_BIG;
constexpr size_t WS_X2B = WS_BIG + 32 * MiB;
constexpr int CW_BAR = 4096;
constexpr int CW_XRANK = 8192;

constexpr int LDS_BYTES = 147456;
constexpr int RING_BYTES = 131072, LDSCTL_OFF = LDS_BYTES - 512, MISC_OFF = LDSCTL_OFF + 320;

#define GAS __attribute__((address_space(1)))
#define LAS __attribute__((address_space(3)))
typedef unsigned short bf16;
typedef unsigned v4u __attribute__((ext_vector_type(4)));
typedef float f32x4 __attribute__((ext_vector_type(4)));
typedef float f32x2 __attribute__((ext_vector_type(2)));
typedef short bf16x8 __attribute__((ext_vector_type(8)));
typedef float f32x16 __attribute__((ext_vector_type(16)));
typedef GAS unsigned gu32;
#define RLX_AGENT __ATOMIC_RELAXED, __HIP_MEMORY_SCOPE_AGENT
#define LDS_WAIT() asm volatile("s_waitcnt lgkmcnt(0)" ::: "memory")

__device__ __forceinline__ unsigned f2bf(float f) { unsigned u = __builtin_bit_cast(unsigned, f); return (u + 0x7fffu + ((u >> 16) & 1u)) >> 16; }
__device__ __forceinline__ unsigned pk2(float lo, float hi) { return f2bf(lo) | (f2bf(hi) << 16); }
__device__ __forceinline__ float bf2f(unsigned short h) { return __builtin_bit_cast(float, (unsigned)h << 16); }
__device__ __forceinline__ float bflo(unsigned w) { return __builtin_bit_cast(float, w << 16); }
__device__ __forceinline__ float bfhi(unsigned w) { return __builtin_bit_cast(float, w & 0xffff0000u); }
__device__ __forceinline__ void unpack8(const v4u w, float (&o)[8]) { o[0] = bflo(w.x); o[1] = bfhi(w.x); o[2] = bflo(w.y); o[3] = bfhi(w.y); o[4] = bflo(w.z); o[5] = bfhi(w.z); o[6] = bflo(w.w); o[7] = bfhi(w.w); }
__device__ __forceinline__ v4u pack8(const float (&v)[8]) { v4u w; w.x = pk2(v[0], v[1]); w.y = pk2(v[2], v[3]); w.z = pk2(v[4], v[5]); w.w = pk2(v[6], v[7]); return w; }
__device__ __forceinline__ float sigmoidf_(float x) { return 1.0f / (1.0f + __expf(-x)); }
__device__ __forceinline__ float wave_sum(float v) {
#pragma unroll
    for (int o = 1; o < 64; o <<= 1) v += __shfl_xor(v, o);
    return v;
}

#define XB_TMO      128
#define XB_XCNT(j)  (256  + 64 * (j))
#define XB_XSUB(j)  (1280 + 64 * (j))
#define XB_XGEN(j)  (2304 + 64 * (j))
#define XB_TOP      3328
#define XB_TOPGEN   3392
#define XCD_BAR_WORDS 3456
#define XB_SPIN_CAP (1u << 26)

__device__ __forceinline__ unsigned xb_ld(unsigned* p)              { return __hip_atomic_load(p, __ATOMIC_RELAXED, __HIP_MEMORY_SCOPE_AGENT); }
__device__ __forceinline__ unsigned xb_add(unsigned* p, unsigned v) { return __hip_atomic_fetch_add(p, v, __ATOMIC_RELAXED, __HIP_MEMORY_SCOPE_AGENT); }
__device__ __forceinline__ unsigned xb_xcc_id() { return (unsigned)__builtin_amdgcn_s_getreg((3 << 11) | 20) & 0xFu; }
#define XB_SPIN(cond, bar) do { unsigned _sp = 0; while (cond) { __builtin_amdgcn_s_sleep(1); \
    if ((++_sp & 255u) == 0u) { if (xb_ld(&(bar)[XB_TMO])) break; if (_sp > XB_SPIN_CAP) { atomicAdd(&(bar)[XB_TMO], 1u); break; } } } } while (0)

struct XcdBarrier { unsigned* bar; unsigned x; volatile LAS unsigned* st; };

__device__ __forceinline__ XcdBarrier xcd_barrier_post(unsigned* bar, volatile LAS unsigned* st) {
    XcdBarrier b; b.bar = bar; b.x = xb_xcc_id(); b.st = st;
    if (threadIdx.x == 0) (void)xb_add(&bar[XB_XCNT(b.x)], 1u);
    return b;
}
__device__ __forceinline__ void xcd_barrier_complete(unsigned* bar, unsigned x, unsigned& nloc, unsigned& nx) {
    const unsigned G = gridDim.x * gridDim.y * gridDim.z;
    unsigned sum, cnt, mine, sp = 0u;
    for (;;) {
        sum = 0u; cnt = 0u; mine = 0u;
#pragma unroll
        for (unsigned j = 0; j < 16; ++j) { const unsigned c = xb_ld(&bar[XB_XCNT(j)]); sum += c; cnt += (c > 0u) ? 1u : 0u; mine = (j == x) ? c : mine; }
        if (sum == G) break;
        __builtin_amdgcn_s_sleep(1);
        if ((++sp & 255u) == 0u) { if (xb_ld(&bar[XB_TMO])) break; if (sp > XB_SPIN_CAP) { atomicAdd(&bar[XB_TMO], 1u); break; } }
    }
    nloc = mine > 0u ? mine : 1u; nx = cnt > 0u ? cnt : 1u;
}
__device__ __forceinline__ void xcd_barrier(const XcdBarrier& b) {
    asm volatile("s_waitcnt vmcnt(0)" ::: "memory");
    __syncthreads();
    if (threadIdx.x == 0) {
        unsigned* bar = b.bar;
        __builtin_amdgcn_s_waitcnt(0);
        unsigned nloc = b.st[0], nx = b.st[1];
        if (nloc == 0u) { xcd_barrier_complete(bar, b.x, nloc, nx); b.st[0] = nloc; b.st[1] = nx; }
        const unsigned old = xb_add(&bar[XB_XSUB(b.x)], 1u);
        const unsigned gen = old / nloc;
        if (old + 1u == (gen + 1u) * nloc) {
            __builtin_amdgcn_fence(__ATOMIC_RELEASE, "agent");
            asm volatile("s_waitcnt vmcnt(0)" ::: "memory");
            const unsigned og = xb_add(&bar[XB_TOP], 1u);
            const unsigned tg = og / nx;
            if (og + 1u == (tg + 1u) * nx) xb_add(&bar[XB_TOPGEN], 1u);
            else XB_SPIN(xb_ld(&bar[XB_TOPGEN]) == tg, bar);
            __builtin_amdgcn_fence(__ATOMIC_ACQUIRE, "agent");
            xb_add(&bar[XB_XGEN(b.x)], 1u);
            asm volatile("s_waitcnt vmcnt(0)" ::: "memory");
        } else {
            XB_SPIN(xb_ld(&bar[XB_XGEN(b.x)]) == gen, bar);
            __builtin_amdgcn_fence(__ATOMIC_ACQUIRE, "agent");
            asm volatile("s_waitcnt vmcnt(0)" ::: "memory");
        }
    }
    __syncthreads();
}

struct Frame {
    LAS unsigned char* lds;
    int tid, lane, wave, vcu, G;
};

struct Args {
    const float* in[20]; float* out; unsigned char* ws; int ph_lo, ph_hi, li, pad;
};

__device__ __forceinline__ void p0_transpose_item(const float* W, int K, int N, bf16* WT, LAS float* scr, int item, int lane) {
    const int nblk = N / 32, kb = item / nblk, nb = item % nblk, k0 = 64 * kb, n0 = 32 * nb;
#pragma unroll 8
    for (int i = 0; i < 32; ++i) { const int kk = 2 * i + (lane >> 5); scr[kk * 33 + (lane & 31)] = W[(size_t)(k0 + kk) * N + n0 + (lane & 31)]; }
    LDS_WAIT(); asm volatile("" ::: "memory");
    const int c = lane & 7;
#pragma unroll
    for (int j = 0; j < 4; ++j) { const int n = (lane >> 3) + 8 * j; const LAS float* s = scr + (8 * c) * 33 + n;
        v4u o; o.x = pk2(s[0 * 33], s[1 * 33]); o.y = pk2(s[2 * 33], s[3 * 33]); o.z = pk2(s[4 * 33], s[5 * 33]); o.w = pk2(s[6 * 33], s[7 * 33]);
        *(v4u*)(WT + (size_t)(n0 + n) * K + k0 + 8 * c) = o; }
    LDS_WAIT(); asm volatile("" ::: "memory");
}
__device__ __forceinline__ void convert_rows(const float* src, bf16* dst, size_t n, int gtid, int nthreads) {
    for (size_t i = (size_t)gtid * 8; i < n; i += (size_t)nthreads * 8) {
        const f32x4 a = *(const f32x4*)(src + i), b = *(const f32x4*)(src + i + 4);
        v4u o; o.x = pk2(a.x, a.y); o.y = pk2(a.z, a.w); o.z = pk2(b.x, b.y); o.w = pk2(b.z, b.w);
        *(v4u*)(dst + i) = o;
    }
}

namespace pg8 {
#define PG8_LAS __attribute__((address_space(3)))
typedef unsigned short bf16_t;
typedef short bf16x8 __attribute__((ext_vector_type(8)));
typedef float f32x4 __attribute__((ext_vector_type(4)));
typedef unsigned u32x4 __attribute__((ext_vector_type(4)));
constexpr int BM = 256, BK = 64, HALF = 128, HTB = HALF * BK * 2  , STAGE_BYTES = 8 * HTB, NXCD = 8, WGM = 8;

__host__ __device__ __forceinline__ int lds_byte(int r, int c) { const int st = (r >> 4) * 2 + (c >> 5), rr = r & 15, cc = c & 31, ob = rr * 64 + cc * 2; return st * 1024 + (ob ^ (((ob >> 9) & 1) << 5)); }
__host__ __device__ __forceinline__ void stage_rc(int b, int& R, int& C) { const int st = b / 1024, sb = b % 1024, swz = sb ^ (((sb >> 9) & 1) << 5); R = (st >> 1) * 16 + swz / 64; C = (st & 1) * 32 + (swz % 64) / 2; }
__host__ __device__ __forceinline__ int perm32(int rho) { const int n = rho >> 4, i = rho & 15; return 8 * (i >> 2) + 4 * n + (i & 3); }

struct Unit { int pm, pn; };
struct Gemm { const bf16_t* A; const bf16_t* Bt; int M, N, K; };

struct StaticOrder {
    int nM, nN, nwg, G, c;
    __host__ __device__ void init(int M, int N, int G_, int c_) { nM = M / BM; nN = N / BM; nwg = nM * nN; G = G_; c = c_; }
    __host__ __device__ bool next(int i, Unit& u) const {
        const long L = (long)i * G + c; if (L >= nwg) return false;
        int wgid = (int)L; { const int q = nwg / NXCD, r = nwg % NXCD, xcd = wgid % NXCD, off = wgid / NXCD; wgid = (xcd < r ? xcd * (q + 1) : r * (q + 1) + (xcd - r) * q) + off; }
        const int nig = WGM * nN, gid = wgid / nig, fm = gid * WGM, gsz = (nM - fm) < WGM ? (nM - fm) : WGM;
        u.pm = fm + ((wgid % nig) % gsz); u.pn = (wgid % nig) / gsz; return true;
    }
    __device__ __forceinline__ void a_ready(const Unit&) const {}
    __device__ __forceinline__ void done(const Unit&) const {}
};

__device__ __forceinline__ unsigned cvt_pk_bf16(float lo, float hi) { unsigned r; asm volatile("v_cvt_pk_bf16_f32 %0, %1, %2" : "=v"(r) : "v"(lo), "v"(hi)); return r; }
typedef float f32x2 __attribute__((ext_vector_type(2)));
template <class Epi, class Sched, bool ALIGN_EPI = false, bool SP2 = false>
__device__ __forceinline__ void gemm_phase(PG8_LAS unsigned char* lds, const Gemm g, const Sched& S, const Epi& E) {
    const int tid = threadIdx.x, wid = __builtin_amdgcn_readfirstlane(tid >> 6), lane = tid & 63, wr = wid >> 2, wc = wid & 3, fr = lane & 15, fq = lane >> 4;
    const int K = g.K, nt = K / BK;
    unsigned voffA[2], voffB[2];
#pragma unroll
    for (int i = 0; i < 2; ++i) { int R, C; stage_rc(tid * 16 + i * 8192, R, C); const int Rb = Epi::PERM ? ((R & ~31) + perm32(R & 31)) : R;
        voffA[i] = (unsigned)(R * K + C) * 2u; voffB[i] = (unsigned)(Rb * K + C) * 2u; }
    const size_t kstep = (size_t)(BK * 2);
    const size_t hstep = (size_t)HALF * K * 2;
    const size_t tstep = 2 * hstep;
    const unsigned ldsw = (unsigned)wid * 1024u;
    const int aoff = lds_byte(wr * 64 + fr, fq * 8), boff = lds_byte(wc * 32 + fr, fq * 8);
#define PG8_SA(b, h) (((b) * 2 + (h)) * HTB)
#define PG8_SB(b, h) ((4 + (b) * 2 + (h)) * HTB)
#define PG8_STAGE(bufoff, gbase, voff) do { _Pragma("unroll") for (int _i = 0; _i < 2; ++_i) \
        __builtin_amdgcn_global_load_lds((const unsigned*)((const char*)(gbase) + (voff)[_i]), (PG8_LAS unsigned*)(lds + (bufoff) + ldsw + _i * 8192), 16, 0, 0); } while (0)
#define PG8_LDA(dst, b, h) do { _Pragma("unroll") for (int m = 0; m < 4; ++m) _Pragma("unroll") for (int k = 0; k < 2; ++k) dst[m][k] = *(const PG8_LAS bf16x8*)(lds + PG8_SA(b, h) + aoff + m * 2048 + k * 1024); } while (0)
#define PG8_LDB(dst, b, h) do { _Pragma("unroll") for (int n = 0; n < 2; ++n) _Pragma("unroll") for (int k = 0; k < 2; ++k) dst[n][k] = *(const PG8_LAS bf16x8*)(lds + PG8_SB(b, h) + boff + n * 2048 + k * 1024); } while (0)
#define PG8_MMA(ai, bj, At, Bt) do { __builtin_amdgcn_s_setprio(1); _Pragma("unroll") for (int m = 0; m < 4; ++m) _Pragma("unroll") for (int n = 0; n < 2; ++n) _Pragma("unroll") for (int k = 0; k < 2; ++k) \
        acc[ai][bj][m][n] = __builtin_amdgcn_mfma_f32_16x16x32_bf16(Bt[n][k], At[m][k], acc[ai][bj][m][n], 0, 0, 0); __builtin_amdgcn_s_setprio(0); } while (0)
#define PG8_WAIT_V(n) asm volatile("s_waitcnt vmcnt(" #n ")" ::: "memory")
#define PG8_WAIT_L(n) asm volatile("s_waitcnt lgkmcnt(" #n ")" ::: "memory")
#define PG8_BAR __builtin_amdgcn_s_barrier()
#define PG8_SCHED __builtin_amdgcn_sched_barrier(0)
    Unit cur, nxt; int ui = 0;
    if (!S.next(0, cur)) return;
    f32x4 acc[2][2][4][2];
#pragma unroll
    for (int a = 0; a < 2; ++a)
#pragma unroll
        for (int b = 0; b < 2; ++b)
#pragma unroll
            for (int m = 0; m < 4; ++m)
#pragma unroll
                for (int n = 0; n < 2; ++n) acc[a][b][m][n] = (f32x4){0.f, 0.f, 0.f, 0.f};
    bf16x8 At[4][2], B0[2][2], B1[2][2];
    const char* cA = (const char*)g.A + (size_t)cur.pm * tstep; const char* cB = (const char*)g.Bt + (size_t)cur.pn * tstep;
    S.a_ready(cur);
    if constexpr (SP2) {
        PG8_STAGE(PG8_SB(0, 0), cB, voffB); PG8_STAGE(PG8_SB(0, 1), cB + hstep, voffB); PG8_STAGE(PG8_SA(0, 0), cA, voffA); PG8_STAGE(PG8_SA(0, 1), cA + hstep, voffA);
        if (wr == 1) PG8_BAR;
        PG8_WAIT_V(2); PG8_BAR;
        PG8_STAGE(PG8_SB(1, 0), cB + kstep, voffB); PG8_STAGE(PG8_SA(1, 0), cA + kstep, voffA); PG8_STAGE(PG8_SB(1, 1), cB + hstep + kstep, voffB);
        PG8_WAIT_V(6); PG8_BAR;
    } else {
        PG8_STAGE(PG8_SB(0, 0), cB, voffB); PG8_STAGE(PG8_SA(0, 0), cA, voffA); PG8_STAGE(PG8_SB(0, 1), cB + hstep, voffB); PG8_STAGE(PG8_SA(0, 1), cA + hstep, voffA);
        if (wr == 1) PG8_BAR;
        PG8_WAIT_V(4); PG8_BAR;
        PG8_STAGE(PG8_SB(1, 0), cB + kstep, voffB); PG8_STAGE(PG8_SA(1, 0), cA + kstep, voffA); PG8_STAGE(PG8_SB(1, 1), cB + hstep + kstep, voffB);
        PG8_WAIT_V(6); PG8_BAR;
    }
    for (;;) {
        const bool has_next = S.next(ui + 1, nxt);
        const char* nA = has_next ? (const char*)g.A + (size_t)nxt.pm * tstep : cA; const char* nB = has_next ? (const char*)g.Bt + (size_t)nxt.pn * tstep : cB;
        for (int t = 0; t < nt; t += 2) {
            const bool last = (t == nt - 2);
            const char* a1 = cA + (size_t)(t + 1) * kstep;
            const char* a2 = last ? nA : cA + (size_t)(t + 2) * kstep; const char* b2 = last ? nB : cB + (size_t)(t + 2) * kstep;
            const char* a3 = a2 + kstep; const char* b3 = b2 + kstep;
            if (last && has_next) S.a_ready(nxt);
            if constexpr (SP2) {
            PG8_LDB(B0, 0, 0); PG8_LDB(B1, 0, 1); PG8_SCHED; PG8_LDA(At, 0, 0); PG8_STAGE(PG8_SA(1, 1), a1 + hstep, voffA);
            PG8_WAIT_V(8); PG8_WAIT_L(0); PG8_BAR; PG8_MMA(0, 0, At, B0); PG8_MMA(0, 1, At, B1); PG8_BAR; PG8_SCHED;
            PG8_LDA(At, 0, 1); PG8_STAGE(PG8_SB(0, 0), b2, voffB); PG8_STAGE(PG8_SB(0, 1), b2 + hstep, voffB); PG8_STAGE(PG8_SA(0, 0), a2, voffA);
            PG8_WAIT_V(8); PG8_WAIT_L(0); PG8_BAR; PG8_MMA(1, 0, At, B0); PG8_MMA(1, 1, At, B1); PG8_BAR; PG8_SCHED;
            PG8_LDB(B0, 1, 0); PG8_LDB(B1, 1, 1); PG8_SCHED; PG8_LDA(At, 1, 0); PG8_STAGE(PG8_SA(0, 1), a2 + hstep, voffA);
            PG8_WAIT_V(8); PG8_WAIT_L(0); PG8_BAR; PG8_MMA(0, 0, At, B0); PG8_MMA(0, 1, At, B1); PG8_BAR; PG8_SCHED;
            PG8_LDA(At, 1, 1); PG8_STAGE(PG8_SB(1, 0), b3, voffB); PG8_STAGE(PG8_SB(1, 1), b3 + hstep, voffB); PG8_STAGE(PG8_SA(1, 0), a3, voffA);
            PG8_WAIT_V(8); PG8_WAIT_L(0); PG8_BAR; PG8_MMA(1, 0, At, B0); PG8_MMA(1, 1, At, B1); PG8_BAR; PG8_SCHED;
            } else {
            PG8_LDB(B0, 0, 0); PG8_SCHED; PG8_LDA(At, 0, 0); PG8_STAGE(PG8_SA(1, 1), a1 + hstep, voffA);
            PG8_WAIT_L(8); PG8_BAR; PG8_WAIT_L(0); PG8_MMA(0, 0, At, B0); PG8_BAR; PG8_SCHED;
            PG8_LDB(B1, 0, 1); PG8_STAGE(PG8_SB(0, 0), b2, voffB);
            PG8_BAR; PG8_WAIT_L(0); PG8_MMA(0, 1, At, B1); PG8_BAR;
            PG8_LDA(At, 0, 1); PG8_STAGE(PG8_SA(0, 0), a2, voffA);
            PG8_BAR; PG8_WAIT_L(0); PG8_MMA(1, 0, At, B0); PG8_BAR; PG8_SCHED;
            PG8_STAGE(PG8_SB(0, 1), b2 + hstep, voffB);
            PG8_WAIT_V(6); PG8_BAR; PG8_MMA(1, 1, At, B1); PG8_BAR;
            PG8_LDB(B0, 1, 0); PG8_SCHED; PG8_LDA(At, 1, 0); PG8_STAGE(PG8_SA(0, 1), a2 + hstep, voffA);
            PG8_WAIT_L(8); PG8_BAR; PG8_WAIT_L(0); PG8_MMA(0, 0, At, B0); PG8_BAR; PG8_SCHED;
            PG8_LDB(B1, 1, 1); PG8_STAGE(PG8_SB(1, 0), b3, voffB);
            PG8_BAR; PG8_WAIT_L(0); PG8_MMA(0, 1, At, B1); PG8_BAR;
            PG8_LDA(At, 1, 1); PG8_STAGE(PG8_SA(1, 0), a3, voffA);
            PG8_BAR; PG8_WAIT_L(0); PG8_MMA(1, 0, At, B0); PG8_BAR; PG8_SCHED;
            PG8_STAGE(PG8_SB(1, 1), b3 + hstep, voffB);
            PG8_WAIT_V(6); PG8_BAR; PG8_MMA(1, 1, At, B1); PG8_BAR;
            }
        }
        if constexpr (ALIGN_EPI) { if (wr == 0) PG8_BAR; }
        if constexpr (!Epi::AFTER_DRAIN) { E(acc, cur, wr, wc, fr, fq); S.done(cur); }
        if (!has_next) break;
#pragma unroll
        for (int a = 0; a < 2; ++a)
#pragma unroll
            for (int b = 0; b < 2; ++b)
#pragma unroll
                for (int m = 0; m < 4; ++m)
#pragma unroll
                    for (int n = 0; n < 2; ++n) acc[a][b][m][n] = (f32x4){0.f, 0.f, 0.f, 0.f};
        cur = nxt; cA = nA; cB = nB; ++ui;
        if constexpr (ALIGN_EPI) { if (wr == 1) PG8_BAR; }
    }
    PG8_WAIT_V(0);
    if constexpr (!ALIGN_EPI) { if (wr == 0) PG8_BAR; }
    PG8_BAR;
    if constexpr (Epi::AFTER_DRAIN) { E.fused(acc, cur, wr, wc, fr, fq, lds, wid, lane); S.done(cur); }
#undef PG8_SA
#undef PG8_SB
#undef PG8_STAGE
#undef PG8_LDA
#undef PG8_LDB
#undef PG8_MMA
#undef PG8_WAIT_V
#undef PG8_WAIT_L
#undef PG8_BAR
#undef PG8_SCHED
}

template <class Fn> struct EpiRow8 {
    static constexpr bool PERM = true, AFTER_DRAIN = false; Fn f;
    __device__ __forceinline__ void operator()(const f32x4 (&acc)[2][2][4][2], const Unit& u, int wr, int wc, int fr, int fq) const {
#pragma unroll
        for (int ai = 0; ai < 2; ++ai)
#pragma unroll
            for (int m = 0; m < 4; ++m) { const int r = u.pm * BM + ai * HALF + wr * 64 + m * 16 + fr;
#pragma unroll
                for (int bj = 0; bj < 2; ++bj) { const int c0 = u.pn * BM + bj * HALF + wc * 32 + 8 * fq;
                    const f32x4 v0 = acc[ai][bj][m][0], v1 = acc[ai][bj][m][1];
                    const float v[8] = {v0[0], v0[1], v0[2], v0[3], v1[0], v1[1], v1[2], v1[3]};
                    f.row8(r, c0, v); } }
    }
};
}

__device__ __forceinline__ void convert_fp8(const float* src, unsigned char* dst, size_t n, float scale, int gtid, int nthreads) {
    for (size_t i = (size_t)gtid * 16; i < n; i += (size_t)nthreads * 16) {
        v4u o;
#pragma unroll
        for (int j = 0; j < 4; ++j) { const f32x4 a = *(const f32x4*)(src + i + 4 * j); int w = 0;
            w = __builtin_amdgcn_cvt_pk_fp8_f32(a.x * scale, a.y * scale, w, false); w = __builtin_amdgcn_cvt_pk_fp8_f32(a.z * scale, a.w * scale, w, true);
            o[j] = (unsigned)w; }
        *(v4u*)(dst + i) = o;
    }
}

template <class Epi>
__device__ __forceinline__ void naive_gemm(const Frame& F, const bf16* A, const bf16* Bt, int M, int N, int K, const Epi& E) {
    LAS float* As = (LAS float*)F.lds;
    LAS float* Bs = As + 32 * 132;
    const int tid = F.tid, tr = tid >> 4, tc = tid & 15;
    const int ntn = N / 128, nt = (M / 128) * ntn;
    for (int tile = F.vcu; tile < nt; tile += F.G) {
        const int tm = tile / ntn, tn = tile % ntn;
        float acc[4][8];
#pragma unroll
        for (int i = 0; i < 4; ++i)
#pragma unroll
            for (int j = 0; j < 8; ++j) acc[i][j] = 0.f;
        for (int k0 = 0; k0 < K; k0 += 32) {
            { const int r = tid >> 2, kc = (tid & 3) * 8;
              const v4u a = *(const v4u*)(A + (size_t)(tm * 128 + r) * K + k0 + kc);
              const v4u b = *(const v4u*)(Bt + (size_t)(tn * 128 + r) * K + k0 + kc);
              float fa[8], fb[8]; unpack8(a, fa); unpack8(b, fb);
#pragma unroll
              for (int j = 0; j < 8; ++j) { As[(kc + j) * 132 + r] = fa[j]; Bs[(kc + j) * 132 + r] = fb[j]; } }
            __syncthreads();
#pragma unroll 8
            for (int k = 0; k < 32; ++k) {
                const f32x4 a = *(const LAS f32x4*)(As + k * 132 + tr * 4);
                const f32x4 b0 = *(const LAS f32x4*)(Bs + k * 132 + tc * 8), b1 = *(const LAS f32x4*)(Bs + k * 132 + tc * 8 + 4);
#pragma unroll
                for (int i = 0; i < 4; ++i) {
                    acc[i][0] += a[i] * b0.x; acc[i][1] += a[i] * b0.y; acc[i][2] += a[i] * b0.z; acc[i][3] += a[i] * b0.w;
                    acc[i][4] += a[i] * b1.x; acc[i][5] += a[i] * b1.y; acc[i][6] += a[i] * b1.z; acc[i][7] += a[i] * b1.w; }
            }
            __syncthreads();
        }
#pragma unroll
        for (int i = 0; i < 4; ++i) E.row8(tm * 128 + tr * 4 + i, tn * 128 + tc * 8, acc[i]);
    }
}

struct EpiStore { bf16* O; int ldc;
    __device__ __forceinline__ void row8(int r, int c0, const float (&v)[8]) const { *(v4u*)(O + (size_t)r * ldc + c0) = pack8(v); } };
struct EpiZ2 { bf16* ONOA; bf16* Zc; bf16* Zg;
    __device__ __forceinline__ void row8(int r, int c0, const float (&v)[8]) const {
        if (c0 < 1024) { float on[8], o[8]; unpack8(*(const v4u*)(ONOA + (size_t)r * D + c0), on);
#pragma unroll
            for (int j = 0; j < 8; ++j) o[j] = on[j] * (v[j] / (1.0f + __expf(-v[j])));
            *(v4u*)(ONOA + (size_t)r * D + c0) = pack8(o); }
        else if (c0 < 4096) *(v4u*)(Zc + (size_t)r * 3072 + (c0 - 1024)) = pack8(v);
        else *(v4u*)(Zg + (size_t)r * 2048 + (c0 - 4096)) = pack8(v); } };
struct EpiGateA { float* TMP; const bf16* Zg;
    __device__ __forceinline__ void row8(int r, int c0, const float (&v)[8]) const {
        float g[8]; unpack8(*(const v4u*)(Zg + (size_t)r * 2048 + c0), g);
        f32x4 o0, o1; o0.x = sigmoidf_(g[0]) * v[0]; o0.y = sigmoidf_(g[1]) * v[1]; o0.z = sigmoidf_(g[2]) * v[2]; o0.w = sigmoidf_(g[3]) * v[3];
        o1.x = sigmoidf_(g[4]) * v[4]; o1.y = sigmoidf_(g[5]) * v[5]; o1.z = sigmoidf_(g[6]) * v[6]; o1.w = sigmoidf_(g[7]) * v[7];
        *(f32x4*)(TMP + (size_t)r * D + c0) = o0; *(f32x4*)(TMP + (size_t)r * D + c0 + 4) = o1; } };
struct EpiGateB { const float* TMP; const bf16* Zg; bf16* MERGED;
    __device__ __forceinline__ void row8(int r, int c0, const float (&v)[8]) const {
        float g[8]; unpack8(*(const v4u*)(Zg + (size_t)r * 2048 + 1024 + c0), g);
        const f32x4 t0 = *(const f32x4*)(TMP + (size_t)r * D + c0), t1 = *(const f32x4*)(TMP + (size_t)r * D + c0 + 4);
        float o[8]; o[0] = t0.x + sigmoidf_(g[0]) * v[0]; o[1] = t0.y + sigmoidf_(g[1]) * v[1]; o[2] = t0.z + sigmoidf_(g[2]) * v[2]; o[3] = t0.w + sigmoidf_(g[3]) * v[3];
        o[4] = t1.x + sigmoidf_(g[4]) * v[4]; o[5] = t1.y + sigmoidf_(g[5]) * v[5]; o[6] = t1.z + sigmoidf_(g[6]) * v[6]; o[7] = t1.w + sigmoidf_(g[7]) * v[7];
        *(v4u*)(MERGED + (size_t)r * D + c0) = pack8(o); } };
struct EpiResid { const float* X; float* Y;
    __device__ __forceinline__ void row8(int r, int c0, const float (&v)[8]) const {
        const f32x4 x0 = *(const f32x4*)(X + (size_t)r * D + c0), x1 = *(const f32x4*)(X + (size_t)r * D + c0 + 4);
        f32x4 o0, o1; o0.x = ALPHA * x0.x + v[0]; o0.y = ALPHA * x0.y + v[1]; o0.z = ALPHA * x0.z + v[2]; o0.w = ALPHA * x0.w + v[3];
        o1.x = ALPHA * x1.x + v[4]; o1.y = ALPHA * x1.y + v[5]; o1.z = ALPHA * x1.z + v[6]; o1.w = ALPHA * x1.w + v[7];
        *(f32x4*)(Y + (size_t)r * D + c0) = o0; *(f32x4*)(Y + (size_t)r * D + c0 + 4) = o1; } };
struct EpiFinal { const bf16* X2B; const bf16* PP; float* OUT;
    __device__ __forceinline__ void row8(int r, int c0, const float (&v)[8]) const {
        float p[8], x2[8]; unpack8(*(const v4u*)(PP + (size_t)r * D + c0), p); unpack8(*(const v4u*)(X2B + (size_t)r * D + c0), x2);
        f32x4 o0, o1; o0.x = x2[0] + sigmoidf_(v[0]) * p[0]; o0.y = x2[1] + sigmoidf_(v[1]) * p[1]; o0.z = x2[2] + sigmoidf_(v[2]) * p[2]; o0.w = x2[3] + sigmoidf_(v[3]) * p[3];
        o1.x = x2[4] + sigmoidf_(v[4]) * p[4]; o1.y = x2[5] + sigmoidf_(v[5]) * p[5]; o1.z = x2[6] + sigmoidf_(v[6]) * p[6]; o1.w = x2[7] + sigmoidf_(v[7]) * p[7];
        *(f32x4*)(OUT + (size_t)r * D + c0) = o0; *(f32x4*)(OUT + (size_t)r * D + c0 + 4) = o1; } };

template <class Fn>
__device__ __forceinline__ void run_gemm(const Frame& F, const bf16* A, const bf16* Bt, int M, int N, int K, const Fn& fn) {
    pg8::Gemm g{A, Bt, M, N, K}; pg8::StaticOrder S; S.init(M, N, F.G, (int)blockIdx.x);
    pg8::EpiRow8<Fn> E{fn};
    pg8::gemm_phase<pg8::EpiRow8<Fn>, pg8::StaticOrder, true, true>(F.lds, g, S, E);
}

__device__ __forceinline__ void ln_row_store(f32x4 (&v)[4], const float* g, const float* b, float* orow, bf16* obrow, int lane) {
    float s = 0.f;
#pragma unroll
    for (int j = 0; j < 4; ++j) s += (v[j].x + v[j].y) + (v[j].z + v[j].w);
    const float mean = wave_sum(s) * (1.f / D); float s2 = 0.f;
#pragma unroll
    for (int j = 0; j < 4; ++j) { v[j] = v[j] - mean; s2 += (v[j].x * v[j].x + v[j].y * v[j].y) + (v[j].z * v[j].z + v[j].w * v[j].w); }
    const float rstd = 1.f / sqrtf(wave_sum(s2) * (1.f / D) + LN_EPS);
#pragma unroll
    for (int j = 0; j < 4; ++j) {
        const f32x4 gg = *(const f32x4*)(g + 4 * lane + 256 * j), bb = *(const f32x4*)(b + 4 * lane + 256 * j);
        const f32x4 o = v[j] * rstd * gg + bb;
        *(f32x4*)(orow + 4 * lane + 256 * j) = o;
        unsigned long long w = (unsigned long long)pk2(o.x, o.y) | ((unsigned long long)pk2(o.z, o.w) << 32);
        *(unsigned long long*)(obrow + 4 * lane + 256 * j) = w;
    }
}
__device__ __forceinline__ float gelu_erf(float x) { return 0.5f * x * (1.0f + erff(x * 0.70710678118654752f)); }

__device__ __forceinline__ float gelu_fast(float v) {
    const float av = fabsf(v), t = __builtin_amdgcn_rcpf(av * 0.2316418882f + 1.0f);
    float q = t * 0.5307027145f + (-0.7265760135f); q = q * t + 0.7107068705f; q = q * t + (-0.142248368f); q = q * t + 0.127414796f; q = q * t;
    const float e = __builtin_amdgcn_exp2f((v * v) * (-0.72134752044f));
    const float m = v * (q * e);
    return v < 0.f ? m : v - m;
}

__device__ __forceinline__ float swap32_sum(float a, float b) { const auto r = __builtin_amdgcn_permlane32_swap(__float_as_int(a), __float_as_int(b), false, false); return __int_as_float(r[0]) + __int_as_float(r[1]); }
__device__ __forceinline__ float swap16_sum(float a, float b) { const auto r = __builtin_amdgcn_permlane16_swap(__float_as_int(a), __float_as_int(b), false, false); return __int_as_float(r[0]) + __int_as_float(r[1]); }
__device__ __forceinline__ float dpp_xor8(float x) { return __int_as_float(__builtin_amdgcn_update_dpp(0, __float_as_int(x), 0x128, 0xf, 0xf, false)); }
__device__ __forceinline__ float dpp_xor4(float x) { return __int_as_float(__builtin_amdgcn_update_dpp(0, __builtin_amdgcn_update_dpp(0, __float_as_int(x), 0x141, 0xf, 0xf, false), 0x1B, 0xf, 0xf, false)); }
__device__ __forceinline__ float dpp_xor2(float x) { return __int_as_float(__builtin_amdgcn_update_dpp(0, __float_as_int(x), 0x4E, 0xf, 0xf, false)); }
__device__ __forceinline__ float dpp_xor1(float x) { return __int_as_float(__builtin_amdgcn_update_dpp(0, __float_as_int(x), 0xB1, 0xf, 0xf, false)); }

__global__ void __launch_bounds__(NWAVES * 64, 2) skel_fwd(Args args) {
    extern __shared__ __attribute__((aligned(16))) unsigned char lds[];
    Frame F;
    F.lds = (LAS unsigned char*)lds;
    F.tid = threadIdx.x; F.lane = F.tid & 63; F.wave = __builtin_amdgcn_readfirstlane(F.tid >> 6);
    F.G = gridDim.x; { const int bx = blockIdx.x; F.vcu = (F.G % 8 == 0) ? (bx % 8) * (F.G / 8) + bx / 8 : bx; }
    unsigned char* ws = args.ws;
    volatile LAS unsigned* MISC = (volatile LAS unsigned*)(F.lds + MISC_OFF);
    for (int u = F.tid; u < (LDS_BYTES - LDSCTL_OFF) / 4; u += NWAVES * 64) ((LAS unsigned*)(F.lds + LDSCTL_OFF))[u] = 0u;
    __syncthreads();
    XcdBarrier bar; bar.bar = (unsigned*)(ws + WS_CTL) + CW_BAR; bar.x = 0; bar.st = nullptr;
    if (N_LAUNCHES == 1) bar = xcd_barrier_post((unsigned*)(ws + WS_CTL) + CW_BAR, MISC + 8);
    if (N_LAUNCHES == 1 && F.tid == 0) { MISC[10] = xb_add((unsigned*)(ws + WS_CTL) + CW_XRANK + 64 * bar.x, 1u); }
    const int lo = args.ph_lo, hi = args.ph_hi;
#define IN(k) (lo <= (k) && (k) < hi)
#define SEAM(k) do { if (IN(k) && IN((k) + 1)) xcd_barrier(bar); } while (0)

    const float* x = args.in[0]; const float* p = args.in[1]; const float* w_in = args.in[2]; const float* lb_param = args.in[3];
    const float* hg_norm_g = args.in[4]; const float* conv_w = args.in[5]; const float* conv_b = args.in[6];
    const float* w_a = args.in[7]; const float* w_b = args.in[8]; const float* w_out = args.in[9];
    const float* ln1_g = args.in[10]; const float* ln1_b = args.in[11]; const float* pk_wq = args.in[12]; const float* pk_sk = args.in[13];
    const float* pk_u = args.in[14]; const float* pk_v = args.in[15]; const float* ln2_g = args.in[16]; const float* ln2_b = args.in[17];
    const float* w_pg = args.in[18]; const float* w_pp = args.in[19];
    float* out = args.out;
    bf16* WinT = (bf16*)(ws + WS_WIN); bf16* WaT = (bf16*)(ws + WS_WA); bf16* WbT = (bf16*)(ws + WS_WB); bf16* WoT = (bf16*)(ws + WS_WO);
    bf16* WpgT = (bf16*)(ws + WS_WPG); bf16* WqT = (bf16*)(ws + WS_WQ); bf16* SKB = (bf16*)(ws + WS_SK); bf16* WppT = (bf16*)(ws + WS_WPP);
    bf16* XB = (bf16*)(ws + WS_XB); bf16* PB = (bf16*)(ws + WS_PB);
    bf16* Zhg = (bf16*)(ws + WS_BIG); bf16* Zc = (bf16*)(ws + WS_ZC); bf16* Zg = (bf16*)(ws + WS_ZG);
    unsigned char* UF8 = (unsigned char*)out; unsigned char* VF8 = (unsigned char*)out + (size_t)16384 * D;
    bf16* ST = (bf16*)out;
    bf16* VT = (bf16*)(ws + WS_VT); bf16* KET = (bf16*)(ws + WS_KET); float* DEC = (float*)(ws + WS_DEC); bf16* ON = (bf16*)(ws + WS_OA);
    bf16* OA = (bf16*)(ws + WS_OA); bf16* YC = (bf16*)(ws + WS_YC);
    float* TMP = (float*)(ws + WS_ZC);
    bf16* MERGED = (bf16*)(ws + WS_OA);
    float* Y = (float*)(ws + WS_Y); float* X1 = (float*)(ws + WS_X1); bf16* X1B = (bf16*)(ws + WS_X1B);
    bf16* QP = (bf16*)(ws + WS_QP); bf16* PP = (bf16*)(ws + WS_OA);
    int* IDS = (int*)(ws + WS_IDS); float* GW = (float*)(ws + WS_GW);
    bf16* X2B = (bf16*)(ws + WS_X2B); bf16* YB = (bf16*)(ws + WS_YB); float* WGT = (float*)(ws + WS_WGT); float* STATS = (float*)(ws + WS_STATS);

    const int gtid = F.vcu * (NWAVES * 64) + F.tid, NT = F.G * NWAVES * 64;
    const int gw = F.vcu * NWAVES + F.wave, NGW = F.G * NWAVES;

    if (IN(0)) {
        LAS float* scr = (LAS float*)(F.lds + F.wave * 16384);
        constexpr int I_IN = (D / 64) * (PROJ_W / 32), I_SQ = (D / 64) * (D / 32), I_Q = (D / 64) * (2048 / 32), I_PP = (PLE / 64) * (D / 32);
        constexpr int NITEMS = I_IN + 4 * I_SQ + I_Q + I_PP;
        for (int it = gw; it < NITEMS; it += NGW) {
            int r = it;
            if (r < I_IN) { p0_transpose_item(w_in, D, PROJ_W, WinT, scr, r, F.lane); continue; } r -= I_IN;
            if (r < I_SQ) { p0_transpose_item(w_a, D, D, WaT, scr, r, F.lane); continue; } r -= I_SQ;
            if (r < I_SQ) { p0_transpose_item(w_b, D, D, WbT, scr, r, F.lane); continue; } r -= I_SQ;
            if (r < I_SQ) { p0_transpose_item(w_out, D, D, WoT, scr, r, F.lane); continue; } r -= I_SQ;
            if (r < I_SQ) { p0_transpose_item(w_pg, D, D, WpgT, scr, r, F.lane); continue; } r -= I_SQ;
            if (r < I_Q) { p0_transpose_item(pk_wq, D, 2048, WqT, scr, r, F.lane); continue; } r -= I_Q;
            p0_transpose_item(w_pp, PLE, D, WppT, scr, r, F.lane);
        }
        convert_rows(x, XB, (size_t)T * D, gtid, NT);
        convert_rows(p, PB, (size_t)T * PLE, gtid, NT);
        convert_rows(pk_sk, SKB, (size_t)PKH * 2 * NKEYS * 128, gtid, NT);
    }
    SEAM(0);
    if (IN(1)) { EpiStore E{Zhg, 3072}; run_gemm(F, XB, WinT, T, 3072, D, E); }
    SEAM(1);
    if (IN(2)) {
        LAS float* tot = (LAS float*)F.lds;
        for (int unit = F.vcu; unit < 2048; unit += F.G) {
            const int n = unit >> 3, h = unit & 7, row0 = n * 64;
            const int c = F.tid & 127, sgm = F.tid >> 7, ch = h * 128 + c;
            const float lb = 1.0f / (1.0f + expf(lb_param[1024 + ch] - lb_param[ch]));
            float lf[16], kk[16];
            float run = 0.f;
#pragma unroll
            for (int i = 0; i < 16; ++i) { const size_t tok = (size_t)row0 + sgm * 16 + i;
                const float fz = bf2f(Zhg[tok * 3072 + 1024 + ch]); const float sg = 1.0f / (1.0f + expf(-fz));
                const float f = lb + (1.0f - lb) * sg; kk[i] = (1.0f - lb) * (1.0f - sg); run += logf(f); lf[i] = run; }
            tot[sgm * 128 + c] = run;
            __syncthreads();
            float off = 0.f, total = 0.f;
#pragma unroll
            for (int s2 = 0; s2 < 4; ++s2) { const float tv = tot[s2 * 128 + c]; total += tv; if (s2 < sgm) off += tv; }
            __syncthreads();
            float kev[16], vv[16];
#pragma unroll
            for (int i = 0; i < 16; ++i) { const size_t tok = (size_t)row0 + sgm * 16 + i; const float bc = lf[i] + off;
                const float q = bf2f(Zhg[tok * 3072 + ch]) * 0.08838834764831845f;
                const float qe = q * expf(bc), ke = kk[i] * expf(-bc);
                vv[i] = bf2f(Zhg[tok * 3072 + 2048 + ch]);
                Zhg[tok * 3072 + ch] = (bf16)f2bf(qe); Zhg[tok * 3072 + 1024 + ch] = (bf16)f2bf(ke); kev[i] = ke; }
            { float t0[8], t1[8];
#pragma unroll
              for (int i = 0; i < 8; ++i) { t0[i] = kev[i]; t1[i] = kev[8 + i]; }
              bf16* dst = KET + ((size_t)unit * 128 + c) * 64 + sgm * 16; *(v4u*)dst = pack8(t0); *(v4u*)(dst + 8) = pack8(t1);
#pragma unroll
              for (int i = 0; i < 8; ++i) { t0[i] = vv[i]; t1[i] = vv[8 + i]; }
              dst = VT + ((size_t)unit * 128 + c) * 64 + sgm * 16; *(v4u*)dst = pack8(t0); *(v4u*)(dst + 8) = pack8(t1); }
            if (sgm == 0) DEC[(size_t)n * 1024 + ch] = expf(total);
        }
    }
    SEAM(2);
    if (IN(3)) {
        const int q4 = F.lane >> 4, l15 = F.lane & 15;
        for (int unit = gw; unit < 2048; unit += NGW) {
            const int n = unit >> 3, h = unit & 7;
            const bf16* ket = KET + (size_t)unit * 128 * 64; const bf16* vt = VT + (size_t)unit * 128 * 64;
            bf16x8 a[8][2];
#pragma unroll
            for (int t = 0; t < 8; ++t)
#pragma unroll
                for (int s2 = 0; s2 < 2; ++s2) a[t][s2] = *(const bf16x8*)(ket + (16 * t + l15) * 64 + 32 * s2 + 8 * q4);
            f32x4 dc[8];
#pragma unroll
            for (int t = 0; t < 8; ++t) dc[t] = *(const f32x4*)(DEC + (size_t)n * 1024 + h * 128 + 16 * t + 4 * q4);
            for (int qd = 0; qd < 4; ++qd) {
                bf16x8 b[2][2];
#pragma unroll
                for (int cc = 0; cc < 2; ++cc)
#pragma unroll
                    for (int s2 = 0; s2 < 2; ++s2) b[cc][s2] = *(const bf16x8*)(vt + (32 * qd + 16 * cc + l15) * 64 + 32 * s2 + 8 * q4);
#pragma unroll
                for (int t = 0; t < 8; ++t)
#pragma unroll
                    for (int cc = 0; cc < 2; ++cc) {
                        f32x4 acc = (f32x4){0.f, 0.f, 0.f, 0.f};
                        acc = __builtin_amdgcn_mfma_f32_16x16x32_bf16(a[t][0], b[cc][0], acc, 0, 0, 0);
                        acc = __builtin_amdgcn_mfma_f32_16x16x32_bf16(a[t][1], b[cc][1], acc, 0, 0, 0);
                        acc = acc * dc[t];
                        const int dv = 32 * qd + 16 * cc + l15;
                        unsigned long long w = (unsigned long long)pk2(acc[0], acc[1]) | ((unsigned long long)pk2(acc[2], acc[3]) << 32);
                        *(unsigned long long*)(ST + ((size_t)unit * 128 + dv) * 128 + 16 * t + 4 * q4) = w;
                    }
            }
        }
    }
    SEAM(3);
    if (IN(4)) {
        for (int i = gtid; i < 65536; i += NT) {
            const int dk4 = i & 31, dv = (i >> 5) & 127, h = (i >> 12) & 7, b = i >> 15;
            f32x4 st = (f32x4){0.f, 0.f, 0.f, 0.f};
#pragma unroll 8
            for (int cn = 0; cn < 128; ++cn) {
                const int n = b * 128 + cn; const size_t unit = (size_t)n * 8 + h;
                unsigned long long* ptr = (unsigned long long*)(ST + (unit * 128 + dv) * 128 + dk4 * 4);
                const unsigned long long d = *ptr;
                const f32x4 dc = *(const f32x4*)(DEC + (size_t)n * 1024 + h * 128 + dk4 * 4);
                *ptr = (unsigned long long)pk2(st[0], st[1]) | ((unsigned long long)pk2(st[2], st[3]) << 32);
                const f32x4 dd = (f32x4){bflo((unsigned)d), bfhi((unsigned)d), bflo((unsigned)(d >> 32)), bfhi((unsigned)(d >> 32))};
                st = dc * st + dd;
            }
        }
    }
    SEAM(4);
    if (IN(5)) {
        const int q4 = F.lane >> 4, l15 = F.lane & 15;
        LAS bf16* Pl = (LAS bf16*)(F.lds + F.wave * 8192);
        for (int unit = gw; unit < 2048; unit += NGW) {
            const int n = unit >> 3, h = unit & 7, row0 = n * 64;
            const bf16* st = ST + (size_t)unit * 128 * 128; const bf16* vt = VT + (size_t)unit * 128 * 64;
            for (int half = 0; half < 2; ++half) {
                const int i0 = half * 32;
                bf16x8 qf[2][4];
#pragma unroll
                for (int it = 0; it < 2; ++it)
#pragma unroll
                    for (int ks = 0; ks < 4; ++ks) qf[it][ks] = *(const bf16x8*)(Zhg + (size_t)(row0 + i0 + 16 * it + l15) * 3072 + h * 128 + 32 * ks + 8 * q4);
                f32x4 acc[8][2];
#pragma unroll
                for (int dvt = 0; dvt < 8; ++dvt) { acc[dvt][0] = (f32x4){0.f, 0.f, 0.f, 0.f}; acc[dvt][1] = (f32x4){0.f, 0.f, 0.f, 0.f}; }
#pragma unroll
                for (int dvt = 0; dvt < 8; ++dvt)
#pragma unroll
                    for (int ks = 0; ks < 4; ++ks) { const bf16x8 a = *(const bf16x8*)(st + (16 * dvt + l15) * 128 + 32 * ks + 8 * q4);
                        acc[dvt][0] = __builtin_amdgcn_mfma_f32_16x16x32_bf16(a, qf[0][ks], acc[dvt][0], 0, 0, 0);
                        acc[dvt][1] = __builtin_amdgcn_mfma_f32_16x16x32_bf16(a, qf[1][ks], acc[dvt][1], 0, 0, 0); }
                const int njt = 2 * (half + 1);
                for (int jt = 0; jt < njt; ++jt) {
                    f32x4 p0 = (f32x4){0.f, 0.f, 0.f, 0.f}, p1 = (f32x4){0.f, 0.f, 0.f, 0.f};
#pragma unroll
                    for (int ks = 0; ks < 4; ++ks) { const bf16x8 a = *(const bf16x8*)(Zhg + (size_t)(row0 + 16 * jt + l15) * 3072 + 1024 + h * 128 + 32 * ks + 8 * q4);
                        p0 = __builtin_amdgcn_mfma_f32_16x16x32_bf16(a, qf[0][ks], p0, 0, 0, 0);
                        p1 = __builtin_amdgcn_mfma_f32_16x16x32_bf16(a, qf[1][ks], p1, 0, 0, 0); }
                    const int jb = 16 * jt + 4 * q4;
                    { const int ii = i0 + l15;
                      const float m0 = (jb + 0 <= ii) ? p0[0] : 0.f, m1 = (jb + 1 <= ii) ? p0[1] : 0.f, m2 = (jb + 2 <= ii) ? p0[2] : 0.f, m3 = (jb + 3 <= ii) ? p0[3] : 0.f;
                      *(LAS unsigned long long*)(Pl + l15 * 72 + jb) = (unsigned long long)pk2(m0, m1) | ((unsigned long long)pk2(m2, m3) << 32); }
                    { const int ii = i0 + 16 + l15;
                      const float m0 = (jb + 0 <= ii) ? p1[0] : 0.f, m1 = (jb + 1 <= ii) ? p1[1] : 0.f, m2 = (jb + 2 <= ii) ? p1[2] : 0.f, m3 = (jb + 3 <= ii) ? p1[3] : 0.f;
                      *(LAS unsigned long long*)(Pl + (16 + l15) * 72 + jb) = (unsigned long long)pk2(m0, m1) | ((unsigned long long)pk2(m2, m3) << 32); }
                }
                LDS_WAIT(); asm volatile("" ::: "memory");
                const int nks = half + 1;
                for (int kj = 0; kj < nks; ++kj) {
                    const bf16x8 b0 = *(const LAS bf16x8*)(Pl + l15 * 72 + 32 * kj + 8 * q4), b1 = *(const LAS bf16x8*)(Pl + (16 + l15) * 72 + 32 * kj + 8 * q4);
#pragma unroll
                    for (int dvt = 0; dvt < 8; ++dvt) { const bf16x8 a = *(const bf16x8*)(vt + (16 * dvt + l15) * 64 + 32 * kj + 8 * q4);
                        acc[dvt][0] = __builtin_amdgcn_mfma_f32_16x16x32_bf16(a, b0, acc[dvt][0], 0, 0, 0);
                        acc[dvt][1] = __builtin_amdgcn_mfma_f32_16x16x32_bf16(a, b1, acc[dvt][1], 0, 0, 0); }
                }
#pragma unroll
                for (int it = 0; it < 2; ++it) {
                    float ss = 0.f;
#pragma unroll
                    for (int dvt = 0; dvt < 8; ++dvt) { const f32x4 v = acc[dvt][it]; ss += (v[0] * v[0] + v[1] * v[1]) + (v[2] * v[2] + v[3] * v[3]); }
                    ss += __shfl_xor(ss, 16); ss += __shfl_xor(ss, 32);
                    const float rinv = 1.0f / sqrtf(ss * (1.0f / 128.0f) + RMS_EPS);
                    const size_t tok = (size_t)row0 + i0 + 16 * it + l15;
#pragma unroll
                    for (int dvt = 0; dvt < 8; ++dvt) { const f32x4 g4 = *(const f32x4*)(hg_norm_g + h * 128 + 16 * dvt + 4 * q4); const f32x4 o = acc[dvt][it] * rinv * g4;
                        *(unsigned long long*)(ON + tok * D + h * 128 + 16 * dvt + 4 * q4) = (unsigned long long)pk2(o[0], o[1]) | ((unsigned long long)pk2(o[2], o[3]) << 32); }
                }
                LDS_WAIT(); asm volatile("" ::: "memory");
            }
        }
    }
    SEAM(5);
    if (IN(6)) { EpiZ2 E{ON, Zc, Zg}; run_gemm(F, XB, WinT + (size_t)3072 * D, T, 6144, D, E); }
    SEAM(6);
    if (IN(7)) {
        for (int i = gtid; i < T * (D / 8); i += NT) {
            const int row = i / (D / 8), c0 = (i % (D / 8)) * 8, t = row % SEQ;
            float cb[8], u0[8], u1[8], u2[8], a[8], b[8];
            unpack8(*(const v4u*)(Zc + (size_t)row * 3072 + c0), cb);
            unpack8(*(const v4u*)(Zc + (size_t)row * 3072 + 1024 + c0), a); unpack8(*(const v4u*)(Zc + (size_t)row * 3072 + 2048 + c0), b);
#pragma unroll
            for (int j = 0; j < 8; ++j) u2[j] = a[j] * b[j];
            if (t >= 1) { unpack8(*(const v4u*)(Zc + (size_t)(row - 1) * 3072 + 1024 + c0), a); unpack8(*(const v4u*)(Zc + (size_t)(row - 1) * 3072 + 2048 + c0), b);
#pragma unroll
                for (int j = 0; j < 8; ++j) u1[j] = a[j] * b[j]; }
            else {
#pragma unroll
                for (int j = 0; j < 8; ++j) u1[j] = 0.f; }
            if (t >= 2) { unpack8(*(const v4u*)(Zc + (size_t)(row - 2) * 3072 + 1024 + c0), a); unpack8(*(const v4u*)(Zc + (size_t)(row - 2) * 3072 + 2048 + c0), b);
#pragma unroll
                for (int j = 0; j < 8; ++j) u0[j] = a[j] * b[j]; }
            else {
#pragma unroll
                for (int j = 0; j < 8; ++j) u0[j] = 0.f; }
            float y[8];
#pragma unroll
            for (int j = 0; j < 8; ++j) { const int c = c0 + j; y[j] = cb[j] * (conv_b[c] + conv_w[c] * u0[j] + conv_w[1024 + c] * u1[j] + conv_w[2048 + c] * u2[j]); }
            *(v4u*)(YC + (size_t)row * D + c0) = pack8(y);
        }
        convert_fp8(pk_u, UF8, (size_t)16384 * D, 32.0f, gtid, NT);
        convert_fp8(pk_v, VF8, (size_t)16384 * D, 1.0f, gtid, NT);
    }
    SEAM(7);
    if (IN(8)) { EpiGateA E{TMP, Zg}; run_gemm(F, OA, WaT, T, D, D, E); }
    SEAM(8);
    if (IN(9)) { EpiGateB E{TMP, Zg, MERGED}; run_gemm(F, YC, WbT, T, D, D, E); }
    SEAM(9);
    if (IN(10)) { EpiResid E{x, Y}; run_gemm(F, MERGED, WoT, T, D, D, E); }
    SEAM(10);
    if (IN(11)) {
        for (int row = gw; row < T; row += NGW) {
            f32x4 v[4];
#pragma unroll
            for (int j = 0; j < 4; ++j) v[j] = *(const f32x4*)(Y + (size_t)row * D + 4 * F.lane + 256 * j);
            ln_row_store(v, ln1_g, ln1_b, X1 + (size_t)row * D, X1B + (size_t)row * D, F.lane);
        }
    }
    SEAM(11);
    if (IN(12)) {
        { EpiStore E{QP, 2048}; run_gemm(F, X1B, WqT, T, 2048, D, E); }
        { EpiStore E{PP, D}; run_gemm(F, PB, WppT, T, D, PLE, E); }
    }
    SEAM(12);
    if (IN(13)) {
        const int lane = F.lane, r31 = lane & 31, hh = lane >> 5;
        LAS unsigned* ib = (LAS unsigned*)(F.lds + F.wave * 4096) + lane * 8;
        const float NEGV = -3.0e38f;
#define TK_INS(L, xx) do { const float x_ = (xx); _Pragma("unroll") for (int i_ = 15; i_ >= 1; --i_) L[i_] = __builtin_amdgcn_fmed3f(L[i_ - 1], L[i_], x_); L[0] = fmaxf(L[0], x_); } while (0)
        for (int task = gw; task < (T / 32) * PKH; task += NGW) {
            const int tg = task >> 3, h = task & 7; const size_t t = (size_t)tg * 32 + r31;
            float L1[16], L2[16];
#pragma unroll
            for (int p2 = 0; p2 < 2; ++p2) {
                float L[16];
#pragma unroll
                for (int i = 0; i < 16; ++i) L[i] = NEGV;
                bf16x8 bq[8];
#pragma unroll
                for (int ks = 0; ks < 8; ++ks) bq[ks] = *(const bf16x8*)(QP + t * 2048 + h * 256 + p2 * 128 + 16 * ks + 8 * hh);
#pragma unroll
                for (int kt = 0; kt < 4; ++kt) {
                    f32x16 acc;
#pragma unroll
                    for (int i = 0; i < 16; ++i) acc[i] = 0.f;
                    const bf16* krow = SKB + ((size_t)((h * 2 + p2) * 128 + 32 * kt + r31)) * 128 + 8 * hh;
#pragma unroll
                    for (int ks = 0; ks < 8; ++ks) { const bf16x8 a = *(const bf16x8*)(krow + 16 * ks); acc = __builtin_amdgcn_mfma_f32_32x32x16_bf16(a, bq[ks], acc, 0, 0, 0); }
#pragma unroll
                    for (int rg = 0; rg < 16; ++rg) { const float xv = acc[rg]; const int idxc = 32 * kt + (rg & 3) + 8 * (rg >> 2);
                        const float xp = __int_as_float((__float_as_int(xv) & ~0x7F) | idxc); TK_INS(L, xp); }
                }
                float P[16];
#pragma unroll
                for (int i = 0; i < 16; ++i) { L[i] = __int_as_float(__float_as_int(L[i]) | (4 * hh)); P[i] = __shfl_xor(L[i], 32); }
#pragma unroll
                for (int i = 0; i < 16; ++i) TK_INS(L, P[i]);
#pragma unroll
                for (int i = 0; i < 16; ++i) { if (p2 == 0) L1[i] = L[i]; else L2[i] = L[i]; }
            }
            unsigned ix1[16], ix2[16];
#pragma unroll
            for (int i = 0; i < 16; ++i) { ix1[i] = (unsigned)__float_as_int(L1[i]) & 0x7Fu; ix2[i] = (unsigned)__float_as_int(L2[i]) & 0x7Fu;
                L1[i] = __int_as_float(__float_as_int(L1[i]) & ~0x7F); L2[i] = __int_as_float(__float_as_int(L2[i]) & ~0x7F); }
#pragma unroll
            for (int i = 0; i < 4; ++i) { ib[i] = ix1[4 * i] | (ix1[4 * i + 1] << 8) | (ix1[4 * i + 2] << 16) | (ix1[4 * i + 3] << 24);
                                          ib[4 + i] = ix2[4 * i] | (ix2[4 * i + 1] << 8) | (ix2[4 * i + 2] << 16) | (ix2[4 * i + 3] << 24); }
            float W[16];
#pragma unroll
            for (int i = 0; i < 16; ++i) W[i] = NEGV;
#pragma unroll
            for (int a = 0; a < 16; ++a)
#pragma unroll
                for (int b = 0; b < 16; ++b)
                    if ((a + 1) * (b + 1) <= 16) { const float c = L1[a] + L2[b]; const float cp = __int_as_float((__float_as_int(c) & ~0xFF) | (a * 16 + b)); TK_INS(W, cp); }
            LDS_WAIT(); asm volatile("" ::: "memory");
            const LAS unsigned char* ibb = (const LAS unsigned char*)ib;
            int eid[16]; float ev[16];
#pragma unroll
            for (int k = 0; k < 16; ++k) { const int bits = __float_as_int(W[k]); const int a = (bits >> 4) & 15, b = bits & 15;
                eid[k] = (int)ibb[a] * 128 + (int)ibb[16 + b]; ev[k] = __int_as_float(bits & ~0xFF); }
            float sum = 0.f; const float mx = ev[0];
#pragma unroll
            for (int k = 0; k < 16; ++k) { ev[k] = expf(ev[k] - mx); sum += ev[k]; }
            const float inv = 1.0f / sum;
            if (hh == 0) {
#pragma unroll
                for (int k4 = 0; k4 < 4; ++k4) {
                    *(v4u*)(IDS + t * 128 + h * 16 + 4 * k4) = (v4u){(unsigned)eid[4 * k4], (unsigned)eid[4 * k4 + 1], (unsigned)eid[4 * k4 + 2], (unsigned)eid[4 * k4 + 3]};
                    *(f32x4*)(GW + t * 128 + h * 16 + 4 * k4) = (f32x4){ev[4 * k4] * inv, ev[4 * k4 + 1] * inv, ev[4 * k4 + 2] * inv, ev[4 * k4 + 3] * inv}; }
            }
            LDS_WAIT(); asm volatile("" ::: "memory");
        }
#undef TK_INS
    }
    SEAM(13);
    int gper = F.G, gfirst = 0, gstep = 1, grank = F.vcu;
    if (N_LAUNCHES == 1 && (IN(14) || IN(15))) {
        if (F.tid == 0) { unsigned* bw = (unsigned*)(ws + WS_CTL) + CW_BAR; unsigned nx = 0, gi = 0, mine = 1;
            for (unsigned j = 0; j < 16; ++j) { const unsigned c = xb_ld(&bw[XB_XCNT(j)]); if (c) { if (j < bar.x) ++gi; ++nx; } if (j == bar.x) mine = c ? c : 1u; }
            MISC[11] = mine; MISC[12] = gi; MISC[13] = nx ? nx : 1u; }
        __syncthreads();
        gper = (int)MISC[11]; gfirst = (int)MISC[12]; gstep = (int)MISC[13]; grank = (int)MISC[10];
    }
    if (IN(14)) {
        const int lane = F.lane;
        LAS unsigned char* wl = F.lds + F.wave * 17920;
        LAS unsigned char* xs8 = wl;
        LAS unsigned* ent = (LAS unsigned*)(wl + 8192);
        LAS float* entg = (LAS float*)(wl + 8192 + 4096);
        const bool isdiag = (lane >> 4) == ((lane >> 2) & 3);
        const float dm0 = (isdiag && (lane & 3) == 0) ? 1.f : 0.f, dm1 = (isdiag && (lane & 3) == 1) ? 1.f : 0.f, dm2 = (isdiag && (lane & 3) == 2) ? 1.f : 0.f, dm3 = (isdiag && (lane & 3) == 3) ? 1.f : 0.f;
        const bool h32 = (lane & 32) != 0, h16 = (lane & 16) != 0, h8 = (lane & 8) != 0, h4 = (lane & 4) != 0;
        for (int sl = gfirst; sl < 8; sl += gstep)
        for (int tg = grank * NWAVES + F.wave; tg < T / 8; tg += gper * NWAVES) {
            const size_t tb = (size_t)tg * 8;
            v4u idv[4]; f32x4 gv[4];
#pragma unroll
            for (int j = 0; j < 4; ++j) { idv[j] = *(const v4u*)(IDS + tb * 128 + lane * 4 + 256 * j); gv[j] = *(const f32x4*)(GW + tb * 128 + lane * 4 + 256 * j); }
#pragma unroll
            for (int ih = 0; ih < 2; ++ih) {
                v4u xr[4][2];
#pragma unroll
                for (int i = 0; i < 4; ++i) { xr[i][0] = *(const v4u*)(X1B + (tb + 4 * ih + i) * D + lane * 16); xr[i][1] = *(const v4u*)(X1B + (tb + 4 * ih + i) * D + lane * 16 + 8); }
#pragma unroll
                for (int i = 0; i < 4; ++i) { float xa[8], xb[8]; unpack8(xr[i][0], xa); unpack8(xr[i][1], xb);
                    v4u o; int w = 0;
                    w = __builtin_amdgcn_cvt_pk_fp8_f32(xa[0], xa[1], w, false); w = __builtin_amdgcn_cvt_pk_fp8_f32(xa[2], xa[3], w, true); o.x = (unsigned)w;
                    w = __builtin_amdgcn_cvt_pk_fp8_f32(xa[4], xa[5], w, false); w = __builtin_amdgcn_cvt_pk_fp8_f32(xa[6], xa[7], w, true); o.y = (unsigned)w;
                    w = __builtin_amdgcn_cvt_pk_fp8_f32(xb[0], xb[1], w, false); w = __builtin_amdgcn_cvt_pk_fp8_f32(xb[2], xb[3], w, true); o.z = (unsigned)w;
                    w = __builtin_amdgcn_cvt_pk_fp8_f32(xb[4], xb[5], w, false); w = __builtin_amdgcn_cvt_pk_fp8_f32(xb[6], xb[7], w, true); o.w = (unsigned)w;
                    *(LAS v4u*)(xs8 + (4 * ih + i) * 1024 + lane * 16) = o; }
                asm volatile("" ::: "memory");
            }
            int cnt = 0;
#pragma unroll
            for (int j = 0; j < 4; ++j)
#pragma unroll
                for (int c = 0; c < 4; ++c) { const unsigned id = idv[j][c]; const bool hit = (int)(id >> 11) == sl; const unsigned long long m = __ballot(hit);
                    const int r = cnt + (int)__builtin_amdgcn_mbcnt_hi((unsigned)(m >> 32), __builtin_amdgcn_mbcnt_lo((unsigned)m, 0u));
                    if (hit) { ent[r] = id | ((unsigned)((lane & 31) * 4 + c) << 14) | ((unsigned)(2 * j + (lane >> 5)) << 21); entg[r] = gv[j][c]; }
                    cnt += __popcll(m); }
            LDS_WAIT(); asm volatile("" ::: "memory");
#define U_LOAD(EN, AV, BASE) do { _Pragma("unroll") for (int i = 0; i < 16; ++i) { const int row_ = ((BASE) + i < cnt) ? (BASE) + i : cnt - 1; EN[i] = (unsigned)__builtin_amdgcn_readfirstlane((int)ent[row_]); \
                AV[i] = *(const v4u*)(UF8 + (size_t)(EN[i] & 0x3fffu) * D + lane * 16); } } while (0)
#define U_COMPUTE(EN, AV, BASE) do { float dd[16]; \
                _Pragma("unroll") for (int i = 0; i < 16; ++i) { \
                    const v4u bv = *(const LAS v4u*)(xs8 + (EN[i] >> 21) * 1024 + lane * 16); \
                    f32x4 acc = (f32x4){0.f, 0.f, 0.f, 0.f}; \
                    acc = __builtin_amdgcn_mfma_f32_16x16x32_fp8_fp8((long)(((unsigned long long)AV[i].y << 32) | AV[i].x), (long)(((unsigned long long)bv.y << 32) | bv.x), acc, 0, 0, 0); \
                    acc = __builtin_amdgcn_mfma_f32_16x16x32_fp8_fp8((long)(((unsigned long long)AV[i].w << 32) | AV[i].z), (long)(((unsigned long long)bv.w << 32) | bv.z), acc, 0, 0, 0); \
                    dd[i] = (dm0 * acc[0] + dm1 * acc[1]) + (dm2 * acc[2] + dm3 * acc[3]); } \
                float v8[8], v4[4], v2[2]; \
                _Pragma("unroll") for (int i = 0; i < 8; ++i) v8[i] = swap32_sum(dd[i], dd[8 + i]); \
                _Pragma("unroll") for (int i = 0; i < 4; ++i) v4[i] = swap16_sum(v8[i], v8[4 + i]); \
                _Pragma("unroll") for (int i = 0; i < 2; ++i) v2[i] = (h8 ? v4[2 + i] : v4[i]) + dpp_xor8(h8 ? v4[i] : v4[2 + i]); \
                float tot = (h4 ? v2[1] : v2[0]) + dpp_xor4(h4 ? v2[0] : v2[1]); \
                tot += dpp_xor2(tot); tot += dpp_xor1(tot); \
                const int row = (BASE) + ((lane >> 2) & 15); \
                if ((lane & 3) == 0 && row < cnt) { const unsigned e2 = ent[row]; \
                    WGT[(tb + (e2 >> 21)) * 128 + ((e2 >> 14) & 127u)] = entg[row] * gelu_fast(tot * 0.03125f); } } while (0)
            if (cnt > 0) { unsigned enA[16], enB[16]; v4u avA[16], avB[16];
              U_LOAD(enA, avA, 0);
              for (int base = 0; base < cnt; base += 32) {
                  U_LOAD(enB, avB, base + 16);
                  __builtin_amdgcn_sched_barrier(0);
                  U_COMPUTE(enA, avA, base);
                  __builtin_amdgcn_sched_barrier(0);
                  U_LOAD(enA, avA, base + 32);
                  __builtin_amdgcn_sched_barrier(0);
                  U_COMPUTE(enB, avB, base + 16);
                  __builtin_amdgcn_sched_barrier(0);
              } }
#undef U_LOAD
#undef U_COMPUTE
            LDS_WAIT(); asm volatile("" ::: "memory");
        }
    }
    SEAM(14);
    if (IN(15)) {
        const int lane = F.lane, rg = lane >> 3, c8 = lane & 7;
        LAS unsigned long long* pr = (LAS unsigned long long*)(F.lds + F.wave * 17920);
        for (int cs = gfirst; cs < 8; cs += gstep)
        for (int tg = grank * NWAVES + F.wave; tg < T / 8; tg += gper * NWAVES) {
            const size_t tb = (size_t)tg * 8;
#pragma unroll
            for (int j = 0; j < 4; ++j) { const v4u idv = *(const v4u*)(IDS + tb * 128 + lane * 4 + 256 * j); const f32x4 wv = *(const f32x4*)(WGT + tb * 128 + lane * 4 + 256 * j);
#pragma unroll
                for (int c = 0; c < 4; ++c) pr[lane * 4 + 256 * j + c] = ((unsigned long long)(unsigned)__float_as_int(wv[c]) << 32) | idv[c]; }
            const size_t t = tb + rg;
            const v4u xv0 = *(const v4u*)(X1B + t * D + cs * 128 + c8 * 16), xv1 = *(const v4u*)(X1B + t * D + cs * 128 + c8 * 16 + 8);
            LDS_WAIT(); asm volatile("" ::: "memory");
            f32x2 acc2[8];
#pragma unroll
            for (int j = 0; j < 8; ++j) acc2[j] = (f32x2){0.f, 0.f};
            const LAS unsigned* prt = (const LAS unsigned*)(pr + rg * 128);
            const unsigned voff = (unsigned)(cs * 128 + c8 * 16);
            for (int it0 = 0; it0 < 128; it0 += 16) {
                v4u vv[16];
#pragma unroll
                for (int k = 0; k < 16; ++k) vv[k] = *(const v4u*)(VF8 + (unsigned)((prt[2 * (it0 + k)] << 10) + voff));
#pragma unroll
                for (int k = 0; k < 16; ++k) { const float w = __int_as_float((int)prt[2 * (it0 + k) + 1]);
#pragma unroll
                    for (int j = 0; j < 4; ++j) { const int wd = (int)vv[k][j];
                        acc2[2 * j] += __builtin_amdgcn_cvt_pk_f32_fp8(wd, false) * w; acc2[2 * j + 1] += __builtin_amdgcn_cvt_pk_f32_fp8(wd, true) * w; } }
            }
            float acc[16];
#pragma unroll
            for (int j = 0; j < 8; ++j) { acc[2 * j] = acc2[j].x; acc[2 * j + 1] = acc2[j].y; }
            { float x0[8], x1v[8]; unpack8(xv0, x0); unpack8(xv1, x1v);
#pragma unroll
              for (int j = 0; j < 8; ++j) { acc[j] += ALPHA * x0[j]; acc[8 + j] += ALPHA * x1v[j]; } }
            float s1 = 0.f, s2 = 0.f;
#pragma unroll
            for (int j = 0; j < 16; ++j) { s1 += acc[j]; s2 += acc[j] * acc[j]; }
            { float r0[8], r1[8];
#pragma unroll
              for (int j = 0; j < 8; ++j) { r0[j] = acc[j]; r1[j] = acc[8 + j]; }
              bf16* yr = YB + t * D + cs * 128 + c8 * 16;
              *(v4u*)yr = pack8(r0); *(v4u*)(yr + 8) = pack8(r1); }
            s1 += __shfl_xor(s1, 1); s1 += __shfl_xor(s1, 2); s1 += __shfl_xor(s1, 4);
            s2 += __shfl_xor(s2, 1); s2 += __shfl_xor(s2, 2); s2 += __shfl_xor(s2, 4);
            if (c8 == 0) { STATS[(t * 8 + cs) * 2] = s1; STATS[(t * 8 + cs) * 2 + 1] = s2; }
            LDS_WAIT(); asm volatile("" ::: "memory");
        }
    }
    SEAM(15);
    if (IN(16)) {
        for (int t = gw; t < T; t += NGW) {
            const int lane = F.lane;
            float y[16]; { float y0[8], y1[8]; unpack8(*(const v4u*)(YB + (size_t)t * D + lane * 16), y0); unpack8(*(const v4u*)(YB + (size_t)t * D + lane * 16 + 8), y1);
#pragma unroll
                for (int j = 0; j < 8; ++j) { y[j] = y0[j]; y[8 + j] = y1[j]; } }
            float s1 = (lane < 8) ? STATS[((size_t)t * 8 + lane) * 2] : 0.f, s2 = (lane < 8) ? STATS[((size_t)t * 8 + lane) * 2 + 1] : 0.f;
            s1 += __shfl_xor(s1, 1); s1 += __shfl_xor(s1, 2); s1 += __shfl_xor(s1, 4);
            s2 += __shfl_xor(s2, 1); s2 += __shfl_xor(s2, 2); s2 += __shfl_xor(s2, 4);
            s1 = __shfl(s1, 0); s2 = __shfl(s2, 0);
            const float mean = s1 * (1.f / D); const float var = fmaxf(s2 * (1.f / D) - mean * mean, 0.f); const float rstd = 1.f / sqrtf(var + LN_EPS);
            float res[16];
#pragma unroll
            for (int j = 0; j < 4; ++j) { const f32x4 gg = *(const f32x4*)(ln2_g + lane * 16 + 4 * j), bb4 = *(const f32x4*)(ln2_b + lane * 16 + 4 * j);
                res[4 * j] = (y[4 * j] - mean) * rstd * gg.x + bb4.x; res[4 * j + 1] = (y[4 * j + 1] - mean) * rstd * gg.y + bb4.y;
                res[4 * j + 2] = (y[4 * j + 2] - mean) * rstd * gg.z + bb4.z; res[4 * j + 3] = (y[4 * j + 3] - mean) * rstd * gg.w + bb4.w; }
            { float r0[8], r1[8];
#pragma unroll
              for (int j = 0; j < 8; ++j) { r0[j] = res[j]; r1[j] = res[8 + j]; }
              *(v4u*)(X2B + (size_t)t * D + lane * 16) = pack8(r0); *(v4u*)(X2B + (size_t)t * D + lane * 16 + 8) = pack8(r1); }
        }
    }
    SEAM(16);
    if (IN(17)) { EpiFinal E{X2B, PP, out}; run_gemm(F, X2B, WpgT, T, D, D, E); }
#undef IN
#undef SEAM
}

extern "C" void kernel_launch(void* const* d_in, const int* in_sizes, int n_in, void* d_out, int out_size, void* d_ws, size_t ws_size, hipStream_t stream) {
    static int grid = 0;
    if (grid == 0) {
        if (n_in != 20 || out_size != T * D || ws_size < WS_END) { fprintf(stderr, "kernel_launch: unexpected shapes (n_in %d out %d ws %zu)\n", n_in, out_size, ws_size); grid = -1; return; }
        int dev = 0, cus = 0;
        if (hipGetDevice(&dev) != hipSuccess || hipDeviceGetAttribute(&cus, hipDeviceAttributeMultiprocessorCount, dev) != hipSuccess) { grid = -1; return; }
        if (hipFuncSetAttribute((const void*)skel_fwd, hipFuncAttributeMaxDynamicSharedMemorySize, LDS_BYTES) != hipSuccess) { fprintf(stderr, "kernel_launch: hipFuncSetAttribute failed\n"); grid = -1; return; }
        (void)hipGetLastError();
        grid = cus;
    }
    if (grid < 0) return;
    if (hipMemsetAsync((char*)d_ws + WS_CTL, 0, CTL_ZERO_BYTES, stream) != hipSuccess) return;
    Args a{};
    for (int i = 0; i < 20; ++i) a.in[i] = (const float*)d_in[i];
    a.out = (float*)d_out; a.ws = (unsigned char*)d_ws;
    if (N_LAUNCHES == 1) {
        a.ph_lo = 0; a.ph_hi = NPHASES; a.li = 0;
        hipLaunchKernelGGL(skel_fwd, dim3(grid), dim3(NWAVES * 64), LDS_BYTES, stream, a);
    } else {
        for (int li = 0; li < NPHASES; ++li) {
            a.ph_lo = li; a.ph_hi = li + 1; a.li = li;
            hipLaunchKernelGGL(skel_fwd, dim3(grid), dim3(NWAVES * 64), LDS_BYTES, stream, a);
        }
    }
}
```
